# Optimizing an MI355X kernel written in HIP

```python
import jax, jax.numpy as jnp
from jax import lax
import numpy as np

D_MODEL = 1024
BATCH = 2
SEQ = 8192
DEPTH = 2

CHUNK = 64
N_MIXERS = 2
N_A = (DEPTH + 1) // 2
N_B = DEPTH // 2
FOX_HEADS = 16
FOX_HEAD_DIM = D_MODEL // FOX_HEADS
Q_BLOCK = 128
RNN_WIDTH = (4 * D_MODEL // 3) // 128 * 128
RNN_BLOCKS = 16
RNN_BLOCK_W = RNN_WIDTH // RNN_BLOCKS
CONV_WIDTH = 4
RG_C = 8.0
D_FF = (8 * D_MODEL // 3 + 255) // 256 * 256
RMS_EPS = 1e-6

kernel_name = "fox_rglru_macaron_hybrid"


def rmsnorm(x, g):
    xf = x.astype(jnp.float32)
    y = xf * lax.rsqrt(jnp.mean(xf * xf, axis=-1, keepdims=True) + RMS_EPS)
    return (y * g.astype(jnp.float32)).astype(x.dtype)


def swiglu(h, w_gu, w_down):
    g, u = jnp.split(h @ w_gu, 2, axis=-1)
    return (jax.nn.silu(g) * u) @ w_down


def forgetting_attention_mixer(h, w_in, b_f, w_out):
    B, T, _ = h.shape
    proj = h @ w_in
    q, k, v, f_logit = jnp.split(proj, [D_MODEL, 2 * D_MODEL, 3 * D_MODEL], axis=-1)
    q = q.reshape(B, T, FOX_HEADS, FOX_HEAD_DIM)
    k = k.reshape(B, T, FOX_HEADS, FOX_HEAD_DIM)
    v = v.reshape(B, T, FOX_HEADS, FOX_HEAD_DIM)
    log_f = jax.nn.log_sigmoid(f_logit.astype(jnp.float32) + b_f.astype(jnp.float32))
    F = jnp.transpose(jnp.cumsum(log_f, axis=1), (0, 2, 1))
    scale = FOX_HEAD_DIM ** -0.5
    k_pos = jnp.arange(T)

    def q_block(i):
        start = i * Q_BLOCK
        qb = lax.dynamic_slice_in_dim(q, start, Q_BLOCK, axis=1)
        Fq = lax.dynamic_slice_in_dim(F, start, Q_BLOCK, axis=2)
        s = jnp.einsum('bqhd,bkhd->bhqk', qb, k, preferred_element_type=jnp.float32) * scale
        s = s + Fq[..., :, None] - F[..., None, :]
        q_pos = start + jnp.arange(Q_BLOCK)
        s = jnp.where(k_pos[None, :] <= q_pos[:, None], s, -jnp.inf)
        p = jax.nn.softmax(s, axis=-1)
        return jnp.einsum('bhqk,bkhd->bqhd', p.astype(v.dtype), v)

    out = lax.map(q_block, jnp.arange(T // Q_BLOCK))
    out = jnp.moveaxis(out, 0, 1).reshape(B, T, D_MODEL)
    return out @ w_out


def _lru_combine(c1, c2):
    a1, b1 = c1
    a2, b2 = c2
    return a1 * a2, a2 * b1 + b2


def rglru_mixer(h, w_in, conv_w, conv_b, w_a, b_a, w_i, b_i, lam, w_out):
    B, T, _ = h.shape
    gate_br, rec_br = jnp.split(h @ w_in, 2, axis=-1)
    gate_br = jax.nn.gelu(gate_br)
    xp = jnp.pad(rec_br, ((0, 0), (CONV_WIDTH - 1, 0), (0, 0)))
    xc = conv_b + xp[:, 0:T] * conv_w[0]
    for j in range(1, CONV_WIDTH):
        xc = xc + xp[:, j:j + T] * conv_w[j]
    xb = xc.reshape(B, T, RNN_BLOCKS, RNN_BLOCK_W)
    r = jax.nn.sigmoid((jnp.einsum('btnc,ncd->btnd', xb, w_a).reshape(B, T, RNN_WIDTH) + b_a).astype(jnp.float32))
    gi = jax.nn.sigmoid((jnp.einsum('btnc,ncd->btnd', xb, w_i).reshape(B, T, RNN_WIDTH) + b_i).astype(jnp.float32))
    log_a = -RG_C * r * jax.nn.softplus(-lam.astype(jnp.float32))
    a = jnp.exp(log_a)
    b = jnp.sqrt(-jnp.expm1(2.0 * log_a)) * (gi * xc.astype(jnp.float32))
    _, hs = lax.associative_scan(_lru_combine, (a, b), axis=1)
    y = hs.astype(h.dtype) * gate_br
    return y @ w_out


def _normal(key, shape, fan_in):
    return jax.random.normal(key, shape, jnp.float32) * (fan_in ** -0.5)


def _gain(key, shape):
    return 1.0 + 0.05 * jax.random.normal(key, shape, jnp.float32)


def setup_inputs(seed: int = 0) -> dict:
    key = jax.random.key(seed)
    ks = jax.random.split(key, 24)
    D, R = D_MODEL, RNN_WIDTH
    a0 = jax.random.uniform(ks[20], (N_B, R), jnp.float32, 0.9, 0.999)
    s0 = a0 ** (1.0 / RG_C)
    return {
        "x": jax.random.normal(ks[0], (BATCH, SEQ, D), jnp.float32),
        "ffn1_norm": _gain(ks[1], (DEPTH, D)),
        "ffn1_w_gu": _normal(ks[2], (DEPTH, D, 2 * D_FF), D),
        "ffn1_w_down": _normal(ks[3], (DEPTH, D_FF, D), D_FF),
        "mix_norm": _gain(ks[4], (DEPTH, D)),
        "ffn2_norm": _gain(ks[5], (DEPTH, D)),
        "ffn2_w_gu": _normal(ks[6], (DEPTH, D, 2 * D_FF), D),
        "ffn2_w_down": _normal(ks[7], (DEPTH, D_FF, D), D_FF),
        "fox_w_in": _normal(ks[8], (N_A, D, 3 * D + FOX_HEADS), D),
        "fox_b_f": 2.0 + 0.5 * jax.random.normal(ks[9], (N_A, FOX_HEADS), jnp.float32),
        "fox_w_out": _normal(ks[10], (N_A, D, D), D),
        "lru_w_in": _normal(ks[11], (N_B, D, 2 * R), D),
        "lru_conv_w": _normal(ks[12], (N_B, CONV_WIDTH, R), CONV_WIDTH),
        "lru_conv_b": 0.02 * jax.random.normal(ks[13], (N_B, R), jnp.float32),
        "lru_w_a": _normal(ks[14], (N_B, RNN_BLOCKS, RNN_BLOCK_W, RNN_BLOCK_W), RNN_BLOCK_W),
        "lru_b_a": 0.02 * jax.random.normal(ks[15], (N_B, R), jnp.float32),
        "lru_w_i": _normal(ks[16], (N_B, RNN_BLOCKS, RNN_BLOCK_W, RNN_BLOCK_W), RNN_BLOCK_W),
        "lru_b_i": 0.02 * jax.random.normal(ks[17], (N_B, R), jnp.float32),
        "lru_lambda": jnp.log(s0) - jnp.log1p(-s0),
        "lru_w_out": _normal(ks[18], (N_B, R, D), R),
        "final_norm": _gain(ks[19], (D,)),
    }


def reference(x, ffn1_norm, ffn1_w_gu, ffn1_w_down, mix_norm, ffn2_norm, ffn2_w_gu, ffn2_w_down,
              fox_w_in, fox_b_f, fox_w_out, lru_w_in, lru_conv_w, lru_conv_b, lru_w_a, lru_b_a,
              lru_w_i, lru_b_i, lru_lambda, lru_w_out, final_norm):
    for i in range(DEPTH):
        x = x + 0.5 * swiglu(rmsnorm(x, ffn1_norm[i]), ffn1_w_gu[i], ffn1_w_down[i])
        h = rmsnorm(x, mix_norm[i])
        j = i // N_MIXERS
        if i % N_MIXERS == 0:
            m = forgetting_attention_mixer(h, fox_w_in[j], fox_b_f[j], fox_w_out[j])
        else:
            m = rglru_mixer(h, lru_w_in[j], lru_conv_w[j], lru_conv_b[j], lru_w_a[j], lru_b_a[j],
                            lru_w_i[j], lru_b_i[j], lru_lambda[j], lru_w_out[j])
        x = x + m
        x = x + 0.5 * swiglu(rmsnorm(x, ffn2_norm[i]), ffn2_w_gu[i], ffn2_w_down[i])
    return rmsnorm(x, final_norm)
```

```cpp
#include <hip/hip_runtime.h>
#include <hip/hip_cooperative_groups.h>
#include <cstdio>
#include <cstdint>
namespace cg = cooperative_groups;
__device__ __forceinline__ int otid() { int t = (int)threadIdx.x; asm volatile("" : "+v"(t)); return t; }
__device__ __forceinline__ int osgpr(int v) { v = __builtin_amdgcn_readfirstlane(v); asm volatile("" : "+s"(v)); return v; }
namespace pg8 {
#define PG8_LAS __attribute__((address_space(3)))
typedef unsigned short bf16_t;
typedef short bf16x8 __attribute__((ext_vector_type(8)));
typedef float f32x4 __attribute__((ext_vector_type(4)));
typedef unsigned u32x4 __attribute__((ext_vector_type(4)));
constexpr int BM = 256, BK = 64, HALF = 128, HTB = HALF * BK * 2  , STAGE_BYTES = 8 * HTB, NXCD = 8, WGM = 8;

__host__ __device__ __forceinline__ int lds_byte(int r, int c) { const int st = (r >> 4) * 2 + (c >> 5), rr = r & 15, cc = c & 31, ob = rr * 64 + cc * 2; return st * 1024 + (ob ^ (((ob >> 9) & 1) << 5)); }
__host__ __device__ __forceinline__ void stage_rc(int b, int& R, int& C) { const int st = b / 1024, sb = b % 1024, swz = sb ^ (((sb >> 9) & 1) << 5); R = (st >> 1) * 16 + swz / 64; C = (st & 1) * 32 + (swz % 64) / 2; }
__host__ __device__ __forceinline__ int perm32(int rho) { const int n = rho >> 4, i = rho & 15; return 8 * (i >> 2) + 4 * n + (i & 3); }

struct Unit { int pm, pn; };
struct Gemm { const bf16_t* A; const bf16_t* Bt; int M, N, K; };

struct StaticOrder {
    int nM, nN, nwg, G, c;
    __host__ __device__ void init(int M, int N, int G_, int c_) { nM = M / BM; nN = N / BM; nwg = nM * nN; G = G_; c = c_; }
    __host__ __device__ bool next(int i, Unit& u) const {
        const long L = (long)i * G + c; if (L >= nwg) return false;
        int wgid = (int)L; { const int q = nwg / NXCD, r = nwg % NXCD, xcd = wgid % NXCD, off = wgid / NXCD; wgid = (xcd < r ? xcd * (q + 1) : r * (q + 1) + (xcd - r) * q) + off; }
        const int nig = WGM * nN, gid = wgid / nig, fm = gid * WGM, gsz = (nM - fm) < WGM ? (nM - fm) : WGM;
        u.pm = fm + ((wgid % nig) % gsz); u.pn = (wgid % nig) / gsz; return true;
    }
    __device__ __forceinline__ void a_ready(const Unit&) const {}
    __device__ __forceinline__ void done(const Unit&) const {}
};

__device__ __forceinline__ unsigned cvt_pk_bf16(float lo, float hi) { unsigned r; asm volatile("v_cvt_pk_bf16_f32 %0, %1, %2" : "=v"(r) : "v"(lo), "v"(hi)); return r; }
typedef float f32x2 __attribute__((ext_vector_type(2)));
__device__ __forceinline__ f32x2 gelu_pk(f32x2 v) {
    const f32x2 av = __builtin_elementwise_abs(v), d = av * 0.2316418882f + 1.0f;
    f32x2 t; t.x = __builtin_amdgcn_rcpf(d.x); t.y = __builtin_amdgcn_rcpf(d.y);
    f32x2 q = t * 0.5307027145f + (-0.7265760135f); q = q * t + 0.7107068705f; q = q * t + (-0.142248368f); q = q * t + 0.127414796f; q = q * t;
    const f32x2 s = (v * v) * (-0.72134752044f);
    f32x2 e; e.x = __builtin_amdgcn_exp2f(s.x); e.y = __builtin_amdgcn_exp2f(s.y);
    const f32x2 m = v * (q * e), r = v - m;
    f32x2 o; o.x = v.x < 0.f ? m.x : r.x; o.y = v.y < 0.f ? m.y : r.y; return o;
}

template <int ACT  > struct EpiBf16 {
    static constexpr bool PERM = true, AFTER_DRAIN = false; static_assert(ACT == 0 || ACT == 1, "EpiBf16: ACT is 0 (none) or 1 (gelu_pk)");
    bf16_t* O; int ldc; const float* bias; int split_cols; size_t split_stride; float scale0;
    __device__ __forceinline__ void operator()(const f32x4 (&acc)[2][2][4][2], const Unit& u, int wr, int wc, int fr, int fq) const {
        const int row0 = u.pm * BM + wr * 64 + fr; int colt = u.pn * BM; bf16_t* base = O;
        float sc = 1.f; if (split_cols) { const int t = colt / split_cols; base += (size_t)t * split_stride; colt -= t * split_cols; if (t == 0) sc = scale0; }
        const int col0 = colt + wc * 32 + 8 * fq, bcol0 = u.pn * BM + wc * 32 + 8 * fq;
        f32x4 bv[2][2];
#pragma unroll
        for (int bj = 0; bj < 2; ++bj)
#pragma unroll
            for (int n = 0; n < 2; ++n) bv[bj][n] = bias ? *(const f32x4*)(bias + bcol0 + bj * HALF + 4 * n) : (f32x4){0.f, 0.f, 0.f, 0.f};
#pragma unroll
        for (int ai = 0; ai < 2; ++ai)
#pragma unroll
            for (int m = 0; m < 4; ++m) { bf16_t* rowp = base + (size_t)(row0 + ai * HALF + m * 16) * ldc + col0;
#pragma unroll
                for (int bj = 0; bj < 2; ++bj) { f32x4 v0 = acc[ai][bj][m][0] + bv[bj][0], v1 = acc[ai][bj][m][1] + bv[bj][1];
                    if (ACT == 1) { f32x2 a = gelu_pk((f32x2){v0[0], v0[1]}), b = gelu_pk((f32x2){v0[2], v0[3]}), c = gelu_pk((f32x2){v1[0], v1[1]}), d = gelu_pk((f32x2){v1[2], v1[3]});
                        v0 = (f32x4){a.x, a.y, b.x, b.y}; v1 = (f32x4){c.x, c.y, d.x, d.y}; }
                    v0 = v0 * sc; v1 = v1 * sc; u32x4 w; w.x = cvt_pk_bf16(v0[0], v0[1]); w.y = cvt_pk_bf16(v0[2], v0[3]); w.z = cvt_pk_bf16(v1[0], v1[1]); w.w = cvt_pk_bf16(v1[2], v1[3]);
                    *(u32x4*)(rowp + bj * HALF) = w; } }
    }
};

typedef unsigned u32x2 __attribute__((ext_vector_type(2)));
__device__ __forceinline__ float rstd_row(const float* ss, int row) {
    const float s = __hip_atomic_load(ss + row, __ATOMIC_RELAXED, __HIP_MEMORY_SCOPE_AGENT);
    return 1.0f / sqrtf(s * (1.0f / 1024.0f) + 1e-6f);
}
__device__ __forceinline__ float fast_sigmoid(float v) { return __builtin_amdgcn_rcpf(1.0f + __builtin_amdgcn_exp2f(-1.4426950408889634f * v)); }
struct EpiSwiGLU {
    static constexpr bool PERM = true, AFTER_DRAIN = false;
    bf16_t* H; const float* ss;
    __device__ __forceinline__ void operator()(const f32x4 (&acc)[2][2][4][2], const Unit& u, int wr, int wc, int fr, int fq) const {
        const int hc0 = u.pn * 128 + wc * 32 + 8 * fq;
#pragma unroll
        for (int ai = 0; ai < 2; ++ai)
#pragma unroll
            for (int m = 0; m < 4; ++m) { const int row = u.pm * BM + ai * HALF + wr * 64 + m * 16 + fr; const float rs = rstd_row(ss, row);
                float hv[8];
#pragma unroll
                for (int n = 0; n < 2; ++n)
#pragma unroll
                    for (int e = 0; e < 4; ++e) { const float g = acc[ai][0][m][n][e] * rs, uu = acc[ai][1][m][n][e] * rs; hv[4 * n + e] = g * fast_sigmoid(g) * uu; }
                u32x4 w; w.x = cvt_pk_bf16(hv[0], hv[1]); w.y = cvt_pk_bf16(hv[2], hv[3]); w.z = cvt_pk_bf16(hv[4], hv[5]); w.w = cvt_pk_bf16(hv[6], hv[7]);
                *(u32x4*)(H + (size_t)row * 2816 + hc0) = w; }
    }
};
struct EpiResid {
    static constexpr bool PERM = false, AFTER_DRAIN = false;
    const float* xin; float* xout; bf16_t* xb; float* ss; float alpha;
    __device__ __forceinline__ void operator()(const f32x4 (&acc)[2][2][4][2], const Unit& u, int wr, int wc, int fr, int fq) const {
        const int col0 = u.pn * BM + wc * 32 + 4 * fq;
#pragma unroll
        for (int ai = 0; ai < 2; ++ai)
#pragma unroll
            for (int m = 0; m < 4; ++m) { const int row = u.pm * BM + ai * HALF + wr * 64 + m * 16 + fr; const size_t off = (size_t)row * 1024 + col0; float s = 0.f;
#pragma unroll
                for (int bj = 0; bj < 2; ++bj)
#pragma unroll
                    for (int n = 0; n < 2; ++n) { const f32x4 xi = *(const f32x4*)(xin + off + bj * HALF + n * 16); const f32x4 o = xi + acc[ai][bj][m][n] * alpha;
                        *(f32x4*)(xout + off + bj * HALF + n * 16) = o; s += (o[0] * o[0] + o[1] * o[1]) + (o[2] * o[2] + o[3] * o[3]);
                        u32x2 w; w.x = cvt_pk_bf16(o[0], o[1]); w.y = cvt_pk_bf16(o[2], o[3]); *(u32x2*)(xb + off + bj * HALF + n * 16) = w; }
                s += __shfl_xor(s, 16); s += __shfl_xor(s, 32);
                if (fq == 0) __hip_atomic_fetch_add(ss + row, s, __ATOMIC_RELAXED, __HIP_MEMORY_SCOPE_AGENT); }
    }
};
struct EpiQKV {
    static constexpr bool PERM = true, AFTER_DRAIN = false;
    bf16_t* Q; size_t split_stride; const float* ss; float scale0;
    __device__ __forceinline__ void operator()(const f32x4 (&acc)[2][2][4][2], const Unit& u, int wr, int wc, int fr, int fq) const {
        int colt = u.pn * BM; const int t = colt >> 10; bf16_t* base = Q + (size_t)t * split_stride; colt -= t << 10; const float sc = (t == 0) ? scale0 : 1.f;
        const int col0 = colt + wc * 32 + 8 * fq;
#pragma unroll
        for (int ai = 0; ai < 2; ++ai)
#pragma unroll
            for (int m = 0; m < 4; ++m) { const int row = u.pm * BM + ai * HALF + wr * 64 + m * 16 + fr; const float rs = rstd_row(ss, row) * sc; bf16_t* rowp = base + (size_t)row * 1024 + col0;
#pragma unroll
                for (int bj = 0; bj < 2; ++bj) { const f32x4 v0 = acc[ai][bj][m][0] * rs, v1 = acc[ai][bj][m][1] * rs;
                    u32x4 w; w.x = cvt_pk_bf16(v0[0], v0[1]); w.y = cvt_pk_bf16(v0[2], v0[3]); w.z = cvt_pk_bf16(v1[0], v1[1]); w.w = cvt_pk_bf16(v1[2], v1[3]);
                    *(u32x4*)(rowp + bj * HALF) = w; } }
    }
};
__device__ __forceinline__ float gelu_tanh(float v) { const float u2 = 1.5957691216057308f * (v + 0.044715f * v * v * v); return v * fast_sigmoid(u2); }
struct EpiLruIn {
    static constexpr bool PERM = true, AFTER_DRAIN = false;
    bf16_t* GATE; bf16_t* REC; const float* ss;
    __device__ __forceinline__ void operator()(const f32x4 (&acc)[2][2][4][2], const Unit& u, int wr, int wc, int fr, int fq) const {
        const bool isg = u.pn < 5; bf16_t* base = isg ? GATE : REC; const int col0 = (isg ? u.pn : u.pn - 5) * BM + wc * 32 + 8 * fq;
#pragma unroll
        for (int ai = 0; ai < 2; ++ai)
#pragma unroll
            for (int m = 0; m < 4; ++m) { const int row = u.pm * BM + ai * HALF + wr * 64 + m * 16 + fr; const float rs = rstd_row(ss, row); bf16_t* rowp = base + (size_t)row * 1280 + col0;
#pragma unroll
                for (int bj = 0; bj < 2; ++bj) { f32x4 v0 = acc[ai][bj][m][0] * rs, v1 = acc[ai][bj][m][1] * rs;
                    if (isg) {
#pragma unroll
                        for (int e = 0; e < 4; ++e) { v0[e] = gelu_tanh(v0[e]); v1[e] = gelu_tanh(v1[e]); } }
                    u32x4 w; w.x = cvt_pk_bf16(v0[0], v0[1]); w.y = cvt_pk_bf16(v0[2], v0[3]); w.z = cvt_pk_bf16(v1[0], v1[1]); w.w = cvt_pk_bf16(v1[2], v1[3]);
                    *(u32x4*)(rowp + bj * HALF) = w; } }
    }
};
template <class Epi, class Sched, bool ALIGN_EPI = false, bool SP2 = false>
__device__ __forceinline__ void gemm_phase(PG8_LAS unsigned char* lds, const Gemm g, const Sched& S, const Epi& E) {
    const int tid = otid(), wid = __builtin_amdgcn_readfirstlane(tid >> 6), lane = tid & 63, wr = wid >> 2, wc = wid & 3, fr = lane & 15, fq = lane >> 4;
    const int K = g.K, nt = K / BK;
    unsigned voffA[2], voffB[2];
#pragma unroll
    for (int i = 0; i < 2; ++i) { int R, C; stage_rc(tid * 16 + i * 8192, R, C); const int Rb = Epi::PERM ? ((R & ~31) + perm32(R & 31)) : R;
        voffA[i] = (unsigned)(R * K + C) * 2u; voffB[i] = (unsigned)(Rb * K + C) * 2u; }
    const size_t kstep = (size_t)(BK * 2);
    const size_t hstep = (size_t)HALF * K * 2;
    const size_t tstep = 2 * hstep;
    const unsigned ldsw = (unsigned)wid * 1024u;
    const int aoff = lds_byte(wr * 64 + fr, fq * 8), boff = lds_byte(wc * 32 + fr, fq * 8);
#define PG8_SA(b, h) (((b) * 2 + (h)) * HTB)
#define PG8_SB(b, h) ((4 + (b) * 2 + (h)) * HTB)
#define PG8_STAGE(bufoff, gbase, voff) do { _Pragma("unroll") for (int _i = 0; _i < 2; ++_i) \
        __builtin_amdgcn_global_load_lds((const unsigned*)((const char*)(gbase) + (voff)[_i]), (PG8_LAS unsigned*)(lds + (bufoff) + ldsw + _i * 8192), 16, 0, 0); } while (0)
#define PG8_LDA(dst, b, h) do { _Pragma("unroll") for (int m = 0; m < 4; ++m) _Pragma("unroll") for (int k = 0; k < 2; ++k) dst[m][k] = *(const PG8_LAS bf16x8*)(lds + PG8_SA(b, h) + aoff + m * 2048 + k * 1024); } while (0)
#define PG8_LDB(dst, b, h) do { _Pragma("unroll") for (int n = 0; n < 2; ++n) _Pragma("unroll") for (int k = 0; k < 2; ++k) dst[n][k] = *(const PG8_LAS bf16x8*)(lds + PG8_SB(b, h) + boff + n * 2048 + k * 1024); } while (0)
#define PG8_MMA(ai, bj, At, Bt) do { __builtin_amdgcn_s_setprio(1); _Pragma("unroll") for (int m = 0; m < 4; ++m) _Pragma("unroll") for (int n = 0; n < 2; ++n) _Pragma("unroll") for (int k = 0; k < 2; ++k) \
        acc[ai][bj][m][n] = __builtin_amdgcn_mfma_f32_16x16x32_bf16(Bt[n][k], At[m][k], acc[ai][bj][m][n], 0, 0, 0); __builtin_amdgcn_s_setprio(0); } while (0)
#define PG8_WAIT_V(n) asm volatile("s_waitcnt vmcnt(" #n ")" ::: "memory")
#define PG8_WAIT_L(n) asm volatile("s_waitcnt lgkmcnt(" #n ")" ::: "memory")
#define PG8_BAR __builtin_amdgcn_s_barrier()
#define PG8_SCHED __builtin_amdgcn_sched_barrier(0)
    Unit cur, nxt; int ui = 0;
    if (!S.next(0, cur)) return;
    f32x4 acc[2][2][4][2];
#pragma unroll
    for (int a = 0; a < 2; ++a)
#pragma unroll
        for (int b = 0; b < 2; ++b)
#pragma unroll
            for (int m = 0; m < 4; ++m)
#pragma unroll
                for (int n = 0; n < 2; ++n) acc[a][b][m][n] = (f32x4){0.f, 0.f, 0.f, 0.f};
    bf16x8 At[4][2], B0[2][2], B1[2][2];
    const char* cA = (const char*)g.A + (size_t)cur.pm * tstep; const char* cB = (const char*)g.Bt + (size_t)cur.pn * tstep;
    S.a_ready(cur);
    if constexpr (SP2) {
        PG8_STAGE(PG8_SB(0, 0), cB, voffB); PG8_STAGE(PG8_SB(0, 1), cB + hstep, voffB); PG8_STAGE(PG8_SA(0, 0), cA, voffA); PG8_STAGE(PG8_SA(0, 1), cA + hstep, voffA);
        if (wr == 1) PG8_BAR;
        PG8_WAIT_V(2); PG8_BAR;
        PG8_STAGE(PG8_SB(1, 0), cB + kstep, voffB); PG8_STAGE(PG8_SA(1, 0), cA + kstep, voffA); PG8_STAGE(PG8_SB(1, 1), cB + hstep + kstep, voffB);
        PG8_WAIT_V(6); PG8_BAR;
    } else {
        PG8_STAGE(PG8_SB(0, 0), cB, voffB); PG8_STAGE(PG8_SA(0, 0), cA, voffA); PG8_STAGE(PG8_SB(0, 1), cB + hstep, voffB); PG8_STAGE(PG8_SA(0, 1), cA + hstep, voffA);
        if (wr == 1) PG8_BAR;
        PG8_WAIT_V(4); PG8_BAR;
        PG8_STAGE(PG8_SB(1, 0), cB + kstep, voffB); PG8_STAGE(PG8_SA(1, 0), cA + kstep, voffA); PG8_STAGE(PG8_SB(1, 1), cB + hstep + kstep, voffB);
        PG8_WAIT_V(6); PG8_BAR;
    }
    for (;;) {
        const bool has_next = S.next(ui + 1, nxt);
        const char* nA = has_next ? (const char*)g.A + (size_t)nxt.pm * tstep : cA; const char* nB = has_next ? (const char*)g.Bt + (size_t)nxt.pn * tstep : cB;
        for (int t = 0; t < nt; t += 2) {
            const bool last = (t == nt - 2);
            const char* a1 = cA + (size_t)(t + 1) * kstep;
            const char* a2 = last ? nA : cA + (size_t)(t + 2) * kstep; const char* b2 = last ? nB : cB + (size_t)(t + 2) * kstep;
            const char* a3 = a2 + kstep; const char* b3 = b2 + kstep;
            if (last && has_next) S.a_ready(nxt);
            if constexpr (SP2) {
            PG8_LDB(B0, 0, 0); PG8_LDB(B1, 0, 1); PG8_SCHED; PG8_LDA(At, 0, 0); PG8_STAGE(PG8_SA(1, 1), a1 + hstep, voffA);
            PG8_WAIT_V(8); PG8_WAIT_L(0); PG8_BAR; PG8_MMA(0, 0, At, B0); PG8_MMA(0, 1, At, B1); PG8_BAR; PG8_SCHED;
            PG8_LDA(At, 0, 1); PG8_STAGE(PG8_SB(0, 0), b2, voffB); PG8_STAGE(PG8_SB(0, 1), b2 + hstep, voffB); PG8_STAGE(PG8_SA(0, 0), a2, voffA);
            PG8_WAIT_V(8); PG8_WAIT_L(0); PG8_BAR; PG8_MMA(1, 0, At, B0); PG8_MMA(1, 1, At, B1); PG8_BAR; PG8_SCHED;
            PG8_LDB(B0, 1, 0); PG8_LDB(B1, 1, 1); PG8_SCHED; PG8_LDA(At, 1, 0); PG8_STAGE(PG8_SA(0, 1), a2 + hstep, voffA);
            PG8_WAIT_V(8); PG8_WAIT_L(0); PG8_BAR; PG8_MMA(0, 0, At, B0); PG8_MMA(0, 1, At, B1); PG8_BAR; PG8_SCHED;
            PG8_LDA(At, 1, 1); PG8_STAGE(PG8_SB(1, 0), b3, voffB); PG8_STAGE(PG8_SB(1, 1), b3 + hstep, voffB); PG8_STAGE(PG8_SA(1, 0), a3, voffA);
            PG8_WAIT_V(8); PG8_WAIT_L(0); PG8_BAR; PG8_MMA(1, 0, At, B0); PG8_MMA(1, 1, At, B1); PG8_BAR; PG8_SCHED;
            } else {
            PG8_LDB(B0, 0, 0); PG8_SCHED; PG8_LDA(At, 0, 0); PG8_STAGE(PG8_SA(1, 1), a1 + hstep, voffA);
            PG8_WAIT_L(8); PG8_BAR; PG8_WAIT_L(0); PG8_MMA(0, 0, At, B0); PG8_BAR; PG8_SCHED;
            PG8_LDB(B1, 0, 1); PG8_STAGE(PG8_SB(0, 0), b2, voffB);
            PG8_BAR; PG8_WAIT_L(0); PG8_MMA(0, 1, At, B1); PG8_BAR;
            PG8_LDA(At, 0, 1); PG8_STAGE(PG8_SA(0, 0), a2, voffA);
            PG8_BAR; PG8_WAIT_L(0); PG8_MMA(1, 0, At, B0); PG8_BAR; PG8_SCHED;
            PG8_STAGE(PG8_SB(0, 1), b2 + hstep, voffB);
            PG8_WAIT_V(6); PG8_BAR; PG8_MMA(1, 1, At, B1); PG8_BAR;
            PG8_LDB(B0, 1, 0); PG8_SCHED; PG8_LDA(At, 1, 0); PG8_STAGE(PG8_SA(0, 1), a2 + hstep, voffA);
            PG8_WAIT_L(8); PG8_BAR; PG8_WAIT_L(0); PG8_MMA(0, 0, At, B0); PG8_BAR; PG8_SCHED;
            PG8_LDB(B1, 1, 1); PG8_STAGE(PG8_SB(1, 0), b3, voffB);
            PG8_BAR; PG8_WAIT_L(0); PG8_MMA(0, 1, At, B1); PG8_BAR;
            PG8_LDA(At, 1, 1); PG8_STAGE(PG8_SA(1, 0), a3, voffA);
            PG8_BAR; PG8_WAIT_L(0); PG8_MMA(1, 0, At, B0); PG8_BAR; PG8_SCHED;
            PG8_STAGE(PG8_SB(1, 1), b3 + hstep, voffB);
            PG8_WAIT_V(6); PG8_BAR; PG8_MMA(1, 1, At, B1); PG8_BAR;
            }
        }
        if constexpr (ALIGN_EPI) { if (wr == 0) PG8_BAR; }
        if constexpr (!Epi::AFTER_DRAIN) { E(acc, cur, wr, wc, fr, fq); S.done(cur); }
        if (!has_next) break;
#pragma unroll
        for (int a = 0; a < 2; ++a)
#pragma unroll
            for (int b = 0; b < 2; ++b)
#pragma unroll
                for (int m = 0; m < 4; ++m)
#pragma unroll
                    for (int n = 0; n < 2; ++n) acc[a][b][m][n] = (f32x4){0.f, 0.f, 0.f, 0.f};
        cur = nxt; cA = nA; cB = nB; ++ui;
        if constexpr (ALIGN_EPI) { if (wr == 1) PG8_BAR; }
    }
    PG8_WAIT_V(0);
    if constexpr (!ALIGN_EPI) { if (wr == 0) PG8_BAR; }
    PG8_BAR;
    if constexpr (Epi::AFTER_DRAIN) { E.fused(acc, cur, wr, wc, fr, fq, lds, wid, lane); S.done(cur); }
#undef PG8_SA
#undef PG8_SB
#undef PG8_STAGE
#undef PG8_LDA
#undef PG8_LDB
#undef PG8_MMA
#undef PG8_WAIT_V
#undef PG8_WAIT_L
#undef PG8_BAR
#undef PG8_SCHED
}
}

#ifndef PG8_SP2
#define PG8_SP2 true
#endif
#ifndef PG8_ALIGN
#define PG8_ALIGN true
#endif
#include <hip/hip_bf16.h>
#include <cmath>
namespace attn_body {
using bf16=__hip_bfloat16;
using bf16x8=__attribute__((ext_vector_type(8)))short;
using s16x4=__attribute__((ext_vector_type(4)))short;
using f32x16=__attribute__((ext_vector_type(16)))float;
using u32x4=__attribute__((ext_vector_type(4)))unsigned;
constexpr int BATCH=2,NHEAD=16,SEQ=8192,D=64,DM=NHEAD*D;
constexpr int NW=8,QBLK=32,QB=QBLK*NW,KVBLK=64,NQB=SEQ/QB;
constexpr int ATTN_PITCH=DM, ATTN_UNIT_ROWS=QB;
__device__ __forceinline__ int crow(int r,int hi){return (r&3)+8*(r>>2)+4*hi;}
#define SBAR() __builtin_amdgcn_sched_barrier(0)
__device__ __forceinline__ void cmask(f32x16&p0,f32x16&p1,int jb,int qrel,int hi){
  const float NEG=-INFINITY; int kb=64*jb+4*hi;
  #pragma unroll
  for(int r=0;r<16;++r){int kv=kb+(r&3)+8*(r>>2); if(kv>qrel)p0[r]=NEG; if(kv+32>qrel)p1[r]=NEG;}
}

constexpr int NSLOT=3, SLOTB=8192;
constexpr int LDS_K=0, LDS_V=NSLOT*SLOTB, LDS_WS=2*NSLOT*SLOTB, LDS_OST=LDS_WS+NW*64*4, LDS_BYTES=LDS_OST+NW*4096;
constexpr float C2=0.125f*1.4426950408889634f;
__device__ __forceinline__ void glds16(const void*gsrc,unsigned lds_dst){unsigned keep;
  asm volatile("s_mov_b32 %0, m0\n\ts_mov_b32 m0, %2\n\ts_nop 0\n\tglobal_load_lds_dwordx4 %1, off\n\ts_mov_b32 m0, %0":"=&s"(keep):"v"(gsrc),"s"(lds_dst):"memory");}
__device__ __forceinline__ float max3f(float a,float b,float c){float r;asm("v_max3_f32 %0, %1, %2, %3":"=v"(r):"v"(a),"v"(b),"v"(c));return r;}
__device__ __forceinline__ float max2f(float a,float b){float r;asm("v_max_f32_e32 %0, %1, %2":"=v"(r):"v"(a),"v"(b));return r;}
__device__ __forceinline__ float fadd_s(float a,float b){float r;asm("v_add_f32_e32 %0, %1, %2":"=v"(r):"v"(a),"v"(b));return r;}
__device__ __forceinline__ float fsub_s(float a,float b){float r;asm("v_sub_f32_e32 %0, %1, %2":"=v"(r):"v"(a),"v"(b));return r;}
typedef float f32x2_t __attribute__((ext_vector_type(2))); typedef __bf16 bf16x2_t __attribute__((ext_vector_type(2)));
__device__ __forceinline__ unsigned cvtpk_s(float lo,float hi){f32x2_t v={lo,hi};bf16x2_t b=__builtin_convertvector(v,bf16x2_t);return __builtin_bit_cast(unsigned,b);}
#define WAIT_BAR(N) asm volatile("s_waitcnt vmcnt(" #N ") lgkmcnt(0)\n\ts_barrier":::"memory")

typedef __attribute__((address_space(3))) const float* lds_fptr; typedef float f32x4_t __attribute__((ext_vector_type(4))); typedef __attribute__((address_space(3))) const f32x4_t* lds_f4ptr;
__device__ __forceinline__ void qkt(f32x16&p0,f32x16&p1,const char*Kslot,const bf16x8*qr,int r32,int hi){
  const char*kb=Kslot+hi*1024+r32*16;
  #pragma unroll
  for(int d0=0;d0<4;++d0){
    const bf16x8 b0=*reinterpret_cast<const bf16x8*>(kb+d0*2048);
    const bf16x8 b1=*reinterpret_cast<const bf16x8*>(kb+d0*2048+512);
    p0=__builtin_amdgcn_mfma_f32_32x32x16_bf16(b0,qr[d0],p0,0,0,0);p1=__builtin_amdgcn_mfma_f32_32x32x16_bf16(b1,qr[d0],p1,0,0,0);}
}
typedef __attribute__((address_space(3))) const char* lds_cptr;
typedef short v4i16_t __attribute__((ext_vector_type(4)));
__device__ __forceinline__ void kload8(bf16x8*kf,lds_cptr kp){
  kf[0]=*(const __attribute__((address_space(3))) bf16x8*)(kp);      kf[1]=*(const __attribute__((address_space(3))) bf16x8*)(kp+512);
  kf[2]=*(const __attribute__((address_space(3))) bf16x8*)(kp+2048); kf[3]=*(const __attribute__((address_space(3))) bf16x8*)(kp+2560);
  kf[4]=*(const __attribute__((address_space(3))) bf16x8*)(kp+4096); kf[5]=*(const __attribute__((address_space(3))) bf16x8*)(kp+4608);
  kf[6]=*(const __attribute__((address_space(3))) bf16x8*)(kp+6144); kf[7]=*(const __attribute__((address_space(3))) bf16x8*)(kp+6656);
}
__device__ __forceinline__ void kload2(bf16x8*kf,lds_cptr kp,int j){ kf[2*j]=*(const __attribute__((address_space(3))) bf16x8*)(kp+j*2048); kf[2*j+1]=*(const __attribute__((address_space(3))) bf16x8*)(kp+j*2048+512); }
__device__ __forceinline__ s16x4 vtr(lds_cptr p){ return __builtin_bit_cast(s16x4,__builtin_amdgcn_ds_read_tr16_b64_v4i16((__attribute__((address_space(3))) v4i16_t*)p)); }
__device__ __forceinline__ float rowmax(const f32x16&p0,const f32x16&p1){
  float a=max3f(p0[0],p0[1],p1[0]),b=max3f(p0[2],p0[3],p1[1]);a=max3f(a,p1[2],p1[3]);
  #pragma unroll
  for(int r=4;r<16;r+=4){a=max3f(a,p0[r],p0[r+1]);b=max3f(b,p0[r+2],p0[r+3]);a=max3f(a,p1[r],p1[r+1]);b=max3f(b,p1[r+2],p1[r+3]);}
  const float m=max2f(a,b);
  auto rr=__builtin_amdgcn_permlane32_swap(__float_as_uint(m),__float_as_uint(m),false,false);
  return max2f(__uint_as_float(rr[0]),__uint_as_float(rr[1]));
}
__device__ __forceinline__ void pv(f32x16*o,int vb,bf16x8 pa0,bf16x8 pa1,bf16x8 pa2,bf16x8 pa3){
  #pragma unroll
  for(int d0=0;d0<2;++d0){s16x4 lo[4],hi[4];
    #pragma unroll
    for(int ks=0;ks<4;++ks){
      asm volatile("ds_read_b64_tr_b16 %0,%1 offset:%c2":"=&v"(lo[ks]):"v"(vb),"i"(d0*4096+ks*1024):"memory");
      asm volatile("ds_read_b64_tr_b16 %0,%1 offset:%c2":"=&v"(hi[ks]):"v"(vb),"i"(d0*4096+ks*1024+512):"memory");}
    asm volatile("s_waitcnt lgkmcnt(0)":::"memory");SBAR();
    #define PK(k) (bf16x8){lo[k][0],lo[k][1],lo[k][2],lo[k][3],hi[k][0],hi[k][1],hi[k][2],hi[k][3]}
    o[d0]=__builtin_amdgcn_mfma_f32_32x32x16_bf16(pa0,PK(0),o[d0],0,0,0);
    o[d0]=__builtin_amdgcn_mfma_f32_32x32x16_bf16(pa1,PK(1),o[d0],0,0,0);
    o[d0]=__builtin_amdgcn_mfma_f32_32x32x16_bf16(pa2,PK(2),o[d0],0,0,0);
    o[d0]=__builtin_amdgcn_mfma_f32_32x32x16_bf16(pa3,PK(3),o[d0],0,0,0);
    #undef PK
  }
}

#ifndef ATTN_STORE16
#define ATTN_STORE16(p,v) (*(u32x4*)(p)=(v))
#endif
template<int THRL> __device__ __forceinline__ void attn_unit(int b,int h,int qb,const bf16*Q,const bf16*__restrict__ K,const bf16*__restrict__ V,bf16*O,char*shm,lds_fptr Gp){
  const int tid=otid(),lane=tid&63,r32=lane&31,hi=lane>>5; const int wid=__builtin_amdgcn_readfirstlane(tid>>6);
  const long rowbase=(long)b*SEQ; const int q0=qb*QB;
  const bf16*Qw=Q+(rowbase+q0+wid*QBLK)*DM+h*D;
  const bf16*Kh=K+rowbase*DM+h*D,*Vh=V+rowbase*DM+h*D;
  const unsigned lds0=(unsigned)(uintptr_t)shm;
  float*wsf=(float*)(shm+LDS_WS)+wid*64;
  const bf16*ksrc=Kh+(long)lane*DM+wid*8;
  const bf16*vsrc=Vh+(long)(16*(wid&3)+(lane>>2))*DM+(wid>>2)*32+(lane&3)*8;
  const unsigned kdst=lds0+LDS_K+wid*1024, vdst=lds0+LDS_V+wid*1024;
  #define DMA_K(t,slot) glds16(ksrc+(long)(t)*KVBLK*DM,(unsigned)__builtin_amdgcn_readfirstlane(kdst+(slot)))
  #define DMA_V(t,slot) glds16(vsrc+(long)(t)*KVBLK*DM,(unsigned)__builtin_amdgcn_readfirstlane(vdst+(slot)))
  const int vb0=(int)(lds0+LDS_V)+((lane>>4)&1)*32+(lane&3)*8+(4*hi+((lane&15)>>2))*64;
  const char*Kbase=shm+LDS_K; bf16x8 kf[8];
  const lds_cptr shm3=(lds_cptr)shm; const lds_cptr kp0=shm3+LDS_K+hi*1024+r32*16; const lds_cptr vp0=shm3+LDS_V+((lane>>4)&1)*32+(lane&3)*8+(4*hi+((lane&15)>>2))*64;
  const int NT=(q0+QB)/KVBLK;
  DMA_K(0,0);DMA_V(0,0);DMA_K(1,SLOTB);
  bf16x8 qr[4];
  #pragma unroll
  for(int d0=0;d0<4;++d0)qr[d0]=*reinterpret_cast<const bf16x8*>(&Qw[(long)r32*DM+d0*16+hi*8]);
  float mhat=0.f,l_reg=0.f;f32x16 o[2];o[0]=f32x16{};o[1]=f32x16{};
  const float Gq=Gp[q0+wid*QBLK+r32]; float negmq=Gq;
  #define BIAS_LD(X0,X1,t) do{ const lds_f4ptr gp_=(lds_f4ptr)(Gp+64*(t)+4*hi); _Pragma("unroll") for(int j_=0;j_<4;++j_){ const f32x4_t a_=gp_[2*j_], b_=gp_[8+2*j_]; \
      X0[4*j_]=a_[0];X0[4*j_+1]=a_[1];X0[4*j_+2]=a_[2];X0[4*j_+3]=a_[3]; X1[4*j_]=b_[0];X1[4*j_+1]=b_[1];X1[4*j_+2]=b_[2];X1[4*j_+3]=b_[3]; } }while(0)
  #define BSUB4(X,B) do{ X[B]=negmq-X[B]; X[(B)+1]=negmq-X[(B)+1]; X[(B)+2]=negmq-X[(B)+2]; X[(B)+3]=negmq-X[(B)+3]; }while(0)
  #define BSUBALL(X0,X1) do{ _Pragma("unroll") for(int r_=0;r_<16;++r_){ X0[r_]=negmq-X0[r_]; X1[r_]=negmq-X1[r_]; } }while(0)
  const int qrel=wid*QBLK+r32;
  #define CMASK(P0,P1,t) do{int jb_=(t)-(NT-4); if(jb_>=0)cmask(P0,P1,jb_,qrel,hi);}while(0)
  bool resc=false;
  #define START(P0,P1) do{ const float rm=rowmax(P0,P1); resc=false; \
    { const float dl=__builtin_fmaxf(rm,-40.f); mhat=fadd_s(mhat,dl); \
      _Pragma("unroll") for(int r=0;r<16;++r){P0[r]=fsub_s(P0[r],dl);P1[r]=fsub_s(P1[r],dl);} \
      negmq=Gq-mhat; } \
    _Pragma("unroll") for(int r=0;r<16;++r)P0[r]=__builtin_amdgcn_exp2f(P0[r]); }while(0)
  #define RESC() do{ if(resc){ asm volatile("s_waitcnt lgkmcnt(0)":::"memory"); \
      _Pragma("unroll") for(int d_=0;d_<2;++d_) _Pragma("unroll") for(int r=0;r<16;++r)o[d_][r]*=wsf[crow(r,hi)]; } }while(0)
  f32x16 pA0,pA1,pB0,pB1;
  int sl_prev=0,sl_cur=0,sl_next=SLOTB;
  #define ROT() do{sl_prev=sl_cur;sl_cur=sl_next;sl_next=(sl_next==(NSLOT-1)*SLOTB)?0:sl_next+SLOTB;}while(0)
  DMA_K(2,2*SLOTB);
  WAIT_BAR(3);
  BIAS_LD(pA0,pA1,0); BSUBALL(pA0,pA1);
  qkt(pA0,pA1,Kbase,qr,r32,hi);asm volatile("s_nop 15\n\ts_nop 7":"+v"(pA0),"+v"(pA1));CMASK(pA0,pA1,0);
  START(pA0,pA1);
  _Pragma("unroll") for(int r=0;r<16;++r)pA1[r]=__builtin_amdgcn_exp2f(pA1[r]);
  BIAS_LD(pB0,pB1,1); BSUBALL(pB0,pB1);
  WAIT_BAR(0);
  DMA_K(3,0);DMA_V(1,SLOTB);
  ROT();
  kload8(kf,kp0+sl_cur);
  WAIT_BAR(2);
  s16x4 vlo[8],vhi[8]; u32x4 pw0,pw1,pw2,pw3;
  #define PKW(P,B) cvtpk_s(P[B],P[B+1])
  #define PAF(k) __builtin_bit_cast(bf16x8,pw##k)
  #define VFR(i) (bf16x8){vlo[i][0],vlo[i][1],vlo[i][2],vlo[i][3],vhi[i][0],vhi[i][1],vhi[i][2],vhi[i][3]}
  #define PIN(x) asm volatile("":"+v"(x))
  #define MX3(a,b,c) __builtin_fmaxf(__builtin_fmaxf((a),(b)),(c))
  #define GAPA(MF,A0,A1,A2,A3,W0,W1,PW) do{ MF; sacc+=A0; sacc+=A1; sacc+=A2; sacc+=A3; PIN(sacc); W0; W1; PIN(PW); SBAR(); }while(0)
  #define EX(v) __builtin_amdgcn_exp2f(v)
  #define GAPB(MF,X,B,GL_,Y,YB) do{ MF; X[B]=EX(X[B]); X[B+1]=EX(X[B+1]); X[B+2]=EX(X[B+2]); X[B+3]=EX(X[B+3]); PIN(X); if(GL_){ BSUB4(Y,YB); PIN(Y); } SBAR(); }while(0)
  #define VRD(i) do{ vlo[i]=vtr(vp_+(((i)>>2)*4096+((i)&3)*1024)); vhi[i]=vtr(vp_+(((i)>>2)*4096+((i)&3)*1024+512)); }while(0)
  #define KRD(G,j) do{ if(G){ kload2(kf,kp0+sl_next,j); SBAR(); } }while(0)
  #define STEP(C0,C1,P0,P1,t,GK,GV,GL) do{ SBAR(); \
    const lds_cptr vp_=vp0+sl_prev; \
    VRD(0); SBAR(); float sacc=(P0[0]+P0[1]); \
    GAPA(C0=__builtin_amdgcn_mfma_f32_32x32x16_bf16(kf[0],qr[0],C0,0,0,0), P0[2],P0[3],P0[4],P0[5],     pw0[0]=PKW(P0,0), pw0[1]=PKW(P0,2), pw0); \
    VRD(4); SBAR(); GAPA(C1=__builtin_amdgcn_mfma_f32_32x32x16_bf16(kf[1],qr[0],C1,0,0,0), P0[6],P0[7],P0[8],P0[9],     pw0[2]=PKW(P0,4), pw0[3]=PKW(P0,6), pw0); \
    VRD(1); SBAR(); GAPA(C0=__builtin_amdgcn_mfma_f32_32x32x16_bf16(kf[2],qr[1],C0,0,0,0),   P0[10],P0[11],P0[12],P0[13], pw1[0]=PKW(P0,8), pw1[1]=PKW(P0,10), pw1); \
    VRD(5); SBAR(); GAPA(C1=__builtin_amdgcn_mfma_f32_32x32x16_bf16(kf[3],qr[1],C1,0,0,0),   P0[14],P0[15],P1[0],P1[1],   pw1[2]=PKW(P0,12),pw1[3]=PKW(P0,14), pw1); \
    VRD(2); SBAR(); GAPA(C0=__builtin_amdgcn_mfma_f32_32x32x16_bf16(kf[4],qr[2],C0,0,0,0),   P1[2],P1[3],P1[4],P1[5],     pw2[0]=PKW(P1,0), pw2[1]=PKW(P1,2), pw2); \
    VRD(6); SBAR(); GAPA(C1=__builtin_amdgcn_mfma_f32_32x32x16_bf16(kf[5],qr[2],C1,0,0,0),   P1[6],P1[7],P1[8],P1[9],     pw2[2]=PKW(P1,4), pw2[3]=PKW(P1,6), pw2); \
    VRD(3); SBAR(); GAPA(C0=__builtin_amdgcn_mfma_f32_32x32x16_bf16(kf[6],qr[3],C0,0,0,0),   P1[10],P1[11],P1[12],P1[13], pw3[0]=PKW(P1,8), pw3[1]=PKW(P1,10), pw3); \
    VRD(7); SBAR(); GAPA(C1=__builtin_amdgcn_mfma_f32_32x32x16_bf16(kf[7],qr[3],C1,0,0,0),   P1[14],P1[15],0.f,0.f,       pw3[2]=PKW(P1,12),pw3[3]=PKW(P1,14), pw3); \
    l_reg+=sacc; \
    if(GK){DMA_K((t)+3,sl_cur);} if(GV){DMA_V((t)+1,sl_next);} \
    CMASK(C0,C1,t); \
    { float a=MX3(C0[0],C0[1],C1[0]),b=MX3(C0[2],C0[3],C1[1]); a=MX3(a,C1[2],C1[3]); \
      _Pragma("unroll") for(int r=4;r<16;r+=4){a=MX3(a,C0[r],C0[r+1]);b=MX3(b,C0[r+2],C0[r+3]);a=MX3(a,C1[r],C1[r+1]);b=MX3(b,C1[r+2],C1[r+3]);} \
      float rm=__builtin_fmaxf(a,b); { auto rr=__builtin_amdgcn_permlane32_swap(__float_as_uint(rm),__float_as_uint(rm),false,false); rm=__builtin_fmaxf(__uint_as_float(rr[0]),__uint_as_float(rr[1])); } \
      resc=false; \
      if(__builtin_expect(__any(rm>(float)THRL),0)){ const float dl=__builtin_fmaxf(rm,0.f); mhat+=dl; \
        _Pragma("unroll") for(int r=0;r<16;++r){C0[r]-=dl;C1[r]-=dl;} \
        negmq=Gq-mhat; \
        const float f=__builtin_amdgcn_exp2f(-dl); l_reg*=f; if(hi==0)wsf[r32]=f; resc=true; } } \
    if(GL){ BIAS_LD(P0,P1,(t)+1); } \
    SBAR(); \
    GAPB(o[0]=__builtin_amdgcn_mfma_f32_32x32x16_bf16(PAF(0),VFR(0),o[0],0,0,0), C0,0, GL,P0,0); \
    GAPB(o[1]=__builtin_amdgcn_mfma_f32_32x32x16_bf16(PAF(0),VFR(4),o[1],0,0,0), C0,4, GL,P0,4); \
    KRD(GL,0); GAPB(o[0]=__builtin_amdgcn_mfma_f32_32x32x16_bf16(PAF(1),VFR(1),o[0],0,0,0), C0,8, GL,P0,8); \
    KRD(GL,1); GAPB(o[1]=__builtin_amdgcn_mfma_f32_32x32x16_bf16(PAF(1),VFR(5),o[1],0,0,0), C0,12, GL,P0,12); \
    KRD(GL,2); GAPB(o[0]=__builtin_amdgcn_mfma_f32_32x32x16_bf16(PAF(2),VFR(2),o[0],0,0,0), C1,0, GL,P1,0); \
    KRD(GL,3); GAPB(o[1]=__builtin_amdgcn_mfma_f32_32x32x16_bf16(PAF(2),VFR(6),o[1],0,0,0), C1,4, GL,P1,4); \
    GAPB(o[0]=__builtin_amdgcn_mfma_f32_32x32x16_bf16(PAF(3),VFR(3),o[0],0,0,0), C1,8, GL,P1,8); \
    GAPB(o[1]=__builtin_amdgcn_mfma_f32_32x32x16_bf16(PAF(3),VFR(7),o[1],0,0,0), C1,12, GL,P1,12); \
    }while(0)
  int t=1;
  #undef CMASK
  #define CMASK(P0,P1,t) do{}while(0)
  for(;t+5<NT;t+=2){
    STEP(pB0,pB1,pA0,pA1,t,true,true,true);     WAIT_BAR(2); RESC(); ROT();
    STEP(pA0,pA1,pB0,pB1,t+1,true,true,true);   WAIT_BAR(2); RESC(); ROT();
  }
  #undef CMASK
  #define CMASK(P0,P1,t) do{int jb_=(t)-(NT-4); if(jb_>=0)cmask(P0,P1,jb_,qrel,hi);}while(0)
  #define ENDW(tt) do{ if((tt)+3<NT){WAIT_BAR(2);} else if((tt)+2<NT){WAIT_BAR(1);} else {WAIT_BAR(0);} }while(0)
  for(;t+1<NT;t+=2){
    STEP(pB0,pB1,pA0,pA1,t,(t+3<NT),(t+1<NT),(t+1<NT));       ENDW(t);   RESC(); ROT();
    STEP(pA0,pA1,pB0,pB1,t+1,(t+4<NT),(t+2<NT),(t+2<NT));     ENDW(t+1); RESC(); ROT();
  }
  STEP(pB0,pB1,pA0,pA1,NT-1,false,false,false); RESC();
  { float sacc=pB0[0]+pB0[1]; _Pragma("unroll") for(int r=2;r<16;++r)sacc+=pB0[r]; _Pragma("unroll") for(int r=0;r<16;++r)sacc+=pB1[r]; l_reg+=sacc;
    pw0=(u32x4){PKW(pB0,0),PKW(pB0,2),PKW(pB0,4),PKW(pB0,6)};pw1=(u32x4){PKW(pB0,8),PKW(pB0,10),PKW(pB0,12),PKW(pB0,14)};pw2=(u32x4){PKW(pB1,0),PKW(pB1,2),PKW(pB1,4),PKW(pB1,6)};pw3=(u32x4){PKW(pB1,8),PKW(pB1,10),PKW(pB1,12),PKW(pB1,14)};
    SBAR(); pv(o,vb0+sl_cur,PAF(0),PAF(1),PAF(2),PAF(3)); }
  #undef PKW
  #undef PAF
  #undef VFR
  #undef PIN
  #undef MX3
  #undef GAPA
  #undef GAPB
  #undef EX
  #undef VRD
  #undef KRD
  #undef STEP
  #undef ENDW
  {auto rr=__builtin_amdgcn_permlane32_swap(__float_as_uint(l_reg),__float_as_uint(l_reg),false,false);l_reg=__uint_as_float(rr[0])+__uint_as_float(rr[1]);}
  if(hi==0)wsf[32+r32]=l_reg;asm volatile("s_waitcnt lgkmcnt(0)":::"memory");
  float rli[16];
  #pragma unroll
  for(int r=0;r<16;++r)rli[r]=__builtin_amdgcn_rcpf(wsf[32+crow(r,hi)]);
  bf16*Ow=O+(rowbase+q0+wid*QBLK)*DM+h*D;
  { bf16*stg=(bf16*)(shm+LDS_OST)+wid*2048;
    #pragma unroll
    for(int r=0;r<16;++r){const int orow=crow(r,hi);
      #pragma unroll
      for(int d0=0;d0<2;++d0)stg[orow*64+d0*32+r32]=__float2bfloat16(o[d0][r]*rli[r]);}
    asm volatile("s_waitcnt lgkmcnt(0)":::"memory");
    #pragma unroll
    for(int i=0;i<4;++i){const int row=i*8+(lane>>3),ch=lane&7; const u32x4 v=*(const u32x4*)(stg+row*64+ch*8); ATTN_STORE16(Ow+(long)row*DM+ch*8,v);} }
  asm volatile("s_waitcnt lgkmcnt(0)\n\ts_barrier":::"memory");
  #undef DMA_K
  #undef BIAS_LD
  #undef BSUB4
  #undef BSUBALL
  #undef DMA_V
  #undef CMASK
  #undef START
  #undef RESC
  #undef ROT
}
constexpr int ATTN_LDS_BYTES=LDS_BYTES;
#undef SBAR
#undef WAIT_BAR
}
#define GAS __attribute__((address_space(1)))
#define LAS __attribute__((address_space(3)))
typedef unsigned short bf16;
typedef unsigned v4u __attribute__((ext_vector_type(4)));
typedef float f32x4 __attribute__((ext_vector_type(4)));
typedef float f32x2 __attribute__((ext_vector_type(2)));
typedef short bf16x8 __attribute__((ext_vector_type(8)));
constexpr int NWAVES = 8;
constexpr int M = 16384, D = 1024, T = 8192, FF = 2816, NGU = 5632, R = 1280, NH = 16, NQKV = 3072, NFOX = 3088;
constexpr size_t MiB = 1u << 20;
constexpr size_t WS_SS = 0;
constexpr size_t WS_LOGF = 1 * MiB;
constexpr size_t WS_LSUM = 2 * MiB;
constexpr size_t WS_WF = 5 * MiB;
constexpr size_t WS_WLG = 5 * MiB + 512 * 1024;
constexpr size_t WS_SP = 6 * MiB;
constexpr size_t WS_WGU = 8 * MiB, WGU_BYTES = 11 * MiB;
constexpr size_t WS_WD = 52 * MiB, WD_BYTES = 5 * MiB + 512 * 1024;
constexpr size_t WS_WQKV = 74 * MiB, WS_WO = 80 * MiB, WS_WLIN = 82 * MiB, WS_WLOUT = 87 * MiB;
constexpr size_t WS_XB = 90 * MiB;
constexpr size_t WS_BIG = 122 * MiB;
constexpr size_t WS_END = 218 * MiB;
constexpr int LDS_BYTES = 147456;
constexpr float LOG2E = 1.4426950408889634f;

__device__ __forceinline__ unsigned f2bf(float f) { unsigned u = __builtin_bit_cast(unsigned, f); return (u + 0x7fffu + ((u >> 16) & 1u)) >> 16; }
__device__ __forceinline__ unsigned pk2(float lo, float hi) { return f2bf(lo) | (f2bf(hi) << 16); }
__device__ __forceinline__ float bf2f(unsigned short b) { return __builtin_bit_cast(float, (unsigned)b << 16); }
__device__ __forceinline__ float wave_sum(float v) {
#pragma unroll
    for (int o = 1; o < 64; o <<= 1) v += __shfl_xor(v, o);
    return v;
}

struct Args { const float* in[21]; float* out; unsigned char* ws; int ph_lo, ph_hi; };
enum { I_X = 0, I_F1N, I_F1GU, I_F1D, I_MIXN, I_F2N, I_F2GU, I_F2D, I_FOXIN, I_FOXBF, I_FOXOUT, I_LIN, I_LCW, I_LCB, I_LWA, I_LBA, I_LWI, I_LBI, I_LLAM, I_LOUT, I_FINN };

template <bool GU> __device__ __forceinline__ void tr_item(const float* W, int ldw, int K, int nblk, const float* gain, bf16* WT, LAS float* scr, int item, int lane) {
    const int kb = item / nblk, nb = item - kb * nblk, k0 = 64 * kb, n0 = 32 * nb;
#pragma unroll 8
    for (int i = 0; i < 32; ++i) { const int kk = 2 * i + (lane >> 5); float w = W[(size_t)(k0 + kk) * ldw + n0 + (lane & 31)]; if (gain) w *= gain[k0 + kk]; scr[kk * 33 + (lane & 31)] = w; }
    asm volatile("s_waitcnt lgkmcnt(0)" ::: "memory");
    int row0 = n0;
    if (GU) { const int c = (n0 < FF) ? n0 : n0 - FF; row0 = 256 * (c >> 7) + (c & 127) + ((n0 < FF) ? 0 : 128); }
    const int c8 = lane & 7;
#pragma unroll
    for (int j = 0; j < 4; ++j) { const int n = (lane >> 3) + 8 * j; const LAS float* s = scr + (8 * c8) * 33 + n;
        v4u o; o.x = pk2(s[0 * 33], s[1 * 33]); o.y = pk2(s[2 * 33], s[3 * 33]); o.z = pk2(s[4 * 33], s[5 * 33]); o.w = pk2(s[6 * 33], s[7 * 33]);
        *(v4u*)(WT + (size_t)(row0 + n) * K + k0 + 8 * c8) = o; }
    asm volatile("s_waitcnt lgkmcnt(0)" ::: "memory");
}

template <class Epi> __device__ __forceinline__ void run_gemm(LAS unsigned char* lds, const bf16* A, const bf16* Bt, int N, int K, const Epi& E) {
    pg8::Gemm g{A, Bt, M, N, K}; pg8::StaticOrder S; S.init(M, N, osgpr((int)gridDim.x), osgpr((int)blockIdx.x));
    pg8::gemm_phase<Epi, pg8::StaticOrder, PG8_ALIGN, PG8_SP2>(lds, g, S, E);
}

template <bool PASSB> __device__ __forceinline__ void lru_phase(LAS unsigned char* L, const Args& args, int vcu, int G, int tid) {
    const int lane = tid & 63, wave = __builtin_amdgcn_readfirstlane(tid >> 6), fr = lane & 15, fq = lane >> 4;
    LAS bf16* Wt = (LAS bf16*)(L);
    LAS bf16* xcb = (LAS bf16*)(L + 33280);
    LAS float* xcf = (LAS float*)(L + 46592);
    LAS float* Aa = (LAS float*)(L + 67072);
    LAS float* Bb = (LAS float*)(L + 87552);
    LAS bf16* recs = (LAS bf16*)(L + 108032);
    LAS float* sub = (LAS float*)(L + 118752);
    LAS float* carry = (LAS float*)(L + 121312);
    LAS float* cst = (LAS float*)(L + 121632);
    unsigned char* ws = args.ws;
    const bf16* Wg = (const bf16*)(ws + WS_WLG); const float* sp = (const float*)(ws + WS_SP);
    bf16* GATE = (bf16*)(ws + WS_BIG); const bf16* REC = (const bf16*)(ws + WS_BIG + 40 * MiB);
    f32x2* SUM = (f32x2*)(ws + WS_LSUM);
    const int n = vcu & 15;
    for (int p = tid; p < 1920; p += 512) { const int row = p / 12, pc = p - row * 12; *(LAS v4u*)(Wt + row * 104 + pc * 8) = *(const v4u*)(Wg + (size_t)(n * 160 + row) * 96 + pc * 8); }
    if (tid < 128) { const int row = tid >> 1, pc = tid & 1; unsigned z = 0u; asm volatile("" : "+v"(z)); *(LAS v4u*)(xcb + row * 104 + 80 + pc * 8) = (v4u){z, z, z, z}; }
    if (tid < 80) { const int c = n * 80 + tid;
        cst[0 * 80 + tid] = args.in[I_LCW][0 * R + c]; cst[1 * 80 + tid] = args.in[I_LCW][1 * R + c]; cst[2 * 80 + tid] = args.in[I_LCW][2 * R + c]; cst[3 * 80 + tid] = args.in[I_LCW][3 * R + c];
        cst[4 * 80 + tid] = args.in[I_LCB][c]; cst[5 * 80 + tid] = args.in[I_LBA][c]; cst[6 * 80 + tid] = args.in[I_LBI][c]; cst[7 * 80 + tid] = sp[c]; }
    __syncthreads();
    float hc = 0.f; int jprev = 0, bprev = 0;
    for (int u = vcu >> 4; u < 256; u += (G >> 4)) {
        const int b = u >> 7, j = u & 127, t0 = j * 64; const size_t rowg0 = (size_t)b * T + t0;
        for (int p = tid; p < 670; p += 512) { const int rr = p / 10, pc = p - rr * 10, tok = t0 - 3 + rr; unsigned z = 0u; asm volatile("" : "+v"(z)); v4u v = (v4u){z, z, z, z};
            if (tok >= 0) v = *(const v4u*)(REC + ((size_t)b * T + tok) * R + n * 80 + pc * 8);
            *(LAS v4u*)(recs + rr * 80 + pc * 8) = v; }
        if (PASSB && tid < 80) {
            if (b != bprev) { hc = 0.f; jprev = 0; bprev = b; }
            const f32x2* S = SUM + ((size_t)b * 128) * R + n * 80 + tid;
#pragma unroll 8
            for (int jj = jprev; jj < j; ++jj) { const f32x2 ab = S[(size_t)jj * R]; hc = ab.x * hc + ab.y; }
            jprev = j; carry[tid] = hc; }
        __syncthreads();
#pragma unroll
        for (int i = 0; i < 10; ++i) { const int idx = tid + 512 * i, t = idx / 80, c = idx - t * 80;
            float x = cst[4 * 80 + c];
#pragma unroll
            for (int jj = 0; jj < 4; ++jj) x += cst[jj * 80 + c] * bf2f(recs[(t + jj) * 80 + c]);
            xcf[t * 80 + c] = x; xcb[t * 104 + c] = (bf16)f2bf(x); }
        __syncthreads();
        { const int mt = wave & 3, ct0 = (wave >> 2) ? 3 : 0, ct1 = (wave >> 2) ? 5 : 3, tok = 16 * mt + fr;
            for (int ct = ct0; ct < ct1; ++ct) { f32x4 ga = (f32x4){0.f, 0.f, 0.f, 0.f}, gi = ga;
#pragma unroll
                for (int kk = 0; kk < 3; ++kk) { const bf16x8 xf = *(const LAS bf16x8*)(xcb + tok * 104 + 32 * kk + 8 * fq);
                    const bf16x8 wa = *(const LAS bf16x8*)(Wt + (16 * ct + fr) * 104 + 32 * kk + 8 * fq), wi = *(const LAS bf16x8*)(Wt + (80 + 16 * ct + fr) * 104 + 32 * kk + 8 * fq);
                    ga = __builtin_amdgcn_mfma_f32_16x16x32_bf16(wa, xf, ga, 0, 0, 0); gi = __builtin_amdgcn_mfma_f32_16x16x32_bf16(wi, xf, gi, 0, 0, 0); }
                const int ch0 = 16 * ct + 4 * fq; const f32x4 xv = *(const LAS f32x4*)(xcf + tok * 80 + ch0); f32x4 av, bv;
#pragma unroll
                for (int e = 0; e < 4; ++e) { const int ch = ch0 + e;
                    const float r = 1.0f / (1.0f + __expf(-(ga[e] + cst[5 * 80 + ch]))), ig = 1.0f / (1.0f + __expf(-(gi[e] + cst[6 * 80 + ch])));
                    const float la = -8.0f * r * cst[7 * 80 + ch]; av[e] = expf(la); bv[e] = sqrtf(-expm1f(2.0f * la)) * (ig * xv[e]); }
                *(LAS f32x4*)(Aa + tok * 80 + ch0) = av; *(LAS f32x4*)(Bb + tok * 80 + ch0) = bv; } }
        __syncthreads();
        const int ch = tid % 80, s = tid / 80;
        if (tid < 320) { float Ap = 1.f, Bp = 0.f;
#pragma unroll
            for (int tt = 0; tt < 16; ++tt) { const int t = 16 * s + tt; const float a = Aa[t * 80 + ch], bb = Bb[t * 80 + ch]; Ap *= a; Bp = a * Bp + bb; }
            sub[(s * 80 + ch) * 2] = Ap; sub[(s * 80 + ch) * 2 + 1] = Bp; }
        __syncthreads();
        if (!PASSB) {
            if (tid < 80) { float Ap = 1.f, Bp = 0.f;
#pragma unroll
                for (int s2 = 0; s2 < 4; ++s2) { const float a = sub[(s2 * 80 + tid) * 2], bb = sub[(s2 * 80 + tid) * 2 + 1]; Ap *= a; Bp = a * Bp + bb; }
                SUM[((size_t)b * 128 + j) * R + n * 80 + tid] = (f32x2){Ap, Bp}; }
        } else {
            if (tid < 320) { float h = carry[ch];
                for (int s2 = 0; s2 < s; ++s2) h = sub[(s2 * 80 + ch) * 2] * h + sub[(s2 * 80 + ch) * 2 + 1];
#pragma unroll
                for (int tt = 0; tt < 16; ++tt) { const int t = 16 * s + tt; h = Aa[t * 80 + ch] * h + Bb[t * 80 + ch]; Bb[t * 80 + ch] = h; } }
            __syncthreads();
            for (int p = tid; p < 640; p += 512) { const int t = p / 10, pc = p - t * 10;
                const f32x4 h0 = *(const LAS f32x4*)(Bb + t * 80 + pc * 8), h1 = *(const LAS f32x4*)(Bb + t * 80 + pc * 8 + 4);
                bf16* gp = GATE + (rowg0 + t) * R + n * 80 + pc * 8; const v4u gv = *(const v4u*)gp;
                v4u o; o.x = pk2(h0[0] * bf2f((unsigned short)(gv.x & 0xffffu)), h0[1] * bf2f((unsigned short)(gv.x >> 16))); o.y = pk2(h0[2] * bf2f((unsigned short)(gv.y & 0xffffu)), h0[3] * bf2f((unsigned short)(gv.y >> 16)));
                o.z = pk2(h1[0] * bf2f((unsigned short)(gv.z & 0xffffu)), h1[1] * bf2f((unsigned short)(gv.z >> 16))); o.w = pk2(h1[2] * bf2f((unsigned short)(gv.w & 0xffffu)), h1[3] * bf2f((unsigned short)(gv.w >> 16)));
                *(v4u*)gp = o; }
        }
        __syncthreads();
    }
}

__device__ __forceinline__ void p0_prologue(LAS unsigned char* lds, const Args& args, int vcu, int G, int tid) {
    const int lane = tid & 63, wave = __builtin_amdgcn_readfirstlane(tid >> 6);
    unsigned char* ws = args.ws;
    LAS float* scr = (LAS float*)(lds + wave * 16384);
    const int gw = vcu * NWAVES + wave, NGW = G * NWAVES;
    constexpr int I_GU = (D / 64) * (NGU / 32), I_DN = (FF / 64) * (D / 32), I_QKV = (D / 64) * (NQKV / 32), I_WO = (D / 64) * (D / 32), I_LI = (D / 64) * (2 * R / 32), I_LO = (R / 64) * (D / 32);
    constexpr int NITEMS = 4 * I_GU + 4 * I_DN + I_QKV + I_WO + I_LI + I_LO;
    for (int it = gw; it < NITEMS; it += NGW) {
        int r = it;
        if (r < 4 * I_GU) { const int f = r / I_GU; r -= f * I_GU; const int layer = f >> 1;
            const float* W = ((f & 1) ? args.in[I_F2GU] : args.in[I_F1GU]) + (size_t)layer * D * NGU; const float* gn = ((f & 1) ? args.in[I_F2N] : args.in[I_F1N]) + layer * D;
            tr_item<true>(W, NGU, D, NGU / 32, gn, (bf16*)(ws + WS_WGU + f * WGU_BYTES), scr, r, lane); continue; }
        r -= 4 * I_GU;
        if (r < 4 * I_DN) { const int f = r / I_DN; r -= f * I_DN; const int layer = f >> 1;
            const float* W = ((f & 1) ? args.in[I_F2D] : args.in[I_F1D]) + (size_t)layer * FF * D;
            tr_item<false>(W, D, FF, D / 32, nullptr, (bf16*)(ws + WS_WD + f * WD_BYTES), scr, r, lane); continue; }
        r -= 4 * I_DN;
        if (r < I_QKV) { tr_item<false>(args.in[I_FOXIN], NFOX, D, NQKV / 32, args.in[I_MIXN], (bf16*)(ws + WS_WQKV), scr, r, lane); continue; }
        r -= I_QKV;
        if (r < I_WO) { tr_item<false>(args.in[I_FOXOUT], D, D, D / 32, nullptr, (bf16*)(ws + WS_WO), scr, r, lane); continue; }
        r -= I_WO;
        if (r < I_LI) { tr_item<false>(args.in[I_LIN], 2 * R, D, 2 * R / 32, args.in[I_MIXN] + D, (bf16*)(ws + WS_WLIN), scr, r, lane); continue; }
        r -= I_LI;
        tr_item<false>(args.in[I_LOUT], D, R, D / 32, nullptr, (bf16*)(ws + WS_WLOUT), scr, r, lane);
    }
    const int gt = vcu * 512 + tid, NGT = G * 512;
    { bf16* wf = (bf16*)(ws + WS_WF);
        for (int i = gt; i < NH * D; i += NGT) { const int h = i >> 10, k = i & 1023; wf[i] = (bf16)f2bf(args.in[I_MIXN][k] * args.in[I_FOXIN][(size_t)k * NFOX + NQKV + h]); } }
    { bf16* wg = (bf16*)(ws + WS_WLG);
        for (int i = gt; i < 16 * 160 * 96; i += NGT) { const int k = i % 96, dd = (i / 96) % 160, n = i / (96 * 160); float v = 0.f;
            if (k < 80) v = (dd < 80) ? args.in[I_LWA][((size_t)n * 80 + k) * 80 + dd] : args.in[I_LWI][((size_t)n * 80 + k) * 80 + (dd - 80)];
            wg[i] = (bf16)f2bf(v); } }
    { float* sp = (float*)(ws + WS_SP); for (int i = gt; i < R; i += NGT) sp[i] = log1pf(expf(-args.in[I_LLAM][i])); }
    { float* ss = (float*)(ws + WS_SS); for (int i = gt; i < 7 * M; i += NGT) ss[M + i] = 0.f; }
    { float* ss0 = (float*)(ws + WS_SS); bf16* xb = (bf16*)(ws + WS_XB); const float* x = args.in[I_X];
        for (int m = gw; m < M; m += NGW) { const f32x4* xr = (const f32x4*)(x + (size_t)m * D) + lane; f32x4 v[4]; float s = 0.f;
#pragma unroll
            for (int j = 0; j < 4; ++j) { v[j] = xr[64 * j]; s += (v[j].x * v[j].x + v[j].y * v[j].y) + (v[j].z * v[j].z + v[j].w * v[j].w); }
            s = wave_sum(s); if (lane == 0) ss0[m] = s;
            unsigned long long* o8 = (unsigned long long*)(xb + (size_t)m * D) + lane;
#pragma unroll
            for (int j = 0; j < 4; ++j) o8[64 * j] = (unsigned long long)pk2(v[j].x, v[j].y) | ((unsigned long long)pk2(v[j].z, v[j].w) << 32); } }
}

__device__ __forceinline__ void flogit_phase(const Args& args, int vcu, int G, int tid) {
    const int lane = tid & 63, wave = __builtin_amdgcn_readfirstlane(tid >> 6), fr = lane & 15, fq = lane >> 4;
    unsigned char* ws = args.ws; const bf16* xb = (const bf16*)(ws + WS_XB); const bf16* wf = (const bf16*)(ws + WS_WF); const float* ss = (const float*)(ws + WS_SS) + 1 * M; float* logf_ = (float*)(ws + WS_LOGF);
    const int gw = vcu * NWAVES + wave, NGW = G * NWAVES;
    for (int grp = gw; grp < M / 16; grp += NGW) { const int row0 = grp * 16;
        const bf16* xa = xb + (size_t)(row0 + fr) * D + 8 * fq; const bf16* wb = wf + (size_t)fr * D + 8 * fq; f32x4 acc = (f32x4){0.f, 0.f, 0.f, 0.f};
#pragma unroll 8
        for (int kk = 0; kk < 32; ++kk) { const bf16x8 xf = *(const bf16x8*)(xa + 32 * kk), wv = *(const bf16x8*)(wb + 32 * kk); acc = __builtin_amdgcn_mfma_f32_16x16x32_bf16(wv, xf, acc, 0, 0, 0); }
        const int row = row0 + fr, b = row >> 13, t = row & (T - 1); const float rs = pg8::rstd_row(ss, row);
#pragma unroll
        for (int e = 0; e < 4; ++e) { const int h = 4 * fq + e; const float z = acc[e] * rs + args.in[I_FOXBF][h];
            const float lf = fminf(z, 0.f) - log1pf(expf(-fabsf(z))); logf_[(size_t)(b * NH + h) * T + t] = lf * LOG2E; } }
}

__device__ __forceinline__ void attn_cumsum(const float* lf, LAS float* Gl, LAS float* wsum, int tid) {
    const int lane = tid & 63, wave = tid >> 6; f32x4 v[4];
#pragma unroll
    for (int j = 0; j < 4; ++j) v[j] = *(const f32x4*)(lf + tid * 16 + 4 * j);
    float run = 0.f;
#pragma unroll
    for (int j = 0; j < 4; ++j) { run += v[j].x; v[j].x = run; run += v[j].y; v[j].y = run; run += v[j].z; v[j].z = run; run += v[j].w; v[j].w = run; }
    float incl = run;
#pragma unroll
    for (int o = 1; o < 64; o <<= 1) { const float nb = __shfl_up(incl, o); if (lane >= o) incl += nb; }
    if (lane == 63) wsum[wave] = incl;
    __syncthreads();
    float base = incl - run;
    for (int w = 0; w < wave; ++w) base += wsum[w];
#pragma unroll
    for (int j = 0; j < 4; ++j) *(LAS f32x4*)(Gl + tid * 16 + 4 * j) = v[j] + base;
    __syncthreads();
}

constexpr int N_PHASES = 17;
#ifndef ONLY_KIND
#define ONLY_KIND -1
#endif
#define KON(k) (ONLY_KIND < 0 || ONLY_KIND == (k))
__global__ void __launch_bounds__(NWAVES * 64, 2) fwd_megakernel(Args args) {
    extern __shared__ __attribute__((aligned(16))) unsigned char lds_raw[];
    LAS unsigned char* lds = (LAS unsigned char*)lds_raw;
    cg::grid_group grid = cg::this_grid();
    unsigned char* ws = args.ws;
    float* ssb = (float*)(ws + WS_SS); bf16* XB = (bf16*)(ws + WS_XB);
    bf16* HB = (bf16*)(ws + WS_BIG); bf16* QB_ = (bf16*)(ws + WS_BIG); bf16* KB = (bf16*)(ws + WS_BIG + 32 * MiB); bf16* VB = (bf16*)(ws + WS_BIG + 64 * MiB);
    bf16* GATE = (bf16*)(ws + WS_BIG); bf16* REC = (bf16*)(ws + WS_BIG + 40 * MiB);
    for (int ph = args.ph_lo; ph < args.ph_hi; ++ph) {
        const int tid = otid(), G = osgpr((int)gridDim.x), bx = osgpr((int)blockIdx.x);
        const int vcu = (G % 8 == 0) ? (bx % 8) * (G / 8) + bx / 8 : bx;
        int kind = 0, f = 0, ssi = 0; const bf16* A = XB; const bf16* Bt = nullptr; int K = D; const float* xin = args.out; float alpha = 1.f;
        switch (ph) {
            case 0: kind = 0; break;
            case 1: kind = 1; f = 0; ssi = 0; break;
            case 2: kind = 2; A = HB; Bt = (const bf16*)(ws + WS_WD + 0 * WD_BYTES); K = FF; xin = args.in[I_X]; alpha = 0.5f; ssi = 1; break;
            case 3: kind = 3; break;
            case 4: kind = 4; break;
            case 5: kind = 2; A = QB_; Bt = (const bf16*)(ws + WS_WO); K = D; alpha = 1.f; ssi = 2; break;
            case 6: kind = 1; f = 1; ssi = 2; break;
            case 7: kind = 2; A = HB; Bt = (const bf16*)(ws + WS_WD + 1 * WD_BYTES); K = FF; alpha = 0.5f; ssi = 3; break;
            case 8: kind = 1; f = 2; ssi = 3; break;
            case 9: kind = 2; A = HB; Bt = (const bf16*)(ws + WS_WD + 2 * WD_BYTES); K = FF; alpha = 0.5f; ssi = 4; break;
            case 10: kind = 5; break;
            case 11: kind = 6; break;
            case 12: kind = 7; break;
            case 13: kind = 2; A = GATE; Bt = (const bf16*)(ws + WS_WLOUT); K = R; alpha = 1.f; ssi = 5; break;
            case 14: kind = 1; f = 3; ssi = 5; break;
            case 15: kind = 2; A = HB; Bt = (const bf16*)(ws + WS_WD + 3 * WD_BYTES); K = FF; alpha = 0.5f; ssi = 6; break;
            default: kind = 8; break;
        }
        if (KON(0) && kind == 0) { p0_prologue(lds, args, vcu, G, tid); }
        else if (KON(1) && kind == 1) { pg8::EpiSwiGLU E{HB, ssb + (size_t)ssi * M}; run_gemm(lds, XB, (const bf16*)(ws + WS_WGU + f * WGU_BYTES), NGU, D, E); }
        else if (KON(2) && kind == 2) { pg8::EpiResid E{xin, args.out, XB, ssb + (size_t)ssi * M, alpha}; run_gemm(lds, A, Bt, D, K, E); }
        else if (KON(3) && kind == 3) { pg8::EpiQKV E{QB_, (size_t)M * D, ssb + 1 * M, attn_body::C2}; run_gemm(lds, XB, (const bf16*)(ws + WS_WQKV), NQKV, D, E); flogit_phase(args, vcu, G, tid); }
        else if (KON(4) && kind == 4) {
            LAS float* Gl = (LAS float*)(lds + 86016); LAS float* wsum = (LAS float*)(lds + 86016 + 32768);
            for (int item = vcu; item < 256; item += G) { const int bh = item >> 3, s = item & 7;
                attn_cumsum((const float*)(ws + WS_LOGF) + (size_t)bh * T, Gl, wsum, tid);
                for (int i = 0; i < 4; ++i) { const int qb = (i == 0) ? s : (i == 1) ? 15 - s : (i == 2) ? 16 + s : 31 - s;
                    attn_body::attn_unit<8>(bh >> 4, bh & 15, qb, (const attn_body::bf16*)QB_, (const attn_body::bf16*)KB, (const attn_body::bf16*)VB, (attn_body::bf16*)QB_, (char*)lds_raw, (attn_body::lds_fptr)Gl); }
                __syncthreads(); }
        }
        else if (KON(5) && kind == 5) { pg8::EpiLruIn E{GATE, REC, ssb + 4 * M}; run_gemm(lds, XB, (const bf16*)(ws + WS_WLIN), 2 * R, D, E); }
        else if (KON(6) && kind == 6) { lru_phase<false>(lds, args, vcu, G, tid); }
        else if (KON(7) && kind == 7) { lru_phase<true>(lds, args, vcu, G, tid); }
        else if (KON(8)) { const int lane = tid & 63, wave = tid >> 6, gw = vcu * NWAVES + wave, NGW = G * NWAVES; const float* ss = ssb + 6 * M; const f32x4* gn = (const f32x4*)args.in[I_FINN] + lane;
            for (int m = gw; m < M; m += NGW) { const float rs = pg8::rstd_row(ss, m); f32x4* xr = (f32x4*)(args.out + (size_t)m * D) + lane;
#pragma unroll
                for (int j = 0; j < 4; ++j) { const f32x4 v = xr[64 * j]; xr[64 * j] = v * rs * gn[64 * j]; } } }
        if (ph + 1 < args.ph_hi) grid.sync();
    }
}

#ifndef MK_PER_PHASE_LAUNCH
#define MK_PER_PHASE_LAUNCH 0
#endif
extern "C" void kernel_launch(void* const* d_in, const int* in_sizes, int n_in, void* d_out, int out_size, void* d_ws, size_t ws_size, hipStream_t stream) {
    static int grid = 0;
    if (grid == 0) {
        if (n_in != 21 || in_sizes[0] != M * D || out_size != M * D || ws_size < WS_END) { fprintf(stderr, "kernel_launch: unexpected shapes (n_in %d, in0 %d, out %d, ws %zu); nothing launched\n", n_in, n_in > 0 ? in_sizes[0] : -1, out_size, ws_size); grid = -1; return; }
        int dev = 0, cus = 0, per_cu = 0;
        if (hipGetDevice(&dev) != hipSuccess || hipDeviceGetAttribute(&cus, hipDeviceAttributeMultiprocessorCount, dev) != hipSuccess) { grid = -1; return; }
        if (hipFuncSetAttribute((const void*)fwd_megakernel, hipFuncAttributeMaxDynamicSharedMemorySize, LDS_BYTES) != hipSuccess) { fprintf(stderr, "kernel_launch: hipFuncSetAttribute failed\n"); grid = -1; return; }
        if (hipOccupancyMaxActiveBlocksPerMultiprocessor(&per_cu, (const void*)fwd_megakernel, NWAVES * 64, LDS_BYTES) != hipSuccess || per_cu < 1) { fprintf(stderr, "kernel_launch: occupancy query says %d blocks per CU\n", per_cu); per_cu = 1; }
        (void)hipGetLastError();
        grid = cus * per_cu;
        if (grid != 256) fprintf(stderr, "kernel_launch: grid %d (this kernel's static unit orders assume 256 workgroups)\n", grid);
    }
    if (grid < 0) return;
    Args a{};
    for (int i = 0; i < 21; ++i) a.in[i] = (const float*)d_in[i];
    a.out = (float*)d_out; a.ws = (unsigned char*)d_ws;
#if MK_PER_PHASE_LAUNCH
    for (int ph = 0; ph < N_PHASES; ++ph) { a.ph_lo = ph; a.ph_hi = ph + 1; hipLaunchKernelGGL(fwd_megakernel, dim3(grid), dim3(NWAVES * 64), LDS_BYTES, stream, a); }
#else
    a.ph_lo = 0; a.ph_hi = N_PHASES;
    void* kargs[] = {&a};
    const hipError_t e = hipLaunchCooperativeKernel((const void*)fwd_megakernel, dim3(grid), dim3(NWAVES * 64), kargs, LDS_BYTES, stream);
    if (e != hipSuccess) fprintf(stderr, "kernel_launch: cooperative launch failed: %s (grid %d)\n", hipGetErrorString(e), grid);
#endif
}
```

```cpp
#define DUP_PH -1
#define DUP_SYNC 0
#include <hip/hip_runtime.h>
#include <hip/hip_cooperative_groups.h>
#include <cstdio>
#include <cstdint>
namespace cg = cooperative_groups;
__device__ __forceinline__ int otid() { int t = (int)threadIdx.x; asm volatile("" : "+v"(t)); return t; }
__device__ __forceinline__ int osgpr(int v) { v = __builtin_amdgcn_readfirstlane(v); asm volatile("" : "+s"(v)); return v; }
namespace pg8 {
#define PG8_LAS __attribute__((address_space(3)))
typedef unsigned short bf16_t;
typedef short bf16x8 __attribute__((ext_vector_type(8)));
typedef float f32x4 __attribute__((ext_vector_type(4)));
typedef unsigned u32x4 __attribute__((ext_vector_type(4)));
constexpr int BM = 256, BK = 64, HALF = 128, HTB = HALF * BK * 2  , STAGE_BYTES = 8 * HTB, NXCD = 8, WGM = 8;

__host__ __device__ __forceinline__ int lds_byte(int r, int c) { const int st = (r >> 4) * 2 + (c >> 5), rr = r & 15, cc = c & 31, ob = rr * 64 + cc * 2; return st * 1024 + (ob ^ (((ob >> 9) & 1) << 5)); }
__host__ __device__ __forceinline__ void stage_rc(int b, int& R, int& C) { const int st = b / 1024, sb = b % 1024, swz = sb ^ (((sb >> 9) & 1) << 5); R = (st >> 1) * 16 + swz / 64; C = (st & 1) * 32 + (swz % 64) / 2; }
__host__ __device__ __forceinline__ int perm32(int rho) { const int n = rho >> 4, i = rho & 15; return 8 * (i >> 2) + 4 * n + (i & 3); }

struct Unit { int pm, pn; };
struct Gemm { const bf16_t* A; const bf16_t* Bt; int M, N, K; };

struct StaticOrder {
    int nM, nN, nwg, G, c;
    __host__ __device__ void init(int M, int N, int G_, int c_) { nM = M / BM; nN = N / BM; nwg = nM * nN; G = G_; c = c_; }
    __host__ __device__ bool next(int i, Unit& u) const {
        const long L = (long)i * G + c; if (L >= nwg) return false;
        int wgid = (int)L; { const int q = nwg / NXCD, r = nwg % NXCD, xcd = wgid % NXCD, off = wgid / NXCD; wgid = (xcd < r ? xcd * (q + 1) : r * (q + 1) + (xcd - r) * q) + off; }
        const int nig = WGM * nN, gid = wgid / nig, fm = gid * WGM, gsz = (nM - fm) < WGM ? (nM - fm) : WGM;
        u.pm = fm + ((wgid % nig) % gsz); u.pn = (wgid % nig) / gsz; return true;
    }
    __device__ __forceinline__ void a_ready(const Unit&) const {}
    __device__ __forceinline__ void done(const Unit&) const {}
};

__device__ __forceinline__ unsigned cvt_pk_bf16(float lo, float hi) { unsigned r; asm volatile("v_cvt_pk_bf16_f32 %0, %1, %2" : "=v"(r) : "v"(lo), "v"(hi)); return r; }
typedef float f32x2 __attribute__((ext_vector_type(2)));
__device__ __forceinline__ f32x2 gelu_pk(f32x2 v) {
    const f32x2 av = __builtin_elementwise_abs(v), d = av * 0.2316418882f + 1.0f;
    f32x2 t; t.x = __builtin_amdgcn_rcpf(d.x); t.y = __builtin_amdgcn_rcpf(d.y);
    f32x2 q = t * 0.5307027145f + (-0.7265760135f); q = q * t + 0.7107068705f; q = q * t + (-0.142248368f); q = q * t + 0.127414796f; q = q * t;
    const f32x2 s = (v * v) * (-0.72134752044f);
    f32x2 e; e.x = __builtin_amdgcn_exp2f(s.x); e.y = __builtin_amdgcn_exp2f(s.y);
    const f32x2 m = v * (q * e), r = v - m;
    f32x2 o; o.x = v.x < 0.f ? m.x : r.x; o.y = v.y < 0.f ? m.y : r.y; return o;
}

template <int ACT  > struct EpiBf16 {
    static constexpr bool PERM = true, AFTER_DRAIN = false; static_assert(ACT == 0 || ACT == 1, "EpiBf16: ACT is 0 (none) or 1 (gelu_pk)");
    bf16_t* O; int ldc; const float* bias; int split_cols; size_t split_stride; float scale0;
    __device__ __forceinline__ void operator()(const f32x4 (&acc)[2][2][4][2], const Unit& u, int wr, int wc, int fr, int fq) const {
        const int row0 = u.pm * BM + wr * 64 + fr; int colt = u.pn * BM; bf16_t* base = O;
        float sc = 1.f; if (split_cols) { const int t = colt / split_cols; base += (size_t)t * split_stride; colt -= t * split_cols; if (t == 0) sc = scale0; }
        const int col0 = colt + wc * 32 + 8 * fq, bcol0 = u.pn * BM + wc * 32 + 8 * fq;
        f32x4 bv[2][2];
#pragma unroll
        for (int bj = 0; bj < 2; ++bj)
#pragma unroll
            for (int n = 0; n < 2; ++n) bv[bj][n] = bias ? *(const f32x4*)(bias + bcol0 + bj * HALF + 4 * n) : (f32x4){0.f, 0.f, 0.f, 0.f};
#pragma unroll
        for (int ai = 0; ai < 2; ++ai)
#pragma unroll
            for (int m = 0; m < 4; ++m) { bf16_t* rowp = base + (size_t)(row0 + ai * HALF + m * 16) * ldc + col0;
#pragma unroll
                for (int bj = 0; bj < 2; ++bj) { f32x4 v0 = acc[ai][bj][m][0] + bv[bj][0], v1 = acc[ai][bj][m][1] + bv[bj][1];
                    if (ACT == 1) { f32x2 a = gelu_pk((f32x2){v0[0], v0[1]}), b = gelu_pk((f32x2){v0[2], v0[3]}), c = gelu_pk((f32x2){v1[0], v1[1]}), d = gelu_pk((f32x2){v1[2], v1[3]});
                        v0 = (f32x4){a.x, a.y, b.x, b.y}; v1 = (f32x4){c.x, c.y, d.x, d.y}; }
                    v0 = v0 * sc; v1 = v1 * sc; u32x4 w; w.x = cvt_pk_bf16(v0[0], v0[1]); w.y = cvt_pk_bf16(v0[2], v0[3]); w.z = cvt_pk_bf16(v1[0], v1[1]); w.w = cvt_pk_bf16(v1[2], v1[3]);
                    *(u32x4*)(rowp + bj * HALF) = w; } }
    }
};

typedef unsigned u32x2 __attribute__((ext_vector_type(2)));
__device__ __forceinline__ float rstd_row(const float* ss, int row) {
    const float s = __hip_atomic_load(ss + row, __ATOMIC_RELAXED, __HIP_MEMORY_SCOPE_AGENT);
    return 1.0f / sqrtf(s * (1.0f / 1024.0f) + 1e-6f);
}
__device__ __forceinline__ float fast_sigmoid(float v) { return __builtin_amdgcn_rcpf(1.0f + __builtin_amdgcn_exp2f(-1.4426950408889634f * v)); }
struct EpiSwiGLU {
    static constexpr bool PERM = true, AFTER_DRAIN = false;
    bf16_t* H; const float* ss;
    __device__ __forceinline__ void operator()(const f32x4 (&acc)[2][2][4][2], const Unit& u, int wr, int wc, int fr, int fq) const {
        const int hc0 = u.pn * 128 + wc * 32 + 8 * fq;
#pragma unroll
        for (int ai = 0; ai < 2; ++ai)
#pragma unroll
            for (int m = 0; m < 4; ++m) { const int row = u.pm * BM + ai * HALF + wr * 64 + m * 16 + fr; const float rs = rstd_row(ss, row);
                float hv[8];
#pragma unroll
                for (int n = 0; n < 2; ++n)
#pragma unroll
                    for (int e = 0; e < 4; ++e) { const float g = acc[ai][0][m][n][e] * rs, uu = acc[ai][1][m][n][e] * rs; hv[4 * n + e] = g * fast_sigmoid(g) * uu; }
                u32x4 w; w.x = cvt_pk_bf16(hv[0], hv[1]); w.y = cvt_pk_bf16(hv[2], hv[3]); w.z = cvt_pk_bf16(hv[4], hv[5]); w.w = cvt_pk_bf16(hv[6], hv[7]);
                *(u32x4*)(H + (size_t)row * 2816 + hc0) = w; }
    }
};
struct EpiResid {
    static constexpr bool PERM = false, AFTER_DRAIN = false;
    const float* xin; float* xout; bf16_t* xb; float* ss; float alpha;
    __device__ __forceinline__ void operator()(const f32x4 (&acc)[2][2][4][2], const Unit& u, int wr, int wc, int fr, int fq) const {
        const int col0 = u.pn * BM + wc * 32 + 4 * fq;
#pragma unroll
        for (int ai = 0; ai < 2; ++ai)
#pragma unroll
            for (int m = 0; m < 4; ++m) { const int row = u.pm * BM + ai * HALF + wr * 64 + m * 16 + fr; const size_t off = (size_t)row * 1024 + col0; float s = 0.f;
#pragma unroll
                for (int bj = 0; bj < 2; ++bj)
#pragma unroll
                    for (int n = 0; n < 2; ++n) { const f32x4 xi = *(const f32x4*)(xin + off + bj * HALF + n * 16); const f32x4 o = xi + acc[ai][bj][m][n] * alpha;
                        *(f32x4*)(xout + off + bj * HALF + n * 16) = o; s += (o[0] * o[0] + o[1] * o[1]) + (o[2] * o[2] + o[3] * o[3]);
                        u32x2 w; w.x = cvt_pk_bf16(o[0], o[1]); w.y = cvt_pk_bf16(o[2], o[3]); *(u32x2*)(xb + off + bj * HALF + n * 16) = w; }
                s += __shfl_xor(s, 16); s += __shfl_xor(s, 32);
                if (fq == 0) __hip_atomic_fetch_add(ss + row, s, __ATOMIC_RELAXED, __HIP_MEMORY_SCOPE_AGENT); }
    }
};
struct EpiQKV {
    static constexpr bool PERM = true, AFTER_DRAIN = false;
    bf16_t* Q; size_t split_stride; const float* ss; float scale0;
    __device__ __forceinline__ void operator()(const f32x4 (&acc)[2][2][4][2], const Unit& u, int wr, int wc, int fr, int fq) const {
        int colt = u.pn * BM; const int t = colt >> 10; bf16_t* base = Q + (size_t)t * split_stride; colt -= t << 10; const float sc = (t == 0) ? scale0 : 1.f;
        const int col0 = colt + wc * 32 + 8 * fq;
#pragma unroll
        for (int ai = 0; ai < 2; ++ai)
#pragma unroll
            for (int m = 0; m < 4; ++m) { const int row = u.pm * BM + ai * HALF + wr * 64 + m * 16 + fr; const float rs = rstd_row(ss, row) * sc; bf16_t* rowp = base + (size_t)row * 1024 + col0;
#pragma unroll
                for (int bj = 0; bj < 2; ++bj) { const f32x4 v0 = acc[ai][bj][m][0] * rs, v1 = acc[ai][bj][m][1] * rs;
                    u32x4 w; w.x = cvt_pk_bf16(v0[0], v0[1]); w.y = cvt_pk_bf16(v0[2], v0[3]); w.z = cvt_pk_bf16(v1[0], v1[1]); w.w = cvt_pk_bf16(v1[2], v1[3]);
                    *(u32x4*)(rowp + bj * HALF) = w; } }
    }
};
__device__ __forceinline__ float gelu_tanh(float v) { const float u2 = 1.5957691216057308f * (v + 0.044715f * v * v * v); return v * fast_sigmoid(u2); }
struct EpiLruIn {
    static constexpr bool PERM = true, AFTER_DRAIN = false;
    bf16_t* GATE; bf16_t* REC; const float* ss;
    __device__ __forceinline__ void operator()(const f32x4 (&acc)[2][2][4][2], const Unit& u, int wr, int wc, int fr, int fq) const {
        const bool isg = u.pn < 5; bf16_t* base = isg ? GATE : REC; const int col0 = (isg ? u.pn : u.pn - 5) * BM + wc * 32 + 8 * fq;
#pragma unroll
        for (int ai = 0; ai < 2; ++ai)
#pragma unroll
            for (int m = 0; m < 4; ++m) { const int row = u.pm * BM + ai * HALF + wr * 64 + m * 16 + fr; const float rs = rstd_row(ss, row); bf16_t* rowp = base + (size_t)row * 1280 + col0;
#pragma unroll
                for (int bj = 0; bj < 2; ++bj) { f32x4 v0 = acc[ai][bj][m][0] * rs, v1 = acc[ai][bj][m][1] * rs;
                    if (isg) {
#pragma unroll
                        for (int e = 0; e < 4; ++e) { v0[e] = gelu_tanh(v0[e]); v1[e] = gelu_tanh(v1[e]); } }
                    u32x4 w; w.x = cvt_pk_bf16(v0[0], v0[1]); w.y = cvt_pk_bf16(v0[2], v0[3]); w.z = cvt_pk_bf16(v1[0], v1[1]); w.w = cvt_pk_bf16(v1[2], v1[3]);
                    *(u32x4*)(rowp + bj * HALF) = w; } }
    }
};
template <class Epi, class Sched, bool ALIGN_EPI = false, bool SP2 = false>
__device__ __forceinline__ void gemm_phase(PG8_LAS unsigned char* lds, const Gemm g, const Sched& S, const Epi& E) {
    const int tid = otid(), wid = __builtin_amdgcn_readfirstlane(tid >> 6), lane = tid & 63, wr = wid >> 2, wc = wid & 3, fr = lane & 15, fq = lane >> 4;
    const int K = g.K, nt = K / BK;
    unsigned voffA[2], voffB[2];
#pragma unroll
    for (int i = 0; i < 2; ++i) { int R, C; stage_rc(tid * 16 + i * 8192, R, C); const int Rb = Epi::PERM ? ((R & ~31) + perm32(R & 31)) : R;
        voffA[i] = (unsigned)(R * K + C) * 2u; voffB[i] = (unsigned)(Rb * K + C) * 2u; }
    const size_t kstep = (size_t)(BK * 2);
    const size_t hstep = (size_t)HALF * K * 2;
    const size_t tstep = 2 * hstep;
    const unsigned ldsw = (unsigned)wid * 1024u;
    const int aoff = lds_byte(wr * 64 + fr, fq * 8), boff = lds_byte(wc * 32 + fr, fq * 8);
#define PG8_SA(b, h) (((b) * 2 + (h)) * HTB)
#define PG8_SB(b, h) ((4 + (b) * 2 + (h)) * HTB)
#define PG8_STAGE(bufoff, gbase, voff) do { _Pragma("unroll") for (int _i = 0; _i < 2; ++_i) \
        __builtin_amdgcn_global_load_lds((const unsigned*)((const char*)(gbase) + (voff)[_i]), (PG8_LAS unsigned*)(lds + (bufoff) + ldsw + _i * 8192), 16, 0, 0); } while (0)
#define PG8_LDA(dst, b, h) do { _Pragma("unroll") for (int m = 0; m < 4; ++m) _Pragma("unroll") for (int k = 0; k < 2; ++k) dst[m][k] = *(const PG8_LAS bf16x8*)(lds + PG8_SA(b, h) + aoff + m * 2048 + k * 1024); } while (0)
#define PG8_LDB(dst, b, h) do { _Pragma("unroll") for (int n = 0; n < 2; ++n) _Pragma("unroll") for (int k = 0; k < 2; ++k) dst[n][k] = *(const PG8_LAS bf16x8*)(lds + PG8_SB(b, h) + boff + n * 2048 + k * 1024); } while (0)
#define PG8_MMA(ai, bj, At, Bt) do { __builtin_amdgcn_s_setprio(1); _Pragma("unroll") for (int m = 0; m < 4; ++m) _Pragma("unroll") for (int n = 0; n < 2; ++n) _Pragma("unroll") for (int k = 0; k < 2; ++k) \
        acc[ai][bj][m][n] = __builtin_amdgcn_mfma_f32_16x16x32_bf16(Bt[n][k], At[m][k], acc[ai][bj][m][n], 0, 0, 0); __builtin_amdgcn_s_setprio(0); } while (0)
#define PG8_WAIT_V(n) asm volatile("s_waitcnt vmcnt(" #n ")" ::: "memory")
#define PG8_WAIT_L(n) asm volatile("s_waitcnt lgkmcnt(" #n ")" ::: "memory")
#define PG8_BAR __builtin_amdgcn_s_barrier()
#define PG8_SCHED __builtin_amdgcn_sched_barrier(0)
    Unit cur, nxt; int ui = 0;
    if (!S.next(0, cur)) return;
    f32x4 acc[2][2][4][2];
#pragma unroll
    for (int a = 0; a < 2; ++a)
#pragma unroll
        for (int b = 0; b < 2; ++b)
#pragma unroll
            for (int m = 0; m < 4; ++m)
#pragma unroll
                for (int n = 0; n < 2; ++n) acc[a][b][m][n] = (f32x4){0.f, 0.f, 0.f, 0.f};
    bf16x8 At[4][2], B0[2][2], B1[2][2];
    const char* cA = (const char*)g.A + (size_t)cur.pm * tstep; const char* cB = (const char*)g.Bt + (size_t)cur.pn * tstep;
    S.a_ready(cur);
    if constexpr (SP2) {
        PG8_STAGE(PG8_SB(0, 0), cB, voffB); PG8_STAGE(PG8_SB(0, 1), cB + hstep, voffB); PG8_STAGE(PG8_SA(0, 0), cA, voffA); PG8_STAGE(PG8_SA(0, 1), cA + hstep, voffA);
        if (wr == 1) PG8_BAR;
        PG8_WAIT_V(2); PG8_BAR;
        PG8_STAGE(PG8_SB(1, 0), cB + kstep, voffB); PG8_STAGE(PG8_SA(1, 0), cA + kstep, voffA); PG8_STAGE(PG8_SB(1, 1), cB + hstep + kstep, voffB);
        PG8_WAIT_V(6); PG8_BAR;
    } else {
        PG8_STAGE(PG8_SB(0, 0), cB, voffB); PG8_STAGE(PG8_SA(0, 0), cA, voffA); PG8_STAGE(PG8_SB(0, 1), cB + hstep, voffB); PG8_STAGE(PG8_SA(0, 1), cA + hstep, voffA);
        if (wr == 1) PG8_BAR;
        PG8_WAIT_V(4); PG8_BAR;
        PG8_STAGE(PG8_SB(1, 0), cB + kstep, voffB); PG8_STAGE(PG8_SA(1, 0), cA + kstep, voffA); PG8_STAGE(PG8_SB(1, 1), cB + hstep + kstep, voffB);
        PG8_WAIT_V(6); PG8_BAR;
    }
    for (;;) {
        const bool has_next = S.next(ui + 1, nxt);
        const char* nA = has_next ? (const char*)g.A + (size_t)nxt.pm * tstep : cA; const char* nB = has_next ? (const char*)g.Bt + (size_t)nxt.pn * tstep : cB;
        for (int t = 0; t < nt; t += 2) {
            const bool last = (t == nt - 2);
            const char* a1 = cA + (size_t)(t + 1) * kstep;
            const char* a2 = last ? nA : cA + (size_t)(t + 2) * kstep; const char* b2 = last ? nB : cB + (size_t)(t + 2) * kstep;
            const char* a3 = a2 + kstep; const char* b3 = b2 + kstep;
            if (last && has_next) S.a_ready(nxt);
            if constexpr (SP2) {
            PG8_LDB(B0, 0, 0); PG8_LDB(B1, 0, 1); PG8_SCHED; PG8_LDA(At, 0, 0); PG8_STAGE(PG8_SA(1, 1), a1 + hstep, voffA);
            PG8_WAIT_V(8); PG8_WAIT_L(0); PG8_BAR; PG8_MMA(0, 0, At, B0); PG8_MMA(0, 1, At, B1); PG8_BAR; PG8_SCHED;
            PG8_LDA(At, 0, 1); PG8_STAGE(PG8_SB(0, 0), b2, voffB); PG8_STAGE(PG8_SB(0, 1), b2 + hstep, voffB); PG8_STAGE(PG8_SA(0, 0), a2, voffA);
            PG8_WAIT_V(8); PG8_WAIT_L(0); PG8_BAR; PG8_MMA(1, 0, At, B0); PG8_MMA(1, 1, At, B1); PG8_BAR; PG8_SCHED;
            PG8_LDB(B0, 1, 0); PG8_LDB(B1, 1, 1); PG8_SCHED; PG8_LDA(At, 1, 0); PG8_STAGE(PG8_SA(0, 1), a2 + hstep, voffA);
            PG8_WAIT_V(8); PG8_WAIT_L(0); PG8_BAR; PG8_MMA(0, 0, At, B0); PG8_MMA(0, 1, At, B1); PG8_BAR; PG8_SCHED;
            PG8_LDA(At, 1, 1); PG8_STAGE(PG8_SB(1, 0), b3, voffB); PG8_STAGE(PG8_SB(1, 1), b3 + hstep, voffB); PG8_STAGE(PG8_SA(1, 0), a3, voffA);
            PG8_WAIT_V(8); PG8_WAIT_L(0); PG8_BAR; PG8_MMA(1, 0, At, B0); PG8_MMA(1, 1, At, B1); PG8_BAR; PG8_SCHED;
            } else {
            PG8_LDB(B0, 0, 0); PG8_SCHED; PG8_LDA(At, 0, 0); PG8_STAGE(PG8_SA(1, 1), a1 + hstep, voffA);
            PG8_WAIT_L(8); PG8_BAR; PG8_WAIT_L(0); PG8_MMA(0, 0, At, B0); PG8_BAR; PG8_SCHED;
            PG8_LDB(B1, 0, 1); PG8_STAGE(PG8_SB(0, 0), b2, voffB);
            PG8_BAR; PG8_WAIT_L(0); PG8_MMA(0, 1, At, B1); PG8_BAR;
            PG8_LDA(At, 0, 1); PG8_STAGE(PG8_SA(0, 0), a2, voffA);
            PG8_BAR; PG8_WAIT_L(0); PG8_MMA(1, 0, At, B0); PG8_BAR; PG8_SCHED;
            PG8_STAGE(PG8_SB(0, 1), b2 + hstep, voffB);
            PG8_WAIT_V(6); PG8_BAR; PG8_MMA(1, 1, At, B1); PG8_BAR;
            PG8_LDB(B0, 1, 0); PG8_SCHED; PG8_LDA(At, 1, 0); PG8_STAGE(PG8_SA(0, 1), a2 + hstep, voffA);
            PG8_WAIT_L(8); PG8_BAR; PG8_WAIT_L(0); PG8_MMA(0, 0, At, B0); PG8_BAR; PG8_SCHED;
            PG8_LDB(B1, 1, 1); PG8_STAGE(PG8_SB(1, 0), b3, voffB);
            PG8_BAR; PG8_WAIT_L(0); PG8_MMA(0, 1, At, B1); PG8_BAR;
            PG8_LDA(At, 1, 1); PG8_STAGE(PG8_SA(1, 0), a3, voffA);
            PG8_BAR; PG8_WAIT_L(0); PG8_MMA(1, 0, At, B0); PG8_BAR; PG8_SCHED;
            PG8_STAGE(PG8_SB(1, 1), b3 + hstep, voffB);
            PG8_WAIT_V(6); PG8_BAR; PG8_MMA(1, 1, At, B1); PG8_BAR;
            }
        }
        if constexpr (ALIGN_EPI) { if (wr == 0) PG8_BAR; }
        if constexpr (!Epi::AFTER_DRAIN) { E(acc, cur, wr, wc, fr, fq); S.done(cur); }
        if (!has_next) break;
#pragma unroll
        for (int a = 0; a < 2; ++a)
#pragma unroll
            for (int b = 0; b < 2; ++b)
#pragma unroll
                for (int m = 0; m < 4; ++m)
#pragma unroll
                    for (int n = 0; n < 2; ++n) acc[a][b][m][n] = (f32x4){0.f, 0.f, 0.f, 0.f};
        cur = nxt; cA = nA; cB = nB; ++ui;
        if constexpr (ALIGN_EPI) { if (wr == 1) PG8_BAR; }
    }
    PG8_WAIT_V(0);
    if constexpr (!ALIGN_EPI) { if (wr == 0) PG8_BAR; }
    PG8_BAR;
    if constexpr (Epi::AFTER_DRAIN) { E.fused(acc, cur, wr, wc, fr, fq, lds, wid, lane); S.done(cur); }
#undef PG8_SA
#undef PG8_SB
#undef PG8_STAGE
#undef PG8_LDA
#undef PG8_LDB
#undef PG8_MMA
#undef PG8_WAIT_V
#undef PG8_WAIT_L
#undef PG8_BAR
#undef PG8_SCHED
}
}

#ifndef PG8_SP2
#define PG8_SP2 true
#endif
#ifndef PG8_ALIGN
#define PG8_ALIGN true
#endif
#include <hip/hip_bf16.h>
#include <cmath>
namespace attn_body {
using bf16=__hip_bfloat16;
using bf16x8=__attribute__((ext_vector_type(8)))short;
using s16x4=__attribute__((ext_vector_type(4)))short;
using f32x16=__attribute__((ext_vector_type(16)))float;
using u32x4=__attribute__((ext_vector_type(4)))unsigned;
constexpr int BATCH=2,NHEAD=16,SEQ=8192,D=64,DM=NHEAD*D;
constexpr int NW=8,QBLK=32,QB=QBLK*NW,KVBLK=64,NQB=SEQ/QB;
constexpr int ATTN_PITCH=DM, ATTN_UNIT_ROWS=QB;
__device__ __forceinline__ int crow(int r,int hi){return (r&3)+8*(r>>2)+4*hi;}
#define SBAR() __builtin_amdgcn_sched_barrier(0)
__device__ __forceinline__ void cmask(f32x16&p0,f32x16&p1,int jb,int qrel,int hi){
  const float NEG=-INFINITY; int kb=64*jb+4*hi;
  #pragma unroll
  for(int r=0;r<16;++r){int kv=kb+(r&3)+8*(r>>2); if(kv>qrel)p0[r]=NEG; if(kv+32>qrel)p1[r]=NEG;}
}

constexpr int NSLOT=3, SLOTB=8192;
constexpr int LDS_K=0, LDS_V=NSLOT*SLOTB, LDS_WS=2*NSLOT*SLOTB, LDS_OST=LDS_WS+NW*64*4, LDS_BYTES=LDS_OST+NW*4096;
constexpr float C2=0.125f*1.4426950408889634f;
__device__ __forceinline__ void glds16(const void*gsrc,unsigned lds_dst){unsigned keep;
  asm volatile("s_mov_b32 %0, m0\n\ts_mov_b32 m0, %2\n\ts_nop 0\n\tglobal_load_lds_dwordx4 %1, off\n\ts_mov_b32 m0, %0":"=&s"(keep):"v"(gsrc),"s"(lds_dst):"memory");}
__device__ __forceinline__ float max3f(float a,float b,float c){float r;asm("v_max3_f32 %0, %1, %2, %3":"=v"(r):"v"(a),"v"(b),"v"(c));return r;}
__device__ __forceinline__ float max2f(float a,float b){float r;asm("v_max_f32_e32 %0, %1, %2":"=v"(r):"v"(a),"v"(b));return r;}
__device__ __forceinline__ float fadd_s(float a,float b){float r;asm("v_add_f32_e32 %0, %1, %2":"=v"(r):"v"(a),"v"(b));return r;}
__device__ __forceinline__ float fsub_s(float a,float b){float r;asm("v_sub_f32_e32 %0, %1, %2":"=v"(r):"v"(a),"v"(b));return r;}
typedef float f32x2_t __attribute__((ext_vector_type(2))); typedef __bf16 bf16x2_t __attribute__((ext_vector_type(2)));
__device__ __forceinline__ unsigned cvtpk_s(float lo,float hi){f32x2_t v={lo,hi};bf16x2_t b=__builtin_convertvector(v,bf16x2_t);return __builtin_bit_cast(unsigned,b);}
#define WAIT_BAR(N) asm volatile("s_waitcnt vmcnt(" #N ") lgkmcnt(0)\n\ts_barrier":::"memory")

typedef __attribute__((address_space(3))) const float* lds_fptr; typedef float f32x4_t __attribute__((ext_vector_type(4))); typedef __attribute__((address_space(3))) const f32x4_t* lds_f4ptr;
__device__ __forceinline__ void qkt(f32x16&p0,f32x16&p1,const char*Kslot,const bf16x8*qr,int r32,int hi){
  const char*kb=Kslot+hi*1024+r32*16;
  #pragma unroll
  for(int d0=0;d0<4;++d0){
    const bf16x8 b0=*reinterpret_cast<const bf16x8*>(kb+d0*2048);
    const bf16x8 b1=*reinterpret_cast<const bf16x8*>(kb+d0*2048+512);
    p0=__builtin_amdgcn_mfma_f32_32x32x16_bf16(b0,qr[d0],p0,0,0,0);p1=__builtin_amdgcn_mfma_f32_32x32x16_bf16(b1,qr[d0],p1,0,0,0);}
}
typedef __attribute__((address_space(3))) const char* lds_cptr;
typedef short v4i16_t __attribute__((ext_vector_type(4)));
__device__ __forceinline__ void kload8(bf16x8*kf,lds_cptr kp){
  kf[0]=*(const __attribute__((address_space(3))) bf16x8*)(kp);      kf[1]=*(const __attribute__((address_space(3))) bf16x8*)(kp+512);
  kf[2]=*(const __attribute__((address_space(3))) bf16x8*)(kp+2048); kf[3]=*(const __attribute__((address_space(3))) bf16x8*)(kp+2560);
  kf[4]=*(const __attribute__((address_space(3))) bf16x8*)(kp+4096); kf[5]=*(const __attribute__((address_space(3))) bf16x8*)(kp+4608);
  kf[6]=*(const __attribute__((address_space(3))) bf16x8*)(kp+6144); kf[7]=*(const __attribute__((address_space(3))) bf16x8*)(kp+6656);
}
__device__ __forceinline__ void kload2(bf16x8*kf,lds_cptr kp,int j){ kf[2*j]=*(const __attribute__((address_space(3))) bf16x8*)(kp+j*2048); kf[2*j+1]=*(const __attribute__((address_space(3))) bf16x8*)(kp+j*2048+512); }
__device__ __forceinline__ s16x4 vtr(lds_cptr p){ return __builtin_bit_cast(s16x4,__builtin_amdgcn_ds_read_tr16_b64_v4i16((__attribute__((address_space(3))) v4i16_t*)p)); }
__device__ __forceinline__ float rowmax(const f32x16&p0,const f32x16&p1){
  float a=max3f(p0[0],p0[1],p1[0]),b=max3f(p0[2],p0[3],p1[1]);a=max3f(a,p1[2],p1[3]);
  #pragma unroll
  for(int r=4;r<16;r+=4){a=max3f(a,p0[r],p0[r+1]);b=max3f(b,p0[r+2],p0[r+3]);a=max3f(a,p1[r],p1[r+1]);b=max3f(b,p1[r+2],p1[r+3]);}
  const float m=max2f(a,b);
  auto rr=__builtin_amdgcn_permlane32_swap(__float_as_uint(m),__float_as_uint(m),false,false);
  return max2f(__uint_as_float(rr[0]),__uint_as_float(rr[1]));
}
__device__ __forceinline__ void pv(f32x16*o,int vb,bf16x8 pa0,bf16x8 pa1,bf16x8 pa2,bf16x8 pa3){
  #pragma unroll
  for(int d0=0;d0<2;++d0){s16x4 lo[4],hi[4];
    #pragma unroll
    for(int ks=0;ks<4;++ks){
      asm volatile("ds_read_b64_tr_b16 %0,%1 offset:%c2":"=&v"(lo[ks]):"v"(vb),"i"(d0*4096+ks*1024):"memory");
      asm volatile("ds_read_b64_tr_b16 %0,%1 offset:%c2":"=&v"(hi[ks]):"v"(vb),"i"(d0*4096+ks*1024+512):"memory");}
    asm volatile("s_waitcnt lgkmcnt(0)":::"memory");SBAR();
    #define PK(k) (bf16x8){lo[k][0],lo[k][1],lo[k][2],lo[k][3],hi[k][0],hi[k][1],hi[k][2],hi[k][3]}
    o[d0]=__builtin_amdgcn_mfma_f32_32x32x16_bf16(pa0,PK(0),o[d0],0,0,0);
    o[d0]=__builtin_amdgcn_mfma_f32_32x32x16_bf16(pa1,PK(1),o[d0],0,0,0);
    o[d0]=__builtin_amdgcn_mfma_f32_32x32x16_bf16(pa2,PK(2),o[d0],0,0,0);
    o[d0]=__builtin_amdgcn_mfma_f32_32x32x16_bf16(pa3,PK(3),o[d0],0,0,0);
    #undef PK
  }
}

#ifndef ATTN_STORE16
#define ATTN_STORE16(p,v) (*(u32x4*)(p)=(v))
#endif
template<int THRL> __device__ __forceinline__ void attn_unit(int b,int h,int qb,const bf16*Q,const bf16*__restrict__ K,const bf16*__restrict__ V,bf16*O,char*shm,lds_fptr Gp){
  const int tid=otid(),lane=tid&63,r32=lane&31,hi=lane>>5; const int wid=__builtin_amdgcn_readfirstlane(tid>>6);
  const long rowbase=(long)b*SEQ; const int q0=qb*QB;
  const bf16*Qw=Q+(rowbase+q0+wid*QBLK)*DM+h*D;
  const bf16*Kh=K+rowbase*DM+h*D,*Vh=V+rowbase*DM+h*D;
  const unsigned lds0=(unsigned)(uintptr_t)shm;
  float*wsf=(float*)(shm+LDS_WS)+wid*64;
  const bf16*ksrc=Kh+(long)lane*DM+wid*8;
  const bf16*vsrc=Vh+(long)(16*(wid&3)+(lane>>2))*DM+(wid>>2)*32+(lane&3)*8;
  const unsigned kdst=lds0+LDS_K+wid*1024, vdst=lds0+LDS_V+wid*1024;
  #define DMA_K(t,slot) glds16(ksrc+(long)(t)*KVBLK*DM,(unsigned)__builtin_amdgcn_readfirstlane(kdst+(slot)))
  #define DMA_V(t,slot) glds16(vsrc+(long)(t)*KVBLK*DM,(unsigned)__builtin_amdgcn_readfirstlane(vdst+(slot)))
  const int vb0=(int)(lds0+LDS_V)+((lane>>4)&1)*32+(lane&3)*8+(4*hi+((lane&15)>>2))*64;
  const char*Kbase=shm+LDS_K; bf16x8 kf[8];
  const lds_cptr shm3=(lds_cptr)shm; const lds_cptr kp0=shm3+LDS_K+hi*1024+r32*16; const lds_cptr vp0=shm3+LDS_V+((lane>>4)&1)*32+(lane&3)*8+(4*hi+((lane&15)>>2))*64;
  const int NT=(q0+QB)/KVBLK;
  DMA_K(0,0);DMA_V(0,0);DMA_K(1,SLOTB);
  bf16x8 qr[4];
  #pragma unroll
  for(int d0=0;d0<4;++d0)qr[d0]=*reinterpret_cast<const bf16x8*>(&Qw[(long)r32*DM+d0*16+hi*8]);
  float mhat=0.f,l_reg=0.f;f32x16 o[2];o[0]=f32x16{};o[1]=f32x16{};
  const float Gq=Gp[q0+wid*QBLK+r32]; float negmq=Gq;
  #define BIAS_LD(X0,X1,t) do{ const lds_f4ptr gp_=(lds_f4ptr)(Gp+64*(t)+4*hi); _Pragma("unroll") for(int j_=0;j_<4;++j_){ const f32x4_t a_=gp_[2*j_], b_=gp_[8+2*j_]; \
      X0[4*j_]=a_[0];X0[4*j_+1]=a_[1];X0[4*j_+2]=a_[2];X0[4*j_+3]=a_[3]; X1[4*j_]=b_[0];X1[4*j_+1]=b_[1];X1[4*j_+2]=b_[2];X1[4*j_+3]=b_[3]; } }while(0)
  #define BSUB4(X,B) do{ X[B]=negmq-X[B]; X[(B)+1]=negmq-X[(B)+1]; X[(B)+2]=negmq-X[(B)+2]; X[(B)+3]=negmq-X[(B)+3]; }while(0)
  #define BSUBALL(X0,X1) do{ _Pragma("unroll") for(int r_=0;r_<16;++r_){ X0[r_]=negmq-X0[r_]; X1[r_]=negmq-X1[r_]; } }while(0)
  const int qrel=wid*QBLK+r32;
  #define CMASK(P0,P1,t) do{int jb_=(t)-(NT-4); if(jb_>=0)cmask(P0,P1,jb_,qrel,hi);}while(0)
  bool resc=false;
  #define START(P0,P1) do{ const float rm=rowmax(P0,P1); resc=false; \
    { const float dl=__builtin_fmaxf(rm,-40.f); mhat=fadd_s(mhat,dl); \
      _Pragma("unroll") for(int r=0;r<16;++r){P0[r]=fsub_s(P0[r],dl);P1[r]=fsub_s(P1[r],dl);} \
      negmq=Gq-mhat; } \
    _Pragma("unroll") for(int r=0;r<16;++r)P0[r]=__builtin_amdgcn_exp2f(P0[r]); }while(0)
  #define RESC() do{ if(resc){ asm volatile("s_waitcnt lgkmcnt(0)":::"memory"); \
      _Pragma("unroll") for(int d_=0;d_<2;++d_) _Pragma("unroll") for(int r=0;r<16;++r)o[d_][r]*=wsf[crow(r,hi)]; } }while(0)
  f32x16 pA0,pA1,pB0,pB1;
  int sl_prev=0,sl_cur=0,sl_next=SLOTB;
  #define ROT() do{sl_prev=sl_cur;sl_cur=sl_next;sl_next=(sl_next==(NSLOT-1)*SLOTB)?0:sl_next+SLOTB;}while(0)
  DMA_K(2,2*SLOTB);
  WAIT_BAR(3);
  BIAS_LD(pA0,pA1,0); BSUBALL(pA0,pA1);
  qkt(pA0,pA1,Kbase,qr,r32,hi);asm volatile("s_nop 15\n\ts_nop 7":"+v"(pA0),"+v"(pA1));CMASK(pA0,pA1,0);
  START(pA0,pA1);
  _Pragma("unroll") for(int r=0;r<16;++r)pA1[r]=__builtin_amdgcn_exp2f(pA1[r]);
  BIAS_LD(pB0,pB1,1); BSUBALL(pB0,pB1);
  WAIT_BAR(0);
  DMA_K(3,0);DMA_V(1,SLOTB);
  ROT();
  kload8(kf,kp0+sl_cur);
  WAIT_BAR(2);
  s16x4 vlo[8],vhi[8]; u32x4 pw0,pw1,pw2,pw3;
  #define PKW(P,B) cvtpk_s(P[B],P[B+1])
  #define PAF(k) __builtin_bit_cast(bf16x8,pw##k)
  #define VFR(i) (bf16x8){vlo[i][0],vlo[i][1],vlo[i][2],vlo[i][3],vhi[i][0],vhi[i][1],vhi[i][2],vhi[i][3]}
  #define PIN(x) asm volatile("":"+v"(x))
  #define MX3(a,b,c) __builtin_fmaxf(__builtin_fmaxf((a),(b)),(c))
  #define GAPA(MF,A0,A1,A2,A3,W0,W1,PW) do{ MF; sacc+=A0; sacc+=A1; sacc+=A2; sacc+=A3; PIN(sacc); W0; W1; PIN(PW); SBAR(); }while(0)
  #define EX(v) __builtin_amdgcn_exp2f(v)
  #define GAPB(MF,X,B,GL_,Y,YB) do{ MF; X[B]=EX(X[B]); X[B+1]=EX(X[B+1]); X[B+2]=EX(X[B+2]); X[B+3]=EX(X[B+3]); PIN(X); if(GL_){ BSUB4(Y,YB); PIN(Y); } SBAR(); }while(0)
  #define VRD(i) do{ vlo[i]=vtr(vp_+(((i)>>2)*4096+((i)&3)*1024)); vhi[i]=vtr(vp_+(((i)>>2)*4096+((i)&3)*1024+512)); }while(0)
  #define KRD(G,j) do{ if(G){ kload2(kf,kp0+sl_next,j); SBAR(); } }while(0)
  #define STEP(C0,C1,P0,P1,t,GK,GV,GL) do{ SBAR(); \
    const lds_cptr vp_=vp0+sl_prev; \
    VRD(0); SBAR(); float sacc=(P0[0]+P0[1]); \
    GAPA(C0=__builtin_amdgcn_mfma_f32_32x32x16_bf16(kf[0],qr[0],C0,0,0,0), P0[2],P0[3],P0[4],P0[5],     pw0[0]=PKW(P0,0), pw0[1]=PKW(P0,2), pw0); \
    VRD(4); SBAR(); GAPA(C1=__builtin_amdgcn_mfma_f32_32x32x16_bf16(kf[1],qr[0],C1,0,0,0), P0[6],P0[7],P0[8],P0[9],     pw0[2]=PKW(P0,4), pw0[3]=PKW(P0,6), pw0); \
    VRD(1); SBAR(); GAPA(C0=__builtin_amdgcn_mfma_f32_32x32x16_bf16(kf[2],qr[1],C0,0,0,0),   P0[10],P0[11],P0[12],P0[13], pw1[0]=PKW(P0,8), pw1[1]=PKW(P0,10), pw1); \
    VRD(5); SBAR(); GAPA(C1=__builtin_amdgcn_mfma_f32_32x32x16_bf16(kf[3],qr[1],C1,0,0,0),   P0[14],P0[15],P1[0],P1[1],   pw1[2]=PKW(P0,12),pw1[3]=PKW(P0,14), pw1); \
    VRD(2); SBAR(); GAPA(C0=__builtin_amdgcn_mfma_f32_32x32x16_bf16(kf[4],qr[2],C0,0,0,0),   P1[2],P1[3],P1[4],P1[5],     pw2[0]=PKW(P1,0), pw2[1]=PKW(P1,2), pw2); \
    VRD(6); SBAR(); GAPA(C1=__builtin_amdgcn_mfma_f32_32x32x16_bf16(kf[5],qr[2],C1,0,0,0),   P1[6],P1[7],P1[8],P1[9],     pw2[2]=PKW(P1,4), pw2[3]=PKW(P1,6), pw2); \
    VRD(3); SBAR(); GAPA(C0=__builtin_amdgcn_mfma_f32_32x32x16_bf16(kf[6],qr[3],C0,0,0,0),   P1[10],P1[11],P1[12],P1[13], pw3[0]=PKW(P1,8), pw3[1]=PKW(P1,10), pw3); \
    VRD(7); SBAR(); GAPA(C1=__builtin_amdgcn_mfma_f32_32x32x16_bf16(kf[7],qr[3],C1,0,0,0),   P1[14],P1[15],0.f,0.f,       pw3[2]=PKW(P1,12),pw3[3]=PKW(P1,14), pw3); \
    l_reg+=sacc; \
    if(GK){DMA_K((t)+3,sl_cur);} if(GV){DMA_V((t)+1,sl_next);} \
    CMASK(C0,C1,t); \
    { float a=MX3(C0[0],C0[1],C1[0]),b=MX3(C0[2],C0[3],C1[1]); a=MX3(a,C1[2],C1[3]); \
      _Pragma("unroll") for(int r=4;r<16;r+=4){a=MX3(a,C0[r],C0[r+1]);b=MX3(b,C0[r+2],C0[r+3]);a=MX3(a,C1[r],C1[r+1]);b=MX3(b,C1[r+2],C1[r+3]);} \
      float rm=__builtin_fmaxf(a,b); { auto rr=__builtin_amdgcn_permlane32_swap(__float_as_uint(rm),__float_as_uint(rm),false,false); rm=__builtin_fmaxf(__uint_as_float(rr[0]),__uint_as_float(rr[1])); } \
      resc=false; \
      if(__builtin_expect(__any(rm>(float)THRL),0)){ const float dl=__builtin_fmaxf(rm,0.f); mhat+=dl; \
        _Pragma("unroll") for(int r=0;r<16;++r){C0[r]-=dl;C1[r]-=dl;} \
        negmq=Gq-mhat; \
        const float f=__builtin_amdgcn_exp2f(-dl); l_reg*=f; if(hi==0)wsf[r32]=f; resc=true; } } \
    if(GL){ BIAS_LD(P0,P1,(t)+1); } \
    SBAR(); \
    GAPB(o[0]=__builtin_amdgcn_mfma_f32_32x32x16_bf16(PAF(0),VFR(0),o[0],0,0,0), C0,0, GL,P0,0); \
    GAPB(o[1]=__builtin_amdgcn_mfma_f32_32x32x16_bf16(PAF(0),VFR(4),o[1],0,0,0), C0,4, GL,P0,4); \
    KRD(GL,0); GAPB(o[0]=__builtin_amdgcn_mfma_f32_32x32x16_bf16(PAF(1),VFR(1),o[0],0,0,0), C0,8, GL,P0,8); \
    KRD(GL,1); GAPB(o[1]=__builtin_amdgcn_mfma_f32_32x32x16_bf16(PAF(1),VFR(5),o[1],0,0,0), C0,12, GL,P0,12); \
    KRD(GL,2); GAPB(o[0]=__builtin_amdgcn_mfma_f32_32x32x16_bf16(PAF(2),VFR(2),o[0],0,0,0), C1,0, GL,P1,0); \
    KRD(GL,3); GAPB(o[1]=__builtin_amdgcn_mfma_f32_32x32x16_bf16(PAF(2),VFR(6),o[1],0,0,0), C1,4, GL,P1,4); \
    GAPB(o[0]=__builtin_amdgcn_mfma_f32_32x32x16_bf16(PAF(3),VFR(3),o[0],0,0,0), C1,8, GL,P1,8); \
    GAPB(o[1]=__builtin_amdgcn_mfma_f32_32x32x16_bf16(PAF(3),VFR(7),o[1],0,0,0), C1,12, GL,P1,12); \
    }while(0)
  int t=1;
  #undef CMASK
  #define CMASK(P0,P1,t) do{}while(0)
  for(;t+5<NT;t+=2){
    STEP(pB0,pB1,pA0,pA1,t,true,true,true);     WAIT_BAR(2); RESC(); ROT();
    STEP(pA0,pA1,pB0,pB1,t+1,true,true,true);   WAIT_BAR(2); RESC(); ROT();
  }
  #undef CMASK
  #define CMASK(P0,P1,t) do{int jb_=(t)-(NT-4); if(jb_>=0)cmask(P0,P1,jb_,qrel,hi);}while(0)
  #define ENDW(tt) do{ if((tt)+3<NT){WAIT_BAR(2);} else if((tt)+2<NT){WAIT_BAR(1);} else {WAIT_BAR(0);} }while(0)
  for(;t+1<NT;t+=2){
    STEP(pB0,pB1,pA0,pA1,t,(t+3<NT),(t+1<NT),(t+1<NT));       ENDW(t);   RESC(); ROT();
    STEP(pA0,pA1,pB0,pB1,t+1,(t+4<NT),(t+2<NT),(t+2<NT));     ENDW(t+1); RESC(); ROT();
  }
  STEP(pB0,pB1,pA0,pA1,NT-1,false,false,false); RESC();
  { float sacc=pB0[0]+pB0[1]; _Pragma("unroll") for(int r=2;r<16;++r)sacc+=pB0[r]; _Pragma("unroll") for(int r=0;r<16;++r)sacc+=pB1[r]; l_reg+=sacc;
    pw0=(u32x4){PKW(pB0,0),PKW(pB0,2),PKW(pB0,4),PKW(pB0,6)};pw1=(u32x4){PKW(pB0,8),PKW(pB0,10),PKW(pB0,12),PKW(pB0,14)};pw2=(u32x4){PKW(pB1,0),PKW(pB1,2),PKW(pB1,4),PKW(pB1,6)};pw3=(u32x4){PKW(pB1,8),PKW(pB1,10),PKW(pB1,12),PKW(pB1,14)};
    SBAR(); pv(o,vb0+sl_cur,PAF(0),PAF(1),PAF(2),PAF(3)); }
  #undef PKW
  #undef PAF
  #undef VFR
  #undef PIN
  #undef MX3
  #undef GAPA
  #undef GAPB
  #undef EX
  #undef VRD
  #undef KRD
  #undef STEP
  #undef ENDW
  {auto rr=__builtin_amdgcn_permlane32_swap(__float_as_uint(l_reg),__float_as_uint(l_reg),false,false);l_reg=__uint_as_float(rr[0])+__uint_as_float(rr[1]);}
  if(hi==0)wsf[32+r32]=l_reg;asm volatile("s_waitcnt lgkmcnt(0)":::"memory");
  float rli[16];
  #pragma unroll
  for(int r=0;r<16;++r)rli[r]=__builtin_amdgcn_rcpf(wsf[32+crow(r,hi)]);
  bf16*Ow=O+(rowbase+q0+wid*QBLK)*DM+h*D;
  { bf16*stg=(bf16*)(shm+LDS_OST)+wid*2048;
    #pragma unroll
    for(int r=0;r<16;++r){const int orow=crow(r,hi);
      #pragma unroll
      for(int d0=0;d0<2;++d0)stg[orow*64+d0*32+r32]=__float2bfloat16(o[d0][r]*rli[r]);}
    asm volatile("s_waitcnt lgkmcnt(0)":::"memory");
    #pragma unroll
    for(int i=0;i<4;++i){const int row=i*8+(lane>>3),ch=lane&7; const u32x4 v=*(const u32x4*)(stg+row*64+ch*8); ATTN_STORE16(Ow+(long)row*DM+ch*8,v);} }
  asm volatile("s_waitcnt lgkmcnt(0)\n\ts_barrier":::"memory");
  #undef DMA_K
  #undef BIAS_LD
  #undef BSUB4
  #undef BSUBALL
  #undef DMA_V
  #undef CMASK
  #undef START
  #undef RESC
  #undef ROT
}
constexpr int ATTN_LDS_BYTES=LDS_BYTES;
#undef SBAR
#undef WAIT_BAR
}
#define GAS __attribute__((address_space(1)))
#define LAS __attribute__((address_space(3)))
typedef unsigned short bf16;
typedef unsigned v4u __attribute__((ext_vector_type(4)));
typedef float f32x4 __attribute__((ext_vector_type(4)));
typedef float f32x2 __attribute__((ext_vector_type(2)));
typedef short bf16x8 __attribute__((ext_vector_type(8)));
constexpr int NWAVES = 8;
constexpr int M = 16384, D = 1024, T = 8192, FF = 2816, NGU = 5632, R = 1280, NH = 16, NQKV = 3072, NFOX = 3088;
constexpr size_t MiB = 1u << 20;
constexpr size_t WS_SS = 0;
constexpr size_t WS_LOGF = 1 * MiB;
constexpr size_t WS_LSUM = 2 * MiB;
constexpr size_t WS_WF = 5 * MiB;
constexpr size_t WS_WLG = 5 * MiB + 512 * 1024;
constexpr size_t WS_SP = 6 * MiB;
constexpr size_t WS_WGU = 8 * MiB, WGU_BYTES = 11 * MiB;
constexpr size_t WS_WD = 52 * MiB, WD_BYTES = 5 * MiB + 512 * 1024;
constexpr size_t WS_WQKV = 74 * MiB, WS_WO = 80 * MiB, WS_WLIN = 82 * MiB, WS_WLOUT = 87 * MiB;
constexpr size_t WS_XB = 90 * MiB;
constexpr size_t WS_BIG = 122 * MiB;
constexpr size_t WS_END = 218 * MiB;
constexpr int LDS_BYTES = 147456;
constexpr float LOG2E = 1.4426950408889634f;

__device__ __forceinline__ unsigned f2bf(float f) { unsigned u = __builtin_bit_cast(unsigned, f); return (u + 0x7fffu + ((u >> 16) & 1u)) >> 16; }
__device__ __forceinline__ unsigned pk2(float lo, float hi) { return f2bf(lo) | (f2bf(hi) << 16); }
__device__ __forceinline__ float bf2f(unsigned short b) { return __builtin_bit_cast(float, (unsigned)b << 16); }
__device__ __forceinline__ float wave_sum(float v) {
#pragma unroll
    for (int o = 1; o < 64; o <<= 1) v += __shfl_xor(v, o);
    return v;
}

#define XB_TMO      128
#define XB_XCNT(j)  (256  + 64 * (j))
#define XB_XSUB(j)  (1280 + 64 * (j))
#define XB_XGEN(j)  (2304 + 64 * (j))
#define XB_TOP      3328
#define XB_TOPGEN   3392
#define XCD_BAR_WORDS 3456
#define XB_SPIN_CAP (1u << 18)

__device__ __forceinline__ unsigned xb_ld(unsigned* p)              { return __hip_atomic_load(p, __ATOMIC_RELAXED, __HIP_MEMORY_SCOPE_AGENT); }
__device__ __forceinline__ unsigned xb_add(unsigned* p, unsigned v) { return __hip_atomic_fetch_add(p, v, __ATOMIC_RELAXED, __HIP_MEMORY_SCOPE_AGENT); }
__device__ __forceinline__ unsigned xb_xcc_id() { return (unsigned)__builtin_amdgcn_s_getreg((3 << 11) | 20) & 0xFu; }
#define XB_SPIN(cond, bar) do { unsigned _sp = 0; while (cond) { __builtin_amdgcn_s_sleep(1); \
    if ((++_sp & 255u) == 0u) { if (xb_ld(&(bar)[XB_TMO])) break; if (_sp > XB_SPIN_CAP) { atomicAdd(&(bar)[XB_TMO], 1u); break; } } } } while (0)

struct XcdBarrier {
    unsigned* bar; unsigned x;
    volatile LAS unsigned* st;
};

__device__ __forceinline__ XcdBarrier xcd_barrier_post(unsigned* bar, volatile LAS unsigned* st) {
    XcdBarrier b; b.bar = bar; b.x = xb_xcc_id(); b.st = st;
    if (threadIdx.x == 0) (void)xb_add(&bar[XB_XCNT(b.x)], 1u);
    return b;
}
__device__ __forceinline__ void xcd_barrier_complete(unsigned* bar, unsigned x, unsigned& nloc, unsigned& nx) {
    const unsigned G = gridDim.x * gridDim.y * gridDim.z;
    unsigned sum, cnt, mine, sp = 0u;
    for (;;) {
        sum = 0u; cnt = 0u; mine = 0u;
#pragma unroll
        for (unsigned j = 0; j < 16; ++j) { const unsigned c = xb_ld(&bar[XB_XCNT(j)]); sum += c; cnt += (c > 0u) ? 1u : 0u; mine = (j == x) ? c : mine; }
        if (sum == G) break;
        __builtin_amdgcn_s_sleep(1);
        if ((++sp & 255u) == 0u) { if (xb_ld(&bar[XB_TMO])) break; if (sp > XB_SPIN_CAP) { atomicAdd(&bar[XB_TMO], 1u); break; } }
    }
    nloc = mine > 0u ? mine : 1u; nx = cnt > 0u ? cnt : 1u;
}

__device__ __forceinline__ void xcd_barrier(const XcdBarrier& b) {
    asm volatile("s_waitcnt vmcnt(0)" ::: "memory");
    __syncthreads();
    if (threadIdx.x == 0) {
        unsigned* bar = b.bar;
        __builtin_amdgcn_s_waitcnt(0);
        unsigned nloc = b.st[0], nx = b.st[1];
        if (nloc == 0u) { xcd_barrier_complete(bar, b.x, nloc, nx); b.st[0] = nloc; b.st[1] = nx; }
        const unsigned old = xb_add(&bar[XB_XSUB(b.x)], 1u);
        const unsigned gen = old / nloc;
        if (old + 1u == (gen + 1u) * nloc) {
            __builtin_amdgcn_fence(__ATOMIC_RELEASE, "agent");
            asm volatile("s_waitcnt vmcnt(0)" ::: "memory");
            const unsigned og = xb_add(&bar[XB_TOP], 1u);
            const unsigned tg = og / nx;
            if (og + 1u == (tg + 1u) * nx) xb_add(&bar[XB_TOPGEN], 1u);
            else XB_SPIN(xb_ld(&bar[XB_TOPGEN]) == tg, bar);
            __builtin_amdgcn_fence(__ATOMIC_ACQUIRE, "agent");
            xb_add(&bar[XB_XGEN(b.x)], 1u);
            asm volatile("s_waitcnt vmcnt(0)" ::: "memory");
        } else {
            XB_SPIN(xb_ld(&bar[XB_XGEN(b.x)]) == gen, bar);
            __builtin_amdgcn_fence(__ATOMIC_ACQUIRE, "agent");
            asm volatile("s_waitcnt vmcnt(0)" ::: "memory");
        }
    }
    __syncthreads();
}

constexpr size_t WS_BAR = 7 * MiB, BAR_BYTES = 16384;
constexpr int MISC_OFF = 131072 + 320;
struct Args { const float* in[21]; float* out; unsigned char* ws; int ph_lo, ph_hi; };
enum { I_X = 0, I_F1N, I_F1GU, I_F1D, I_MIXN, I_F2N, I_F2GU, I_F2D, I_FOXIN, I_FOXBF, I_FOXOUT, I_LIN, I_LCW, I_LCB, I_LWA, I_LBA, I_LWI, I_LBI, I_LLAM, I_LOUT, I_FINN };

template <bool GU> __device__ __forceinline__ void tr_item(const float* W, int ldw, int K, int nblk, const float* gain, bf16* WT, LAS float* scr, int item, int lane) {
    const int kb = item / nblk, nb = item - kb * nblk, k0 = 64 * kb, n0 = 32 * nb;
#pragma unroll 8
    for (int i = 0; i < 32; ++i) { const int kk = 2 * i + (lane >> 5); float w = W[(size_t)(k0 + kk) * ldw + n0 + (lane & 31)]; if (gain) w *= gain[k0 + kk]; scr[kk * 33 + (lane & 31)] = w; }
    asm volatile("s_waitcnt lgkmcnt(0)" ::: "memory");
    int row0 = n0;
    if (GU) { const int c = (n0 < FF) ? n0 : n0 - FF; row0 = 256 * (c >> 7) + (c & 127) + ((n0 < FF) ? 0 : 128); }
    const int c8 = lane & 7;
#pragma unroll
    for (int j = 0; j < 4; ++j) { const int n = (lane >> 3) + 8 * j; const LAS float* s = scr + (8 * c8) * 33 + n;
        v4u o; o.x = pk2(s[0 * 33], s[1 * 33]); o.y = pk2(s[2 * 33], s[3 * 33]); o.z = pk2(s[4 * 33], s[5 * 33]); o.w = pk2(s[6 * 33], s[7 * 33]);
        *(v4u*)(WT + (size_t)(row0 + n) * K + k0 + 8 * c8) = o; }
    asm volatile("s_waitcnt lgkmcnt(0)" ::: "memory");
}

template <class Epi> __device__ __forceinline__ void run_gemm(LAS unsigned char* lds, const bf16* A, const bf16* Bt, int N, int K, const Epi& E) {
    pg8::Gemm g{A, Bt, M, N, K}; pg8::StaticOrder S; S.init(M, N, osgpr((int)gridDim.x), osgpr((int)blockIdx.x));
    pg8::gemm_phase<Epi, pg8::StaticOrder, PG8_ALIGN, PG8_SP2>(lds, g, S, E);
}

template <bool PASSB> __device__ __forceinline__ void lru_phase(LAS unsigned char* L, const Args& args, int vcu, int G, int tid, bf16* YOUT) {
    const int lane = tid & 63, wave = __builtin_amdgcn_readfirstlane(tid >> 6), fr = lane & 15, fq = lane >> 4;
    LAS bf16* Wt = (LAS bf16*)(L);
    LAS bf16* xcb = (LAS bf16*)(L + 33280);
    LAS float* xcf = (LAS float*)(L + 46592);
    LAS float* Aa = (LAS float*)(L + 67072);
    LAS float* Bb = (LAS float*)(L + 87552);
    LAS bf16* recs = (LAS bf16*)(L + 108032);
    LAS float* sub = (LAS float*)(L + 118752);
    LAS float* carry = (LAS float*)(L + 121312);
    LAS float* cst = (LAS float*)(L + 121632);
    unsigned char* ws = args.ws;
    const bf16* Wg = (const bf16*)(ws + WS_WLG); const float* sp = (const float*)(ws + WS_SP);
    const bf16* GATE = (const bf16*)(ws + WS_BIG); const bf16* REC = (const bf16*)(ws + WS_BIG + 40 * MiB);
    f32x2* SUM = (f32x2*)(ws + WS_LSUM);
    const int n = vcu & 15;
    for (int p = tid; p < 1920; p += 512) { const int row = p / 12, pc = p - row * 12; *(LAS v4u*)(Wt + row * 104 + pc * 8) = *(const v4u*)(Wg + (size_t)(n * 160 + row) * 96 + pc * 8); }
    if (tid < 128) { const int row = tid >> 1, pc = tid & 1; unsigned z = 0u; asm volatile("" : "+v"(z)); *(LAS v4u*)(xcb + row * 104 + 80 + pc * 8) = (v4u){z, z, z, z}; }
    if (tid < 80) { const int c = n * 80 + tid;
        cst[0 * 80 + tid] = args.in[I_LCW][0 * R + c]; cst[1 * 80 + tid] = args.in[I_LCW][1 * R + c]; cst[2 * 80 + tid] = args.in[I_LCW][2 * R + c]; cst[3 * 80 + tid] = args.in[I_LCW][3 * R + c];
        cst[4 * 80 + tid] = args.in[I_LCB][c]; cst[5 * 80 + tid] = args.in[I_LBA][c]; cst[6 * 80 + tid] = args.in[I_LBI][c]; cst[7 * 80 + tid] = sp[c]; }
    __syncthreads();
    float hc = 0.f; int jprev = 0, bprev = 0;
    for (int u = vcu >> 4; u < 256; u += (G >> 4)) {
        const int b = u >> 7, j = u & 127, t0 = j * 64; const size_t rowg0 = (size_t)b * T + t0;
        for (int p = tid; p < 670; p += 512) { const int rr = p / 10, pc = p - rr * 10, tok = t0 - 3 + rr; unsigned z = 0u; asm volatile("" : "+v"(z)); v4u v = (v4u){z, z, z, z};
            if (tok >= 0) v = *(const v4u*)(REC + ((size_t)b * T + tok) * R + n * 80 + pc * 8);
            *(LAS v4u*)(recs + rr * 80 + pc * 8) = v; }
        if (PASSB && tid < 80) {
            if (b != bprev) { hc = 0.f; jprev = 0; bprev = b; }
            const f32x2* S = SUM + ((size_t)b * 128) * R + n * 80 + tid;
#pragma unroll 8
            for (int jj = jprev; jj < j; ++jj) { const f32x2 ab = S[(size_t)jj * R]; hc = ab.x * hc + ab.y; }
            jprev = j; carry[tid] = hc; }
        __syncthreads();
#pragma unroll
        for (int i = 0; i < 10; ++i) { const int idx = tid + 512 * i, t = idx / 80, c = idx - t * 80;
            float x = cst[4 * 80 + c];
#pragma unroll
            for (int jj = 0; jj < 4; ++jj) x += cst[jj * 80 + c] * bf2f(recs[(t + jj) * 80 + c]);
            xcf[t * 80 + c] = x; xcb[t * 104 + c] = (bf16)f2bf(x); }
        __syncthreads();
        { const int mt = wave & 3, ct0 = (wave >> 2) ? 3 : 0, ct1 = (wave >> 2) ? 5 : 3, tok = 16 * mt + fr;
            for (int ct = ct0; ct < ct1; ++ct) { f32x4 ga = (f32x4){0.f, 0.f, 0.f, 0.f}, gi = ga;
#pragma unroll
                for (int kk = 0; kk < 3; ++kk) { const bf16x8 xf = *(const LAS bf16x8*)(xcb + tok * 104 + 32 * kk + 8 * fq);
                    const bf16x8 wa = *(const LAS bf16x8*)(Wt + (16 * ct + fr) * 104 + 32 * kk + 8 * fq), wi = *(const LAS bf16x8*)(Wt + (80 + 16 * ct + fr) * 104 + 32 * kk + 8 * fq);
                    ga = __builtin_amdgcn_mfma_f32_16x16x32_bf16(wa, xf, ga, 0, 0, 0); gi = __builtin_amdgcn_mfma_f32_16x16x32_bf16(wi, xf, gi, 0, 0, 0); }
                const int ch0 = 16 * ct + 4 * fq; const f32x4 xv = *(const LAS f32x4*)(xcf + tok * 80 + ch0); f32x4 av, bv;
#pragma unroll
                for (int e = 0; e < 4; ++e) { const int ch = ch0 + e;
                    const float r = 1.0f / (1.0f + __expf(-(ga[e] + cst[5 * 80 + ch]))), ig = 1.0f / (1.0f + __expf(-(gi[e] + cst[6 * 80 + ch])));
                    const float la = -8.0f * r * cst[7 * 80 + ch]; av[e] = expf(la); bv[e] = sqrtf(-expm1f(2.0f * la)) * (ig * xv[e]); }
                *(LAS f32x4*)(Aa + tok * 80 + ch0) = av; *(LAS f32x4*)(Bb + tok * 80 + ch0) = bv; } }
        __syncthreads();
        const int ch = tid % 80, s = tid / 80;
        if (tid < 320) { float Ap = 1.f, Bp = 0.f;
#pragma unroll
            for (int tt = 0; tt < 16; ++tt) { const int t = 16 * s + tt; const float a = Aa[t * 80 + ch], bb = Bb[t * 80 + ch]; Ap *= a; Bp = a * Bp + bb; }
            sub[(s * 80 + ch) * 2] = Ap; sub[(s * 80 + ch) * 2 + 1] = Bp; }
        __syncthreads();
        if (!PASSB) {
            if (tid < 80) { float Ap = 1.f, Bp = 0.f;
#pragma unroll
                for (int s2 = 0; s2 < 4; ++s2) { const float a = sub[(s2 * 80 + tid) * 2], bb = sub[(s2 * 80 + tid) * 2 + 1]; Ap *= a; Bp = a * Bp + bb; }
                SUM[((size_t)b * 128 + j) * R + n * 80 + tid] = (f32x2){Ap, Bp}; }
        } else {
            if (tid < 320) { float h = carry[ch];
                for (int s2 = 0; s2 < s; ++s2) h = sub[(s2 * 80 + ch) * 2] * h + sub[(s2 * 80 + ch) * 2 + 1];
#pragma unroll
                for (int tt = 0; tt < 16; ++tt) { const int t = 16 * s + tt; h = Aa[t * 80 + ch] * h + Bb[t * 80 + ch]; Bb[t * 80 + ch] = h; } }
            __syncthreads();
            for (int p = tid; p < 640; p += 512) { const int t = p / 10, pc = p - t * 10;
                const f32x4 h0 = *(const LAS f32x4*)(Bb + t * 80 + pc * 8), h1 = *(const LAS f32x4*)(Bb + t * 80 + pc * 8 + 4);
                const bf16* gp = GATE + (rowg0 + t) * R + n * 80 + pc * 8; const v4u gv = *(const v4u*)gp;
                v4u o; o.x = pk2(h0[0] * bf2f((unsigned short)(gv.x & 0xffffu)), h0[1] * bf2f((unsigned short)(gv.x >> 16))); o.y = pk2(h0[2] * bf2f((unsigned short)(gv.y & 0xffffu)), h0[3] * bf2f((unsigned short)(gv.y >> 16)));
                o.z = pk2(h1[0] * bf2f((unsigned short)(gv.z & 0xffffu)), h1[1] * bf2f((unsigned short)(gv.z >> 16))); o.w = pk2(h1[2] * bf2f((unsigned short)(gv.w & 0xffffu)), h1[3] * bf2f((unsigned short)(gv.w >> 16)));
                *(v4u*)(YOUT + (rowg0 + t) * R + n * 80 + pc * 8) = o; }
        }
        __syncthreads();
    }
}

__device__ __forceinline__ void p0_prologue(LAS unsigned char* lds, const Args& args, int vcu, int G, int tid) {
    const int lane = tid & 63, wave = __builtin_amdgcn_readfirstlane(tid >> 6);
    unsigned char* ws = args.ws;
    LAS float* scr = (LAS float*)(lds + wave * 16384);
    const int gw = vcu * NWAVES + wave, NGW = G * NWAVES;
    constexpr int I_GU = (D / 64) * (NGU / 32), I_DN = (FF / 64) * (D / 32), I_QKV = (D / 64) * (NQKV / 32), I_WO = (D / 64) * (D / 32), I_LI = (D / 64) * (2 * R / 32), I_LO = (R / 64) * (D / 32);
    constexpr int NITEMS = 4 * I_GU + 4 * I_DN + I_QKV + I_WO + I_LI + I_LO;
    for (int it = gw; it < NITEMS; it += NGW) {
        int r = it;
        if (r < 4 * I_GU) { const int f = r / I_GU; r -= f * I_GU; const int layer = f >> 1;
            const float* W = ((f & 1) ? args.in[I_F2GU] : args.in[I_F1GU]) + (size_t)layer * D * NGU; const float* gn = ((f & 1) ? args.in[I_F2N] : args.in[I_F1N]) + layer * D;
            tr_item<true>(W, NGU, D, NGU / 32, gn, (bf16*)(ws + WS_WGU + f * WGU_BYTES), scr, r, lane); continue; }
        r -= 4 * I_GU;
        if (r < 4 * I_DN) { const int f = r / I_DN; r -= f * I_DN; const int layer = f >> 1;
            const float* W = ((f & 1) ? args.in[I_F2D] : args.in[I_F1D]) + (size_t)layer * FF * D;
            tr_item<false>(W, D, FF, D / 32, nullptr, (bf16*)(ws + WS_WD + f * WD_BYTES), scr, r, lane); continue; }
        r -= 4 * I_DN;
        if (r < I_QKV) { tr_item<false>(args.in[I_FOXIN], NFOX, D, NQKV / 32, args.in[I_MIXN], (bf16*)(ws + WS_WQKV), scr, r, lane); continue; }
        r -= I_QKV;
        if (r < I_WO) { tr_item<false>(args.in[I_FOXOUT], D, D, D / 32, nullptr, (bf16*)(ws + WS_WO), scr, r, lane); continue; }
        r -= I_WO;
        if (r < I_LI) { tr_item<false>(args.in[I_LIN], 2 * R, D, 2 * R / 32, args.in[I_MIXN] + D, (bf16*)(ws + WS_WLIN), scr, r, lane); continue; }
        r -= I_LI;
        tr_item<false>(args.in[I_LOUT], D, R, D / 32, nullptr, (bf16*)(ws + WS_WLOUT), scr, r, lane);
    }
    const int gt = vcu * 512 + tid, NGT = G * 512;
    { bf16* wf = (bf16*)(ws + WS_WF);
        for (int i = gt; i < NH * D; i += NGT) { const int h = i >> 10, k = i & 1023; wf[i] = (bf16)f2bf(args.in[I_MIXN][k] * args.in[I_FOXIN][(size_t)k * NFOX + NQKV + h]); } }
    { bf16* wg = (bf16*)(ws + WS_WLG);
        for (int i = gt; i < 16 * 160 * 96; i += NGT) { const int k = i % 96, dd = (i / 96) % 160, n = i / (96 * 160); float v = 0.f;
            if (k < 80) v = (dd < 80) ? args.in[I_LWA][((size_t)n * 80 + k) * 80 + dd] : args.in[I_LWI][((size_t)n * 80 + k) * 80 + (dd - 80)];
            wg[i] = (bf16)f2bf(v); } }
    { float* sp = (float*)(ws + WS_SP); for (int i = gt; i < R; i += NGT) sp[i] = log1pf(expf(-args.in[I_LLAM][i])); }
    { float* ss = (float*)(ws + WS_SS); for (int i = gt; i < 7 * M; i += NGT) ss[M + i] = 0.f; }
    { float* ss0 = (float*)(ws + WS_SS); bf16* xb = (bf16*)(ws + WS_XB); const float* x = args.in[I_X];
        for (int m = gw; m < M; m += NGW) { const f32x4* xr = (const f32x4*)(x + (size_t)m * D) + lane; f32x4 v[4]; float s = 0.f;
#pragma unroll
            for (int j = 0; j < 4; ++j) { v[j] = xr[64 * j]; s += (v[j].x * v[j].x + v[j].y * v[j].y) + (v[j].z * v[j].z + v[j].w * v[j].w); }
            s = wave_sum(s); if (lane == 0) ss0[m] = s;
            unsigned long long* o8 = (unsigned long long*)(xb + (size_t)m * D) + lane;
#pragma unroll
            for (int j = 0; j < 4; ++j) o8[64 * j] = (unsigned long long)pk2(v[j].x, v[j].y) | ((unsigned long long)pk2(v[j].z, v[j].w) << 32); } }
}

__device__ __forceinline__ void flogit_phase(const Args& args, int vcu, int G, int tid) {
    const int lane = tid & 63, wave = __builtin_amdgcn_readfirstlane(tid >> 6), fr = lane & 15, fq = lane >> 4;
    unsigned char* ws = args.ws; const bf16* xb = (const bf16*)(ws + WS_XB); const bf16* wf = (const bf16*)(ws + WS_WF); const float* ss = (const float*)(ws + WS_SS) + 1 * M; float* logf_ = (float*)(ws + WS_LOGF);
    const int gw = vcu * NWAVES + wave, NGW = G * NWAVES;
    for (int grp = gw; grp < M / 16; grp += NGW) { const int row0 = grp * 16;
        const bf16* xa = xb + (size_t)(row0 + fr) * D + 8 * fq; const bf16* wb = wf + (size_t)fr * D + 8 * fq; f32x4 acc = (f32x4){0.f, 0.f, 0.f, 0.f};
#pragma unroll 8
        for (int kk = 0; kk < 32; ++kk) { const bf16x8 xf = *(const bf16x8*)(xa + 32 * kk), wv = *(const bf16x8*)(wb + 32 * kk); acc = __builtin_amdgcn_mfma_f32_16x16x32_bf16(wv, xf, acc, 0, 0, 0); }
        const int row = row0 + fr, b = row >> 13, t = row & (T - 1); const float rs = pg8::rstd_row(ss, row);
#pragma unroll
        for (int e = 0; e < 4; ++e) { const int h = 4 * fq + e; const float z = acc[e] * rs + args.in[I_FOXBF][h];
            const float lf = fminf(z, 0.f) - log1pf(expf(-fabsf(z))); logf_[(size_t)(b * NH + h) * T + t] = lf * LOG2E; } }
}

__device__ __forceinline__ void attn_cumsum(const float* lf, LAS float* Gl, LAS float* wsum, int tid) {
    const int lane = tid & 63, wave = tid >> 6; f32x4 v[4];
#pragma unroll
    for (int j = 0; j < 4; ++j) v[j] = *(const f32x4*)(lf + tid * 16 + 4 * j);
    float run = 0.f;
#pragma unroll
    for (int j = 0; j < 4; ++j) { run += v[j].x; v[j].x = run; run += v[j].y; v[j].y = run; run += v[j].z; v[j].z = run; run += v[j].w; v[j].w = run; }
    float incl = run;
#pragma unroll
    for (int o = 1; o < 64; o <<= 1) { const float nb = __shfl_up(incl, o); if (lane >= o) incl += nb; }
    if (lane == 63) wsum[wave] = incl;
    __syncthreads();
    float base = incl - run;
    for (int w = 0; w < wave; ++w) base += wsum[w];
#pragma unroll
    for (int j = 0; j < 4; ++j) *(LAS f32x4*)(Gl + tid * 16 + 4 * j) = v[j] + base;
    __syncthreads();
}

constexpr int N_PHASES = 17;
#ifndef ONLY_KIND
#define ONLY_KIND -1
#endif
#define KON(k) (ONLY_KIND < 0 || ONLY_KIND == (k))
#ifndef DUP_PH
#define DUP_PH -1
#endif
#ifndef DUP_SYNC
#define DUP_SYNC 0
#endif
__global__ void __launch_bounds__(NWAVES * 64, 2) fwd_megakernel(Args args) {
    extern __shared__ __attribute__((aligned(16))) unsigned char lds_raw[];
    LAS unsigned char* lds = (LAS unsigned char*)lds_raw;
    cg::grid_group grid = cg::this_grid();
    if (threadIdx.x < 16) ((LAS unsigned*)(lds + MISC_OFF))[threadIdx.x] = 0u;
    __syncthreads();
    XcdBarrier xbar = xcd_barrier_post((unsigned*)(args.ws + WS_BAR), (volatile LAS unsigned*)(lds + MISC_OFF));
    unsigned char* ws = args.ws;
    float* ssb = (float*)(ws + WS_SS); bf16* XB = (bf16*)(ws + WS_XB);
    bf16* HB = (bf16*)(ws + WS_BIG); bf16* QB_ = (bf16*)(ws + WS_BIG); bf16* KB = (bf16*)(ws + WS_BIG + 32 * MiB); bf16* VB = (bf16*)(ws + WS_BIG + 64 * MiB);
    bf16* GATE = (bf16*)(ws + WS_BIG); bf16* REC = (bf16*)(ws + WS_BIG + 40 * MiB);
    for (int pp = args.ph_lo; pp < args.ph_hi; ++pp) {
        int ph = pp; bool dummy = false;
        if (DUP_PH >= 0) { dummy = (pp == DUP_PH); ph = (pp <= DUP_PH) ? pp : pp - 1; }
        const int tid = otid(), G = osgpr((int)gridDim.x), bx = osgpr((int)blockIdx.x);
        const int vcu = (G % 8 == 0) ? (bx % 8) * (G / 8) + bx / 8 : bx;
        int kind = 0, f = 0, ssi = 0; const bf16* A = XB; const bf16* Bt = nullptr; int K = D; const float* xin = args.out; float alpha = 1.f;
        switch (ph) {
            case 0: kind = 0; break;
            case 1: kind = 1; f = 0; ssi = 0; break;
            case 2: kind = 2; A = HB; Bt = (const bf16*)(ws + WS_WD + 0 * WD_BYTES); K = FF; xin = args.in[I_X]; alpha = 0.5f; ssi = 1; break;
            case 3: kind = 3; break;
            case 4: kind = 4; break;
            case 5: kind = 2; A = QB_; Bt = (const bf16*)(ws + WS_WO); K = D; alpha = 1.f; ssi = 2; break;
            case 6: kind = 1; f = 1; ssi = 2; break;
            case 7: kind = 2; A = HB; Bt = (const bf16*)(ws + WS_WD + 1 * WD_BYTES); K = FF; alpha = 0.5f; ssi = 3; break;
            case 8: kind = 1; f = 2; ssi = 3; break;
            case 9: kind = 2; A = HB; Bt = (const bf16*)(ws + WS_WD + 2 * WD_BYTES); K = FF; alpha = 0.5f; ssi = 4; break;
            case 10: kind = 5; break;
            case 11: kind = 6; break;
            case 12: kind = 7; break;
            case 13: kind = 2; A = GATE; Bt = (const bf16*)(ws + WS_WLOUT); K = R; alpha = 1.f; ssi = 5; break;
            case 14: kind = 1; f = 3; ssi = 5; break;
            case 15: kind = 2; A = HB; Bt = (const bf16*)(ws + WS_WD + 3 * WD_BYTES); K = FF; alpha = 0.5f; ssi = 6; break;
            default: kind = 8; break;
        }
        if (dummy) { alpha = 0.f; if (kind == 2) ssi = 7; }
        bf16* const OB = dummy ? (bf16*)(ws + 218 * MiB) : QB_; bf16* const YB = dummy ? (bf16*)(ws + WS_BIG + 80 * MiB) : GATE;
        if (KON(0) && kind == 0) { p0_prologue(lds, args, vcu, G, tid); }
        else if (KON(1) && kind == 1) { pg8::EpiSwiGLU E{HB, ssb + (size_t)ssi * M}; run_gemm(lds, XB, (const bf16*)(ws + WS_WGU + f * WGU_BYTES), NGU, D, E); }
        else if (KON(2) && kind == 2) { pg8::EpiResid E{xin, args.out, XB, ssb + (size_t)ssi * M, alpha}; run_gemm(lds, A, Bt, D, K, E); }
        else if (KON(3) && kind == 3) { pg8::EpiQKV E{QB_, (size_t)M * D, ssb + 1 * M, attn_body::C2}; run_gemm(lds, XB, (const bf16*)(ws + WS_WQKV), NQKV, D, E); flogit_phase(args, vcu, G, tid); }
        else if (KON(4) && kind == 4) {
            LAS float* Gl = (LAS float*)(lds + 86016); LAS float* wsum = (LAS float*)(lds + 86016 + 32768);
            for (int item = vcu; item < 256; item += G) { const int bh = item >> 3, s = item & 7;
                attn_cumsum((const float*)(ws + WS_LOGF) + (size_t)bh * T, Gl, wsum, tid);
                for (int i = 0; i < 4; ++i) { const int qb = (i == 0) ? s : (i == 1) ? 15 - s : (i == 2) ? 16 + s : 31 - s;
                    attn_body::attn_unit<8>(bh >> 4, bh & 15, qb, (const attn_body::bf16*)QB_, (const attn_body::bf16*)KB, (const attn_body::bf16*)VB, (attn_body::bf16*)OB, (char*)lds_raw, (attn_body::lds_fptr)Gl); }
                __syncthreads(); }
        }
        else if (KON(5) && kind == 5) { pg8::EpiLruIn E{GATE, REC, ssb + 4 * M}; run_gemm(lds, XB, (const bf16*)(ws + WS_WLIN), 2 * R, D, E); }
        else if (KON(6) && kind == 6) { lru_phase<false>(lds, args, vcu, G, tid, YB); }
        else if (KON(7) && kind == 7) { lru_phase<true>(lds, args, vcu, G, tid, YB); }
        else if (KON(8)) { const int lane = tid & 63, wave = tid >> 6, gw = vcu * NWAVES + wave, NGW = G * NWAVES; const float* ss = ssb + 6 * M; const f32x4* gn = (const f32x4*)args.in[I_FINN] + lane;
            for (int m = gw; m < M; m += NGW) { const float rs = pg8::rstd_row(ss, m); f32x4* xr = (f32x4*)(args.out + (size_t)m * D) + lane;
#pragma unroll
                for (int j = 0; j < 4; ++j) { const f32x4 v = xr[64 * j]; xr[64 * j] = v * rs * gn[64 * j]; } } }
        if (pp + 1 < args.ph_hi) { if (pp == args.ph_lo) grid.sync(); else xcd_barrier(xbar); if (DUP_SYNC) xcd_barrier(xbar); }
    }
}

#ifndef MK_PER_PHASE_LAUNCH
#define MK_PER_PHASE_LAUNCH 0
#endif
extern "C" void kernel_launch(void* const* d_in, const int* in_sizes, int n_in, void* d_out, int out_size, void* d_ws, size_t ws_size, hipStream_t stream) {
    static int grid = 0;
    if (grid == 0) {
        if (n_in != 21 || in_sizes[0] != M * D || out_size != M * D || ws_size < WS_END) { fprintf(stderr, "kernel_launch: unexpected shapes (n_in %d, in0 %d, out %d, ws %zu); nothing launched\n", n_in, n_in > 0 ? in_sizes[0] : -1, out_size, ws_size); grid = -1; return; }
        int dev = 0, cus = 0, per_cu = 0;
        if (hipGetDevice(&dev) != hipSuccess || hipDeviceGetAttribute(&cus, hipDeviceAttributeMultiprocessorCount, dev) != hipSuccess) { grid = -1; return; }
        if (hipFuncSetAttribute((const void*)fwd_megakernel, hipFuncAttributeMaxDynamicSharedMemorySize, LDS_BYTES) != hipSuccess) { fprintf(stderr, "kernel_launch: hipFuncSetAttribute failed\n"); grid = -1; return; }
        if (hipOccupancyMaxActiveBlocksPerMultiprocessor(&per_cu, (const void*)fwd_megakernel, NWAVES * 64, LDS_BYTES) != hipSuccess || per_cu < 1) { fprintf(stderr, "kernel_launch: occupancy query says %d blocks per CU\n", per_cu); per_cu = 1; }
        (void)hipGetLastError();
        grid = cus * per_cu;
        if (grid != 256) fprintf(stderr, "kernel_launch: grid %d (this kernel's static unit orders assume 256 workgroups)\n", grid);
    }
    if (grid < 0) return;
    Args a{};
    for (int i = 0; i < 21; ++i) a.in[i] = (const float*)d_in[i];
    a.out = (float*)d_out; a.ws = (unsigned char*)d_ws;
    if (hipMemsetAsync((unsigned char*)d_ws + WS_BAR, 0, BAR_BYTES, stream) != hipSuccess) { fprintf(stderr, "kernel_launch: memset of the barrier words failed\n"); return; }
#if MK_PER_PHASE_LAUNCH
    for (int ph = 0; ph < N_PHASES; ++ph) { a.ph_lo = ph; a.ph_hi = ph + 1; hipLaunchKernelGGL(fwd_megakernel, dim3(grid), dim3(NWAVES * 64), LDS_BYTES, stream, a); }
#else
    a.ph_lo = 0; a.ph_hi = N_PHASES + ((DUP_PH >= 0) ? 1 : 0);
    void* kargs[] = {&a};
    const hipError_t e = hipLaunchCooperativeKernel((const void*)fwd_megakernel, dim3(grid), dim3(NWAVES * 64), kargs, LDS_BYTES, stream);
    if (e != hipSuccess) fprintf(stderr, "kernel_launch: cooperative launch failed: %s (grid %d)\n", hipGetErrorString(e), grid);
#endif
}
```

```cpp
#define DUP_PH -1
#define DUP_SYNC 0
#include <hip/hip_runtime.h>
#include <hip/hip_cooperative_groups.h>
#include <cstdio>
#include <cstdint>
namespace cg = cooperative_groups;
__device__ __forceinline__ int otid() { int t = (int)threadIdx.x; asm volatile("" : "+v"(t)); return t; }
__device__ __forceinline__ int osgpr(int v) { v = __builtin_amdgcn_readfirstlane(v); asm volatile("" : "+s"(v)); return v; }
namespace pg8 {
#define PG8_LAS __attribute__((address_space(3)))
typedef unsigned short bf16_t;
typedef short bf16x8 __attribute__((ext_vector_type(8)));
typedef float f32x4 __attribute__((ext_vector_type(4)));
typedef unsigned u32x4 __attribute__((ext_vector_type(4)));
constexpr int BM = 256, BK = 64, HALF = 128, HTB = HALF * BK * 2  , STAGE_BYTES = 8 * HTB, NXCD = 8, WGM = 8;

__host__ __device__ __forceinline__ int lds_byte(int r, int c) { const int st = (r >> 4) * 2 + (c >> 5), rr = r & 15, cc = c & 31, ob = rr * 64 + cc * 2; return st * 1024 + (ob ^ (((ob >> 9) & 1) << 5)); }
__host__ __device__ __forceinline__ void stage_rc(int b, int& R, int& C) { const int st = b / 1024, sb = b % 1024, swz = sb ^ (((sb >> 9) & 1) << 5); R = (st >> 1) * 16 + swz / 64; C = (st & 1) * 32 + (swz % 64) / 2; }
__host__ __device__ __forceinline__ int perm32(int rho) { const int n = rho >> 4, i = rho & 15; return 8 * (i >> 2) + 4 * n + (i & 3); }

struct Unit { int pm, pn; };
struct Gemm { const bf16_t* A; const bf16_t* Bt; int M, N, K; };

struct StaticOrder {
    int nM, nN, nwg, G, c;
    __host__ __device__ void init(int M, int N, int G_, int c_) { nM = M / BM; nN = N / BM; nwg = nM * nN; G = G_; c = c_; }
    __host__ __device__ bool next(int i, Unit& u) const {
        const long L = (long)i * G + c; if (L >= nwg) return false;
        int wgid = (int)L; { const int q = nwg / NXCD, r = nwg % NXCD, xcd = wgid % NXCD, off = wgid / NXCD; wgid = (xcd < r ? xcd * (q + 1) : r * (q + 1) + (xcd - r) * q) + off; }
        const int nig = WGM * nN, gid = wgid / nig, fm = gid * WGM, gsz = (nM - fm) < WGM ? (nM - fm) : WGM;
        u.pm = fm + ((wgid % nig) % gsz); u.pn = (wgid % nig) / gsz; return true;
    }
    __device__ __forceinline__ void a_ready(const Unit&) const {}
    __device__ __forceinline__ void done(const Unit&) const {}
};

__device__ __forceinline__ unsigned cvt_pk_bf16(float lo, float hi) { unsigned r; asm volatile("v_cvt_pk_bf16_f32 %0, %1, %2" : "=v"(r) : "v"(lo), "v"(hi)); return r; }
typedef float f32x2 __attribute__((ext_vector_type(2)));
__device__ __forceinline__ f32x2 gelu_pk(f32x2 v) {
    const f32x2 av = __builtin_elementwise_abs(v), d = av * 0.2316418882f + 1.0f;
    f32x2 t; t.x = __builtin_amdgcn_rcpf(d.x); t.y = __builtin_amdgcn_rcpf(d.y);
    f32x2 q = t * 0.5307027145f + (-0.7265760135f); q = q * t + 0.7107068705f; q = q * t + (-0.142248368f); q = q * t + 0.127414796f; q = q * t;
    const f32x2 s = (v * v) * (-0.72134752044f);
    f32x2 e; e.x = __builtin_amdgcn_exp2f(s.x); e.y = __builtin_amdgcn_exp2f(s.y);
    const f32x2 m = v * (q * e), r = v - m;
    f32x2 o; o.x = v.x < 0.f ? m.x : r.x; o.y = v.y < 0.f ? m.y : r.y; return o;
}

template <int ACT  > struct EpiBf16 {
    static constexpr bool PERM = true, AFTER_DRAIN = false; static_assert(ACT == 0 || ACT == 1, "EpiBf16: ACT is 0 (none) or 1 (gelu_pk)");
    bf16_t* O; int ldc; const float* bias; int split_cols; size_t split_stride; float scale0;
    __device__ __forceinline__ void operator()(const f32x4 (&acc)[2][2][4][2], const Unit& u, int wr, int wc, int fr, int fq) const {
        const int row0 = u.pm * BM + wr * 64 + fr; int colt = u.pn * BM; bf16_t* base = O;
        float sc = 1.f; if (split_cols) { const int t = colt / split_cols; base += (size_t)t * split_stride; colt -= t * split_cols; if (t == 0) sc = scale0; }
        const int col0 = colt + wc * 32 + 8 * fq, bcol0 = u.pn * BM + wc * 32 + 8 * fq;
        f32x4 bv[2][2];
#pragma unroll
        for (int bj = 0; bj < 2; ++bj)
#pragma unroll
            for (int n = 0; n < 2; ++n) bv[bj][n] = bias ? *(const f32x4*)(bias + bcol0 + bj * HALF + 4 * n) : (f32x4){0.f, 0.f, 0.f, 0.f};
#pragma unroll
        for (int ai = 0; ai < 2; ++ai)
#pragma unroll
            for (int m = 0; m < 4; ++m) { bf16_t* rowp = base + (size_t)(row0 + ai * HALF + m * 16) * ldc + col0;
#pragma unroll
                for (int bj = 0; bj < 2; ++bj) { f32x4 v0 = acc[ai][bj][m][0] + bv[bj][0], v1 = acc[ai][bj][m][1] + bv[bj][1];
                    if (ACT == 1) { f32x2 a = gelu_pk((f32x2){v0[0], v0[1]}), b = gelu_pk((f32x2){v0[2], v0[3]}), c = gelu_pk((f32x2){v1[0], v1[1]}), d = gelu_pk((f32x2){v1[2], v1[3]});
                        v0 = (f32x4){a.x, a.y, b.x, b.y}; v1 = (f32x4){c.x, c.y, d.x, d.y}; }
                    v0 = v0 * sc; v1 = v1 * sc; u32x4 w; w.x = cvt_pk_bf16(v0[0], v0[1]); w.y = cvt_pk_bf16(v0[2], v0[3]); w.z = cvt_pk_bf16(v1[0], v1[1]); w.w = cvt_pk_bf16(v1[2], v1[3]);
                    *(u32x4*)(rowp + bj * HALF) = w; } }
    }
};

typedef unsigned u32x2 __attribute__((ext_vector_type(2)));
__device__ __forceinline__ float rstd_row(const float* ss, int row) {
    const float s = __hip_atomic_load(ss + row, __ATOMIC_RELAXED, __HIP_MEMORY_SCOPE_AGENT);
    return 1.0f / sqrtf(s * (1.0f / 1024.0f) + 1e-6f);
}
__device__ __forceinline__ float fast_sigmoid(float v) { return __builtin_amdgcn_rcpf(1.0f + __builtin_amdgcn_exp2f(-1.4426950408889634f * v)); }
struct EpiSwiGLU {
    static constexpr bool PERM = true, AFTER_DRAIN = false;
    bf16_t* H; const float* ss;
    __device__ __forceinline__ void operator()(const f32x4 (&acc)[2][2][4][2], const Unit& u, int wr, int wc, int fr, int fq) const {
        const int hc0 = u.pn * 128 + wc * 32 + 8 * fq;
#pragma unroll
        for (int ai = 0; ai < 2; ++ai)
#pragma unroll
            for (int m = 0; m < 4; ++m) { const int row = u.pm * BM + ai * HALF + wr * 64 + m * 16 + fr; const float rs = rstd_row(ss, row);
                float hv[8];
#pragma unroll
                for (int n = 0; n < 2; ++n)
#pragma unroll
                    for (int e = 0; e < 4; ++e) { const float g = acc[ai][0][m][n][e] * rs, uu = acc[ai][1][m][n][e] * rs; hv[4 * n + e] = g * fast_sigmoid(g) * uu; }
                u32x4 w; w.x = cvt_pk_bf16(hv[0], hv[1]); w.y = cvt_pk_bf16(hv[2], hv[3]); w.z = cvt_pk_bf16(hv[4], hv[5]); w.w = cvt_pk_bf16(hv[6], hv[7]);
                *(u32x4*)(H + (size_t)row * 2816 + hc0) = w; }
    }
};
struct EpiResid {
    static constexpr bool PERM = false, AFTER_DRAIN = false;
    const float* xin; float* xout; bf16_t* xb; float* ss; float alpha;
    __device__ __forceinline__ void operator()(const f32x4 (&acc)[2][2][4][2], const Unit& u, int wr, int wc, int fr, int fq) const {
        const int col0 = u.pn * BM + wc * 32 + 4 * fq;
#pragma unroll
        for (int ai = 0; ai < 2; ++ai)
#pragma unroll
            for (int m = 0; m < 4; ++m) { const int row = u.pm * BM + ai * HALF + wr * 64 + m * 16 + fr; const size_t off = (size_t)row * 1024 + col0; float s = 0.f;
#pragma unroll
                for (int bj = 0; bj < 2; ++bj)
#pragma unroll
                    for (int n = 0; n < 2; ++n) { const f32x4 xi = *(const f32x4*)(xin + off + bj * HALF + n * 16); const f32x4 o = xi + acc[ai][bj][m][n] * alpha;
                        *(f32x4*)(xout + off + bj * HALF + n * 16) = o; s += (o[0] * o[0] + o[1] * o[1]) + (o[2] * o[2] + o[3] * o[3]);
                        u32x2 w; w.x = cvt_pk_bf16(o[0], o[1]); w.y = cvt_pk_bf16(o[2], o[3]); *(u32x2*)(xb + off + bj * HALF + n * 16) = w; }
                s += __shfl_xor(s, 16); s += __shfl_xor(s, 32);
                if (fq == 0) __hip_atomic_fetch_add(ss + row, s, __ATOMIC_RELAXED, __HIP_MEMORY_SCOPE_AGENT); }
    }
};
struct EpiQKV {
    static constexpr bool PERM = true, AFTER_DRAIN = false;
    bf16_t* Q; size_t split_stride; const float* ss; float scale0;
    __device__ __forceinline__ void operator()(const f32x4 (&acc)[2][2][4][2], const Unit& u, int wr, int wc, int fr, int fq) const {
        int colt = u.pn * BM; const int t = colt >> 10; bf16_t* base = Q + (size_t)t * split_stride; colt -= t << 10; const float sc = (t == 0) ? scale0 : 1.f;
        const int col0 = colt + wc * 32 + 8 * fq;
#pragma unroll
        for (int ai = 0; ai < 2; ++ai)
#pragma unroll
            for (int m = 0; m < 4; ++m) { const int row = u.pm * BM + ai * HALF + wr * 64 + m * 16 + fr; const float rs = rstd_row(ss, row) * sc; bf16_t* rowp = base + (size_t)row * 1024 + col0;
#pragma unroll
                for (int bj = 0; bj < 2; ++bj) { const f32x4 v0 = acc[ai][bj][m][0] * rs, v1 = acc[ai][bj][m][1] * rs;
                    u32x4 w; w.x = cvt_pk_bf16(v0[0], v0[1]); w.y = cvt_pk_bf16(v0[2], v0[3]); w.z = cvt_pk_bf16(v1[0], v1[1]); w.w = cvt_pk_bf16(v1[2], v1[3]);
                    *(u32x4*)(rowp + bj * HALF) = w; } }
    }
};
__device__ __forceinline__ float gelu_tanh(float v) { const float u2 = 1.5957691216057308f * (v + 0.044715f * v * v * v); return v * fast_sigmoid(u2); }
struct EpiLruIn {
    static constexpr bool PERM = true, AFTER_DRAIN = false;
    bf16_t* GATE; bf16_t* REC; const float* ss;
    __device__ __forceinline__ void operator()(const f32x4 (&acc)[2][2][4][2], const Unit& u, int wr, int wc, int fr, int fq) const {
        const bool isg = u.pn < 5; bf16_t* base = isg ? GATE : REC; const int col0 = (isg ? u.pn : u.pn - 5) * BM + wc * 32 + 8 * fq;
#pragma unroll
        for (int ai = 0; ai < 2; ++ai)
#pragma unroll
            for (int m = 0; m < 4; ++m) { const int row = u.pm * BM + ai * HALF + wr * 64 + m * 16 + fr; const float rs = rstd_row(ss, row); bf16_t* rowp = base + (size_t)row * 1280 + col0;
#pragma unroll
                for (int bj = 0; bj < 2; ++bj) { f32x4 v0 = acc[ai][bj][m][0] * rs, v1 = acc[ai][bj][m][1] * rs;
                    if (isg) {
#pragma unroll
                        for (int e = 0; e < 4; ++e) { v0[e] = gelu_tanh(v0[e]); v1[e] = gelu_tanh(v1[e]); } }
                    u32x4 w; w.x = cvt_pk_bf16(v0[0], v0[1]); w.y = cvt_pk_bf16(v0[2], v0[3]); w.z = cvt_pk_bf16(v1[0], v1[1]); w.w = cvt_pk_bf16(v1[2], v1[3]);
                    *(u32x4*)(rowp + bj * HALF) = w; } }
    }
};
template <class Epi, class Sched, bool ALIGN_EPI = false, bool SP2 = false>
__device__ __forceinline__ void gemm_phase(PG8_LAS unsigned char* lds, const Gemm g, const Sched& S, const Epi& E) {
    const int tid = otid(), wid = __builtin_amdgcn_readfirstlane(tid >> 6), lane = tid & 63, wr = wid >> 2, wc = wid & 3, fr = lane & 15, fq = lane >> 4;
    const int K = g.K, nt = K / BK;
    unsigned voffA[2], voffB[2];
#pragma unroll
    for (int i = 0; i < 2; ++i) { int R, C; stage_rc(tid * 16 + i * 8192, R, C); const int Rb = Epi::PERM ? ((R & ~31) + perm32(R & 31)) : R;
        voffA[i] = (unsigned)(R * K + C) * 2u; voffB[i] = (unsigned)(Rb * K + C) * 2u; }
    const size_t kstep = (size_t)(BK * 2);
    const size_t hstep = (size_t)HALF * K * 2;
    const size_t tstep = 2 * hstep;
    const unsigned ldsw = (unsigned)wid * 1024u;
    const int aoff = lds_byte(wr * 64 + fr, fq * 8), boff = lds_byte(wc * 32 + fr, fq * 8);
#define PG8_SA(b, h) (((b) * 2 + (h)) * HTB)
#define PG8_SB(b, h) ((4 + (b) * 2 + (h)) * HTB)
#define PG8_STAGE(bufoff, gbase, voff) do { _Pragma("unroll") for (int _i = 0; _i < 2; ++_i) \
        __builtin_amdgcn_global_load_lds((const unsigned*)((const char*)(gbase) + (voff)[_i]), (PG8_LAS unsigned*)(lds + (bufoff) + ldsw + _i * 8192), 16, 0, 0); } while (0)
#define PG8_LDA(dst, b, h) do { _Pragma("unroll") for (int m = 0; m < 4; ++m) _Pragma("unroll") for (int k = 0; k < 2; ++k) dst[m][k] = *(const PG8_LAS bf16x8*)(lds + PG8_SA(b, h) + aoff + m * 2048 + k * 1024); } while (0)
#define PG8_LDB(dst, b, h) do { _Pragma("unroll") for (int n = 0; n < 2; ++n) _Pragma("unroll") for (int k = 0; k < 2; ++k) dst[n][k] = *(const PG8_LAS bf16x8*)(lds + PG8_SB(b, h) + boff + n * 2048 + k * 1024); } while (0)
#define PG8_MMA(ai, bj, At, Bt) do { __builtin_amdgcn_s_setprio(1); _Pragma("unroll") for (int m = 0; m < 4; ++m) _Pragma("unroll") for (int n = 0; n < 2; ++n) _Pragma("unroll") for (int k = 0; k < 2; ++k) \
        acc[ai][bj][m][n] = __builtin_amdgcn_mfma_f32_16x16x32_bf16(Bt[n][k], At[m][k], acc[ai][bj][m][n], 0, 0, 0); __builtin_amdgcn_s_setprio(0); } while (0)
#define PG8_WAIT_V(n) asm volatile("s_waitcnt vmcnt(" #n ")" ::: "memory")
#define PG8_WAIT_L(n) asm volatile("s_waitcnt lgkmcnt(" #n ")" ::: "memory")
#define PG8_BAR __builtin_amdgcn_s_barrier()
#define PG8_SCHED __builtin_amdgcn_sched_barrier(0)
    Unit cur, nxt; int ui = 0;
    if (!S.next(0, cur)) return;
    f32x4 acc[2][2][4][2];
#pragma unroll
    for (int a = 0; a < 2; ++a)
#pragma unroll
        for (int b = 0; b < 2; ++b)
#pragma unroll
            for (int m = 0; m < 4; ++m)
#pragma unroll
                for (int n = 0; n < 2; ++n) acc[a][b][m][n] = (f32x4){0.f, 0.f, 0.f, 0.f};
    bf16x8 At[4][2], B0[2][2], B1[2][2];
    const char* cA = (const char*)g.A + (size_t)cur.pm * tstep; const char* cB = (const char*)g.Bt + (size_t)cur.pn * tstep;
    S.a_ready(cur);
    if constexpr (SP2) {
        PG8_STAGE(PG8_SB(0, 0), cB, voffB); PG8_STAGE(PG8_SB(0, 1), cB + hstep, voffB); PG8_STAGE(PG8_SA(0, 0), cA, voffA); PG8_STAGE(PG8_SA(0, 1), cA + hstep, voffA);
        if (wr == 1) PG8_BAR;
        PG8_WAIT_V(2); PG8_BAR;
        PG8_STAGE(PG8_SB(1, 0), cB + kstep, voffB); PG8_STAGE(PG8_SA(1, 0), cA + kstep, voffA); PG8_STAGE(PG8_SB(1, 1), cB + hstep + kstep, voffB);
        PG8_WAIT_V(6); PG8_BAR;
    } else {
        PG8_STAGE(PG8_SB(0, 0), cB, voffB); PG8_STAGE(PG8_SA(0, 0), cA, voffA); PG8_STAGE(PG8_SB(0, 1), cB + hstep, voffB); PG8_STAGE(PG8_SA(0, 1), cA + hstep, voffA);
        if (wr == 1) PG8_BAR;
        PG8_WAIT_V(4); PG8_BAR;
        PG8_STAGE(PG8_SB(1, 0), cB + kstep, voffB); PG8_STAGE(PG8_SA(1, 0), cA + kstep, voffA); PG8_STAGE(PG8_SB(1, 1), cB + hstep + kstep, voffB);
        PG8_WAIT_V(6); PG8_BAR;
    }
    for (;;) {
        const bool has_next = S.next(ui + 1, nxt);
        const char* nA = has_next ? (const char*)g.A + (size_t)nxt.pm * tstep : cA; const char* nB = has_next ? (const char*)g.Bt + (size_t)nxt.pn * tstep : cB;
        for (int t = 0; t < nt; t += 2) {
            const bool last = (t == nt - 2);
            const char* a1 = cA + (size_t)(t + 1) * kstep;
            const char* a2 = last ? nA : cA + (size_t)(t + 2) * kstep; const char* b2 = last ? nB : cB + (size_t)(t + 2) * kstep;
            const char* a3 = a2 + kstep; const char* b3 = b2 + kstep;
            if (last && has_next) S.a_ready(nxt);
            if constexpr (SP2) {
            PG8_LDB(B0, 0, 0); PG8_LDB(B1, 0, 1); PG8_SCHED; PG8_LDA(At, 0, 0); PG8_STAGE(PG8_SA(1, 1), a1 + hstep, voffA);
            PG8_WAIT_V(8); PG8_WAIT_L(0); PG8_BAR; PG8_MMA(0, 0, At, B0); PG8_MMA(0, 1, At, B1); PG8_BAR; PG8_SCHED;
            PG8_LDA(At, 0, 1); PG8_STAGE(PG8_SB(0, 0), b2, voffB); PG8_STAGE(PG8_SB(0, 1), b2 + hstep, voffB); PG8_STAGE(PG8_SA(0, 0), a2, voffA);
            PG8_WAIT_V(8); PG8_WAIT_L(0); PG8_BAR; PG8_MMA(1, 0, At, B0); PG8_MMA(1, 1, At, B1); PG8_BAR; PG8_SCHED;
            PG8_LDB(B0, 1, 0); PG8_LDB(B1, 1, 1); PG8_SCHED; PG8_LDA(At, 1, 0); PG8_STAGE(PG8_SA(0, 1), a2 + hstep, voffA);
            PG8_WAIT_V(8); PG8_WAIT_L(0); PG8_BAR; PG8_MMA(0, 0, At, B0); PG8_MMA(0, 1, At, B1); PG8_BAR; PG8_SCHED;
            PG8_LDA(At, 1, 1); PG8_STAGE(PG8_SB(1, 0), b3, voffB); PG8_STAGE(PG8_SB(1, 1), b3 + hstep, voffB); PG8_STAGE(PG8_SA(1, 0), a3, voffA);
            PG8_WAIT_V(8); PG8_WAIT_L(0); PG8_BAR; PG8_MMA(1, 0, At, B0); PG8_MMA(1, 1, At, B1); PG8_BAR; PG8_SCHED;
            } else {
            PG8_LDB(B0, 0, 0); PG8_SCHED; PG8_LDA(At, 0, 0); PG8_STAGE(PG8_SA(1, 1), a1 + hstep, voffA);
            PG8_WAIT_L(8); PG8_BAR; PG8_WAIT_L(0); PG8_MMA(0, 0, At, B0); PG8_BAR; PG8_SCHED;
            PG8_LDB(B1, 0, 1); PG8_STAGE(PG8_SB(0, 0), b2, voffB);
            PG8_BAR; PG8_WAIT_L(0); PG8_MMA(0, 1, At, B1); PG8_BAR;
            PG8_LDA(At, 0, 1); PG8_STAGE(PG8_SA(0, 0), a2, voffA);
            PG8_BAR; PG8_WAIT_L(0); PG8_MMA(1, 0, At, B0); PG8_BAR; PG8_SCHED;
            PG8_STAGE(PG8_SB(0, 1), b2 + hstep, voffB);
            PG8_WAIT_V(6); PG8_BAR; PG8_MMA(1, 1, At, B1); PG8_BAR;
            PG8_LDB(B0, 1, 0); PG8_SCHED; PG8_LDA(At, 1, 0); PG8_STAGE(PG8_SA(0, 1), a2 + hstep, voffA);
            PG8_WAIT_L(8); PG8_BAR; PG8_WAIT_L(0); PG8_MMA(0, 0, At, B0); PG8_BAR; PG8_SCHED;
            PG8_LDB(B1, 1, 1); PG8_STAGE(PG8_SB(1, 0), b3, voffB);
            PG8_BAR; PG8_WAIT_L(0); PG8_MMA(0, 1, At, B1); PG8_BAR;
            PG8_LDA(At, 1, 1); PG8_STAGE(PG8_SA(1, 0), a3, voffA);
            PG8_BAR; PG8_WAIT_L(0); PG8_MMA(1, 0, At, B0); PG8_BAR; PG8_SCHED;
            PG8_STAGE(PG8_SB(1, 1), b3 + hstep, voffB);
            PG8_WAIT_V(6); PG8_BAR; PG8_MMA(1, 1, At, B1); PG8_BAR;
            }
        }
        if constexpr (ALIGN_EPI) { if (wr == 0) PG8_BAR; }
        if constexpr (!Epi::AFTER_DRAIN) { E(acc, cur, wr, wc, fr, fq); S.done(cur); }
        if (!has_next) break;
#pragma unroll
        for (int a = 0; a < 2; ++a)
#pragma unroll
            for (int b = 0; b < 2; ++b)
#pragma unroll
                for (int m = 0; m < 4; ++m)
#pragma unroll
                    for (int n = 0; n < 2; ++n) acc[a][b][m][n] = (f32x4){0.f, 0.f, 0.f, 0.f};
        cur = nxt; cA = nA; cB = nB; ++ui;
        if constexpr (ALIGN_EPI) { if (wr == 1) PG8_BAR; }
    }
    PG8_WAIT_V(0);
    if constexpr (!ALIGN_EPI) { if (wr == 0) PG8_BAR; }
    PG8_BAR;
    if constexpr (Epi::AFTER_DRAIN) { E.fused(acc, cur, wr, wc, fr, fq, lds, wid, lane); S.done(cur); }
#undef PG8_SA
#undef PG8_SB
#undef PG8_STAGE
#undef PG8_LDA
#undef PG8_LDB
#undef PG8_MMA
#undef PG8_WAIT_V
#undef PG8_WAIT_L
#undef PG8_BAR
#undef PG8_SCHED
}
}

#ifndef PG8_SP2
#define PG8_SP2 true
#endif
#ifndef PG8_ALIGN
#define PG8_ALIGN true
#endif
#include <hip/hip_bf16.h>
#include <cmath>
namespace attn_body {
using bf16=__hip_bfloat16;
using bf16x8=__attribute__((ext_vector_type(8)))short;
using s16x4=__attribute__((ext_vector_type(4)))short;
using f32x16=__attribute__((ext_vector_type(16)))float;
using u32x4=__attribute__((ext_vector_type(4)))unsigned;
constexpr int BATCH=2,NHEAD=16,SEQ=8192,D=64,DM=NHEAD*D;
constexpr int NW=8,QBLK=32,QB=QBLK*NW,KVBLK=64,NQB=SEQ/QB;
constexpr int ATTN_PITCH=DM, ATTN_UNIT_ROWS=QB;
__device__ __forceinline__ int crow(int r,int hi){return (r&3)+8*(r>>2)+4*hi;}
#define SBAR() __builtin_amdgcn_sched_barrier(0)
__device__ __forceinline__ void cmask(f32x16&p0,f32x16&p1,int jb,int qrel,int hi){
  const float NEG=-INFINITY; int kb=64*jb+4*hi;
  #pragma unroll
  for(int r=0;r<16;++r){int kv=kb+(r&3)+8*(r>>2); if(kv>qrel)p0[r]=NEG; if(kv+32>qrel)p1[r]=NEG;}
}

constexpr int NSLOT=3, SLOTB=8192;
constexpr int LDS_K=0, LDS_V=NSLOT*SLOTB, LDS_WS=2*NSLOT*SLOTB, LDS_OST=LDS_WS+NW*64*4, LDS_BYTES=LDS_OST+NW*4096;
constexpr float C2=0.125f*1.4426950408889634f;
__device__ __forceinline__ void glds16(const void*gsrc,unsigned lds_dst){unsigned keep;
  asm volatile("s_mov_b32 %0, m0\n\ts_mov_b32 m0, %2\n\ts_nop 0\n\tglobal_load_lds_dwordx4 %1, off\n\ts_mov_b32 m0, %0":"=&s"(keep):"v"(gsrc),"s"(lds_dst):"memory");}
__device__ __forceinline__ float max3f(float a,float b,float c){float r;asm("v_max3_f32 %0, %1, %2, %3":"=v"(r):"v"(a),"v"(b),"v"(c));return r;}
__device__ __forceinline__ float max2f(float a,float b){float r;asm("v_max_f32_e32 %0, %1, %2":"=v"(r):"v"(a),"v"(b));return r;}
__device__ __forceinline__ float fadd_s(float a,float b){float r;asm("v_add_f32_e32 %0, %1, %2":"=v"(r):"v"(a),"v"(b));return r;}
__device__ __forceinline__ float fsub_s(float a,float b){float r;asm("v_sub_f32_e32 %0, %1, %2":"=v"(r):"v"(a),"v"(b));return r;}
typedef float f32x2_t __attribute__((ext_vector_type(2))); typedef __bf16 bf16x2_t __attribute__((ext_vector_type(2)));
__device__ __forceinline__ unsigned cvtpk_s(float lo,float hi){f32x2_t v={lo,hi};bf16x2_t b=__builtin_convertvector(v,bf16x2_t);return __builtin_bit_cast(unsigned,b);}
#define WAIT_BAR(N) asm volatile("s_waitcnt vmcnt(" #N ") lgkmcnt(0)\n\ts_barrier":::"memory")

typedef __attribute__((address_space(3))) const float* lds_fptr; typedef float f32x4_t __attribute__((ext_vector_type(4))); typedef __attribute__((address_space(3))) const f32x4_t* lds_f4ptr;
__device__ __forceinline__ void qkt(f32x16&p0,f32x16&p1,const char*Kslot,const bf16x8*qr,int r32,int hi){
  const char*kb=Kslot+hi*1024+r32*16;
  #pragma unroll
  for(int d0=0;d0<4;++d0){
    const bf16x8 b0=*reinterpret_cast<const bf16x8*>(kb+d0*2048);
    const bf16x8 b1=*reinterpret_cast<const bf16x8*>(kb+d0*2048+512);
    p0=__builtin_amdgcn_mfma_f32_32x32x16_bf16(b0,qr[d0],p0,0,0,0);p1=__builtin_amdgcn_mfma_f32_32x32x16_bf16(b1,qr[d0],p1,0,0,0);}
}
typedef __attribute__((address_space(3))) const char* lds_cptr;
typedef short v4i16_t __attribute__((ext_vector_type(4)));
__device__ __forceinline__ void kload8(bf16x8*kf,lds_cptr kp){
  kf[0]=*(const __attribute__((address_space(3))) bf16x8*)(kp);      kf[1]=*(const __attribute__((address_space(3))) bf16x8*)(kp+512);
  kf[2]=*(const __attribute__((address_space(3))) bf16x8*)(kp+2048); kf[3]=*(const __attribute__((address_space(3))) bf16x8*)(kp+2560);
  kf[4]=*(const __attribute__((address_space(3))) bf16x8*)(kp+4096); kf[5]=*(const __attribute__((address_space(3))) bf16x8*)(kp+4608);
  kf[6]=*(const __attribute__((address_space(3))) bf16x8*)(kp+6144); kf[7]=*(const __attribute__((address_space(3))) bf16x8*)(kp+6656);
}
__device__ __forceinline__ void kload2(bf16x8*kf,lds_cptr kp,int j){ kf[2*j]=*(const __attribute__((address_space(3))) bf16x8*)(kp+j*2048); kf[2*j+1]=*(const __attribute__((address_space(3))) bf16x8*)(kp+j*2048+512); }
__device__ __forceinline__ s16x4 vtr(lds_cptr p){ return __builtin_bit_cast(s16x4,__builtin_amdgcn_ds_read_tr16_b64_v4i16((__attribute__((address_space(3))) v4i16_t*)p)); }
__device__ __forceinline__ float rowmax(const f32x16&p0,const f32x16&p1){
  float a=max3f(p0[0],p0[1],p1[0]),b=max3f(p0[2],p0[3],p1[1]);a=max3f(a,p1[2],p1[3]);
  #pragma unroll
  for(int r=4;r<16;r+=4){a=max3f(a,p0[r],p0[r+1]);b=max3f(b,p0[r+2],p0[r+3]);a=max3f(a,p1[r],p1[r+1]);b=max3f(b,p1[r+2],p1[r+3]);}
  const float m=max2f(a,b);
  auto rr=__builtin_amdgcn_permlane32_swap(__float_as_uint(m),__float_as_uint(m),false,false);
  return max2f(__uint_as_float(rr[0]),__uint_as_float(rr[1]));
}
__device__ __forceinline__ void pv(f32x16*o,int vb,bf16x8 pa0,bf16x8 pa1,bf16x8 pa2,bf16x8 pa3){
  #pragma unroll
  for(int d0=0;d0<2;++d0){s16x4 lo[4],hi[4];
    #pragma unroll
    for(int ks=0;ks<4;++ks){
      asm volatile("ds_read_b64_tr_b16 %0,%1 offset:%c2":"=&v"(lo[ks]):"v"(vb),"i"(d0*4096+ks*1024):"memory");
      asm volatile("ds_read_b64_tr_b16 %0,%1 offset:%c2":"=&v"(hi[ks]):"v"(vb),"i"(d0*4096+ks*1024+512):"memory");}
    asm volatile("s_waitcnt lgkmcnt(0)":::"memory");SBAR();
    #define PK(k) (bf16x8){lo[k][0],lo[k][1],lo[k][2],lo[k][3],hi[k][0],hi[k][1],hi[k][2],hi[k][3]}
    o[d0]=__builtin_amdgcn_mfma_f32_32x32x16_bf16(pa0,PK(0),o[d0],0,0,0);
    o[d0]=__builtin_amdgcn_mfma_f32_32x32x16_bf16(pa1,PK(1),o[d0],0,0,0);
    o[d0]=__builtin_amdgcn_mfma_f32_32x32x16_bf16(pa2,PK(2),o[d0],0,0,0);
    o[d0]=__builtin_amdgcn_mfma_f32_32x32x16_bf16(pa3,PK(3),o[d0],0,0,0);
    #undef PK
  }
}

#ifndef ATTN_STORE16
#define ATTN_STORE16(p,v) (*(u32x4*)(p)=(v))
#endif
template<int THRL> __device__ __forceinline__ void attn_unit(int b,int h,int qb,const bf16*Q,const bf16*__restrict__ K,const bf16*__restrict__ V,bf16*O,char*shm,lds_fptr Gp){
  const int tid=otid(),lane=tid&63,r32=lane&31,hi=lane>>5; const int wid=__builtin_amdgcn_readfirstlane(tid>>6);
  const long rowbase=(long)b*SEQ; const int q0=qb*QB;
  const bf16*Qw=Q+(rowbase+q0+wid*QBLK)*DM+h*D;
  const bf16*Kh=K+rowbase*DM+h*D,*Vh=V+rowbase*DM+h*D;
  const unsigned lds0=(unsigned)(uintptr_t)shm;
  float*wsf=(float*)(shm+LDS_WS)+wid*64;
  const bf16*ksrc=Kh+(long)lane*DM+wid*8;
  const bf16*vsrc=Vh+(long)(16*(wid&3)+(lane>>2))*DM+(wid>>2)*32+(lane&3)*8;
  const unsigned kdst=lds0+LDS_K+wid*1024, vdst=lds0+LDS_V+wid*1024;
  #define DMA_K(t,slot) glds16(ksrc+(long)(t)*KVBLK*DM,(unsigned)__builtin_amdgcn_readfirstlane(kdst+(slot)))
  #define DMA_V(t,slot) glds16(vsrc+(long)(t)*KVBLK*DM,(unsigned)__builtin_amdgcn_readfirstlane(vdst+(slot)))
  const int vb0=(int)(lds0+LDS_V)+((lane>>4)&1)*32+(lane&3)*8+(4*hi+((lane&15)>>2))*64;
  const char*Kbase=shm+LDS_K; bf16x8 kf[8];
  const lds_cptr shm3=(lds_cptr)shm; const lds_cptr kp0=shm3+LDS_K+hi*1024+r32*16; const lds_cptr vp0=shm3+LDS_V+((lane>>4)&1)*32+(lane&3)*8+(4*hi+((lane&15)>>2))*64;
  const int NT=(q0+QB)/KVBLK;
  DMA_K(0,0);DMA_V(0,0);DMA_K(1,SLOTB);
  bf16x8 qr[4];
  #pragma unroll
  for(int d0=0;d0<4;++d0)qr[d0]=*reinterpret_cast<const bf16x8*>(&Qw[(long)r32*DM+d0*16+hi*8]);
  float mhat=0.f,l_reg=0.f;f32x16 o[2];o[0]=f32x16{};o[1]=f32x16{};
  const float Gq=Gp[q0+wid*QBLK+r32]; float negmq=Gq;
  #define BIAS_LD(X0,X1,t) do{ const lds_f4ptr gp_=(lds_f4ptr)(Gp+64*(t)+4*hi); _Pragma("unroll") for(int j_=0;j_<4;++j_){ const f32x4_t a_=gp_[2*j_], b_=gp_[8+2*j_]; \
      X0[4*j_]=a_[0];X0[4*j_+1]=a_[1];X0[4*j_+2]=a_[2];X0[4*j_+3]=a_[3]; X1[4*j_]=b_[0];X1[4*j_+1]=b_[1];X1[4*j_+2]=b_[2];X1[4*j_+3]=b_[3]; } }while(0)
  #define BSUB4(X,B) do{ X[B]=negmq-X[B]; X[(B)+1]=negmq-X[(B)+1]; X[(B)+2]=negmq-X[(B)+2]; X[(B)+3]=negmq-X[(B)+3]; }while(0)
  #define BSUBALL(X0,X1) do{ _Pragma("unroll") for(int r_=0;r_<16;++r_){ X0[r_]=negmq-X0[r_]; X1[r_]=negmq-X1[r_]; } }while(0)
  const int qrel=wid*QBLK+r32;
  #define CMASK(P0,P1,t) do{int jb_=(t)-(NT-4); if(jb_>=0)cmask(P0,P1,jb_,qrel,hi);}while(0)
  bool resc=false;
  #define START(P0,P1) do{ const float rm=rowmax(P0,P1); resc=false; \
    { const float dl=__builtin_fmaxf(rm,-40.f); mhat=fadd_s(mhat,dl); \
      _Pragma("unroll") for(int r=0;r<16;++r){P0[r]=fsub_s(P0[r],dl);P1[r]=fsub_s(P1[r],dl);} \
      negmq=Gq-mhat; } \
    _Pragma("unroll") for(int r=0;r<16;++r)P0[r]=__builtin_amdgcn_exp2f(P0[r]); }while(0)
  #define RESC() do{ if(resc){ asm volatile("s_waitcnt lgkmcnt(0)":::"memory"); \
      _Pragma("unroll") for(int d_=0;d_<2;++d_) _Pragma("unroll") for(int r=0;r<16;++r)o[d_][r]*=wsf[crow(r,hi)]; } }while(0)
  f32x16 pA0,pA1,pB0,pB1;
  int sl_prev=0,sl_cur=0,sl_next=SLOTB;
  #define ROT() do{sl_prev=sl_cur;sl_cur=sl_next;sl_next=(sl_next==(NSLOT-1)*SLOTB)?0:sl_next+SLOTB;}while(0)
  DMA_K(2,2*SLOTB);
  WAIT_BAR(3);
  BIAS_LD(pA0,pA1,0); BSUBALL(pA0,pA1);
  qkt(pA0,pA1,Kbase,qr,r32,hi);asm volatile("s_nop 15\n\ts_nop 7":"+v"(pA0),"+v"(pA1));CMASK(pA0,pA1,0);
  START(pA0,pA1);
  _Pragma("unroll") for(int r=0;r<16;++r)pA1[r]=__builtin_amdgcn_exp2f(pA1[r]);
  BIAS_LD(pB0,pB1,1); BSUBALL(pB0,pB1);
  WAIT_BAR(0);
  DMA_K(3,0);DMA_V(1,SLOTB);
  ROT();
  kload8(kf,kp0+sl_cur);
  WAIT_BAR(2);
  s16x4 vlo[8],vhi[8]; u32x4 pw0,pw1,pw2,pw3;
  #define PKW(P,B) cvtpk_s(P[B],P[B+1])
  #define PAF(k) __builtin_bit_cast(bf16x8,pw##k)
  #define VFR(i) (bf16x8){vlo[i][0],vlo[i][1],vlo[i][2],vlo[i][3],vhi[i][0],vhi[i][1],vhi[i][2],vhi[i][3]}
  #define PIN(x) asm volatile("":"+v"(x))
  #define MX3(a,b,c) __builtin_fmaxf(__builtin_fmaxf((a),(b)),(c))
  #define GAPA(MF,A0,A1,A2,A3,W0,W1,PW) do{ MF; sacc+=A0; sacc+=A1; sacc+=A2; sacc+=A3; PIN(sacc); W0; W1; PIN(PW); SBAR(); }while(0)
  #define EX(v) __builtin_amdgcn_exp2f(v)
  #define GAPB(MF,X,B,GL_,Y,YB) do{ MF; X[B]=EX(X[B]); X[B+1]=EX(X[B+1]); X[B+2]=EX(X[B+2]); X[B+3]=EX(X[B+3]); PIN(X); if(GL_){ BSUB4(Y,YB); PIN(Y); } SBAR(); }while(0)
  #define VRD(i) do{ vlo[i]=vtr(vp_+(((i)>>2)*4096+((i)&3)*1024)); vhi[i]=vtr(vp_+(((i)>>2)*4096+((i)&3)*1024+512)); }while(0)
  #define KRD(G,j) do{ if(G){ kload2(kf,kp0+sl_next,j); SBAR(); } }while(0)
  #define STEP(C0,C1,P0,P1,t,GK,GV,GL) do{ SBAR(); \
    const lds_cptr vp_=vp0+sl_prev; \
    VRD(0); SBAR(); float sacc=(P0[0]+P0[1]); \
    GAPA(C0=__builtin_amdgcn_mfma_f32_32x32x16_bf16(kf[0],qr[0],C0,0,0,0), P0[2],P0[3],P0[4],P0[5],     pw0[0]=PKW(P0,0), pw0[1]=PKW(P0,2), pw0); \
    VRD(4); SBAR(); GAPA(C1=__builtin_amdgcn_mfma_f32_32x32x16_bf16(kf[1],qr[0],C1,0,0,0), P0[6],P0[7],P0[8],P0[9],     pw0[2]=PKW(P0,4), pw0[3]=PKW(P0,6), pw0); \
    VRD(1); SBAR(); GAPA(C0=__builtin_amdgcn_mfma_f32_32x32x16_bf16(kf[2],qr[1],C0,0,0,0),   P0[10],P0[11],P0[12],P0[13], pw1[0]=PKW(P0,8), pw1[1]=PKW(P0,10), pw1); \
    VRD(5); SBAR(); GAPA(C1=__builtin_amdgcn_mfma_f32_32x32x16_bf16(kf[3],qr[1],C1,0,0,0),   P0[14],P0[15],P1[0],P1[1],   pw1[2]=PKW(P0,12),pw1[3]=PKW(P0,14), pw1); \
    VRD(2); SBAR(); GAPA(C0=__builtin_amdgcn_mfma_f32_32x32x16_bf16(kf[4],qr[2],C0,0,0,0),   P1[2],P1[3],P1[4],P1[5],     pw2[0]=PKW(P1,0), pw2[1]=PKW(P1,2), pw2); \
    VRD(6); SBAR(); GAPA(C1=__builtin_amdgcn_mfma_f32_32x32x16_bf16(kf[5],qr[2],C1,0,0,0),   P1[6],P1[7],P1[8],P1[9],     pw2[2]=PKW(P1,4), pw2[3]=PKW(P1,6), pw2); \
    VRD(3); SBAR(); GAPA(C0=__builtin_amdgcn_mfma_f32_32x32x16_bf16(kf[6],qr[3],C0,0,0,0),   P1[10],P1[11],P1[12],P1[13], pw3[0]=PKW(P1,8), pw3[1]=PKW(P1,10), pw3); \
    VRD(7); SBAR(); GAPA(C1=__builtin_amdgcn_mfma_f32_32x32x16_bf16(kf[7],qr[3],C1,0,0,0),   P1[14],P1[15],0.f,0.f,       pw3[2]=PKW(P1,12),pw3[3]=PKW(P1,14), pw3); \
    l_reg+=sacc; \
    if(GK){DMA_K((t)+3,sl_cur);} if(GV){DMA_V((t)+1,sl_next);} \
    CMASK(C0,C1,t); \
    { float a=MX3(C0[0],C0[1],C1[0]),b=MX3(C0[2],C0[3],C1[1]); a=MX3(a,C1[2],C1[3]); \
      _Pragma("unroll") for(int r=4;r<16;r+=4){a=MX3(a,C0[r],C0[r+1]);b=MX3(b,C0[r+2],C0[r+3]);a=MX3(a,C1[r],C1[r+1]);b=MX3(b,C1[r+2],C1[r+3]);} \
      float rm=__builtin_fmaxf(a,b); { auto rr=__builtin_amdgcn_permlane32_swap(__float_as_uint(rm),__float_as_uint(rm),false,false); rm=__builtin_fmaxf(__uint_as_float(rr[0]),__uint_as_float(rr[1])); } \
      resc=false; \
      if(__builtin_expect(__any(rm>(float)THRL),0)){ const float dl=__builtin_fmaxf(rm,0.f); mhat+=dl; \
        _Pragma("unroll") for(int r=0;r<16;++r){C0[r]-=dl;C1[r]-=dl;} \
        negmq=Gq-mhat; \
        const float f=__builtin_amdgcn_exp2f(-dl); l_reg*=f; if(hi==0)wsf[r32]=f; resc=true; } } \
    if(GL){ BIAS_LD(P0,P1,(t)+1); } \
    SBAR(); \
    GAPB(o[0]=__builtin_amdgcn_mfma_f32_32x32x16_bf16(PAF(0),VFR(0),o[0],0,0,0), C0,0, GL,P0,0); \
    GAPB(o[1]=__builtin_amdgcn_mfma_f32_32x32x16_bf16(PAF(0),VFR(4),o[1],0,0,0), C0,4, GL,P0,4); \
    KRD(GL,0); GAPB(o[0]=__builtin_amdgcn_mfma_f32_32x32x16_bf16(PAF(1),VFR(1),o[0],0,0,0), C0,8, GL,P0,8); \
    KRD(GL,1); GAPB(o[1]=__builtin_amdgcn_mfma_f32_32x32x16_bf16(PAF(1),VFR(5),o[1],0,0,0), C0,12, GL,P0,12); \
    KRD(GL,2); GAPB(o[0]=__builtin_amdgcn_mfma_f32_32x32x16_bf16(PAF(2),VFR(2),o[0],0,0,0), C1,0, GL,P1,0); \
    KRD(GL,3); GAPB(o[1]=__builtin_amdgcn_mfma_f32_32x32x16_bf16(PAF(2),VFR(6),o[1],0,0,0), C1,4, GL,P1,4); \
    GAPB(o[0]=__builtin_amdgcn_mfma_f32_32x32x16_bf16(PAF(3),VFR(3),o[0],0,0,0), C1,8, GL,P1,8); \
    GAPB(o[1]=__builtin_amdgcn_mfma_f32_32x32x16_bf16(PAF(3),VFR(7),o[1],0,0,0), C1,12, GL,P1,12); \
    }while(0)
  int t=1;
  #undef CMASK
  #define CMASK(P0,P1,t) do{}while(0)
  for(;t+5<NT;t+=2){
    STEP(pB0,pB1,pA0,pA1,t,true,true,true);     WAIT_BAR(2); RESC(); ROT();
    STEP(pA0,pA1,pB0,pB1,t+1,true,true,true);   WAIT_BAR(2); RESC(); ROT();
  }
  #undef CMASK
  #define CMASK(P0,P1,t) do{int jb_=(t)-(NT-4); if(jb_>=0)cmask(P0,P1,jb_,qrel,hi);}while(0)
  #define ENDW(tt) do{ if((tt)+3<NT){WAIT_BAR(2);} else if((tt)+2<NT){WAIT_BAR(1);} else {WAIT_BAR(0);} }while(0)
  for(;t+1<NT;t+=2){
    STEP(pB0,pB1,pA0,pA1,t,(t+3<NT),(t+1<NT),(t+1<NT));       ENDW(t);   RESC(); ROT();
    STEP(pA0,pA1,pB0,pB1,t+1,(t+4<NT),(t+2<NT),(t+2<NT));     ENDW(t+1); RESC(); ROT();
  }
  STEP(pB0,pB1,pA0,pA1,NT-1,false,false,false); RESC();
  { float sacc=pB0[0]+pB0[1]; _Pragma("unroll") for(int r=2;r<16;++r)sacc+=pB0[r]; _Pragma("unroll") for(int r=0;r<16;++r)sacc+=pB1[r]; l_reg+=sacc;
    pw0=(u32x4){PKW(pB0,0),PKW(pB0,2),PKW(pB0,4),PKW(pB0,6)};pw1=(u32x4){PKW(pB0,8),PKW(pB0,10),PKW(pB0,12),PKW(pB0,14)};pw2=(u32x4){PKW(pB1,0),PKW(pB1,2),PKW(pB1,4),PKW(pB1,6)};pw3=(u32x4){PKW(pB1,8),PKW(pB1,10),PKW(pB1,12),PKW(pB1,14)};
    SBAR(); pv(o,vb0+sl_cur,PAF(0),PAF(1),PAF(2),PAF(3)); }
  #undef PKW
  #undef PAF
  #undef VFR
  #undef PIN
  #undef MX3
  #undef GAPA
  #undef GAPB
  #undef EX
  #undef VRD
  #undef KRD
  #undef STEP
  #undef ENDW
  {auto rr=__builtin_amdgcn_permlane32_swap(__float_as_uint(l_reg),__float_as_uint(l_reg),false,false);l_reg=__uint_as_float(rr[0])+__uint_as_float(rr[1]);}
  if(hi==0)wsf[32+r32]=l_reg;asm volatile("s_waitcnt lgkmcnt(0)":::"memory");
  float rli[16];
  #pragma unroll
  for(int r=0;r<16;++r)rli[r]=__builtin_amdgcn_rcpf(wsf[32+crow(r,hi)]);
  bf16*Ow=O+(rowbase+q0+wid*QBLK)*DM+h*D;
  { bf16*stg=(bf16*)(shm+LDS_OST)+wid*2048;
    #pragma unroll
    for(int r=0;r<16;++r){const int orow=crow(r,hi);
      #pragma unroll
      for(int d0=0;d0<2;++d0)stg[orow*64+d0*32+r32]=__float2bfloat16(o[d0][r]*rli[r]);}
    asm volatile("s_waitcnt lgkmcnt(0)":::"memory");
    #pragma unroll
    for(int i=0;i<4;++i){const int row=i*8+(lane>>3),ch=lane&7; const u32x4 v=*(const u32x4*)(stg+row*64+ch*8); ATTN_STORE16(Ow+(long)row*DM+ch*8,v);} }
  asm volatile("s_waitcnt lgkmcnt(0)\n\ts_barrier":::"memory");
  #undef DMA_K
  #undef BIAS_LD
  #undef BSUB4
  #undef BSUBALL
  #undef DMA_V
  #undef CMASK
  #undef START
  #undef RESC
  #undef ROT
}
constexpr int ATTN_LDS_BYTES=LDS_BYTES;
#undef SBAR
#undef WAIT_BAR
}
#define GAS __attribute__((address_space(1)))
#define LAS __attribute__((address_space(3)))
typedef unsigned short bf16;
typedef unsigned v4u __attribute__((ext_vector_type(4)));
typedef float f32x4 __attribute__((ext_vector_type(4)));
typedef float f32x2 __attribute__((ext_vector_type(2)));
typedef short bf16x8 __attribute__((ext_vector_type(8)));
constexpr int NWAVES = 8;
constexpr int M = 16384, D = 1024, T = 8192, FF = 2816, NGU = 5632, R = 1280, NH = 16, NQKV = 3072, NFOX = 3088;
constexpr size_t MiB = 1u << 20;
constexpr size_t WS_SS = 0;
constexpr size_t WS_LOGF = 1 * MiB;
constexpr size_t WS_LSUM = 2 * MiB;
constexpr size_t WS_WF = 5 * MiB;
constexpr size_t WS_WLG = 5 * MiB + 512 * 1024;
constexpr size_t WS_SP = 6 * MiB;
constexpr size_t WS_WGU = 8 * MiB, WGU_BYTES = 11 * MiB;
constexpr size_t WS_WD = 52 * MiB, WD_BYTES = 5 * MiB + 512 * 1024;
constexpr size_t WS_WQKV = 74 * MiB, WS_WO = 80 * MiB, WS_WLIN = 82 * MiB, WS_WLOUT = 87 * MiB;
constexpr size_t WS_XB = 90 * MiB;
constexpr size_t WS_BIG = 122 * MiB;
constexpr size_t WS_END = 218 * MiB;
constexpr int LDS_BYTES = 147456;
constexpr float LOG2E = 1.4426950408889634f;

__device__ __forceinline__ unsigned f2bf(float f) { unsigned u = __builtin_bit_cast(unsigned, f); return (u + 0x7fffu + ((u >> 16) & 1u)) >> 16; }
__device__ __forceinline__ unsigned pk2(float lo, float hi) { return f2bf(lo) | (f2bf(hi) << 16); }
__device__ __forceinline__ float bf2f(unsigned short b) { return __builtin_bit_cast(float, (unsigned)b << 16); }
__device__ __forceinline__ float wave_sum(float v) {
#pragma unroll
    for (int o = 1; o < 64; o <<= 1) v += __shfl_xor(v, o);
    return v;
}

#define XB_TMO      128
#define XB_XCNT(j)  (256  + 64 * (j))
#define XB_XSUB(j)  (1280 + 64 * (j))
#define XB_XGEN(j)  (2304 + 64 * (j))
#define XB_TOP      3328
#define XB_TOPGEN   3392
#define XCD_BAR_WORDS 3456
#define XB_SPIN_CAP (1u << 18)

__device__ __forceinline__ unsigned xb_ld(unsigned* p)              { return __hip_atomic_load(p, __ATOMIC_RELAXED, __HIP_MEMORY_SCOPE_AGENT); }
__device__ __forceinline__ unsigned xb_add(unsigned* p, unsigned v) { return __hip_atomic_fetch_add(p, v, __ATOMIC_RELAXED, __HIP_MEMORY_SCOPE_AGENT); }
__device__ __forceinline__ unsigned xb_xcc_id() { return (unsigned)__builtin_amdgcn_s_getreg((3 << 11) | 20) & 0xFu; }
#define XB_SPIN(cond, bar) do { unsigned _sp = 0; while (cond) { __builtin_amdgcn_s_sleep(1); \
    if ((++_sp & 255u) == 0u) { if (xb_ld(&(bar)[XB_TMO])) break; if (_sp > XB_SPIN_CAP) { atomicAdd(&(bar)[XB_TMO], 1u); break; } } } } while (0)

struct XcdBarrier {
    unsigned* bar; unsigned x;
    volatile LAS unsigned* st;
};

__device__ __forceinline__ XcdBarrier xcd_barrier_post(unsigned* bar, volatile LAS unsigned* st) {
    XcdBarrier b; b.bar = bar; b.x = xb_xcc_id(); b.st = st;
    if (threadIdx.x == 0) (void)xb_add(&bar[XB_XCNT(b.x)], 1u);
    return b;
}
__device__ __forceinline__ void xcd_barrier_complete(unsigned* bar, unsigned x, unsigned& nloc, unsigned& nx) {
    const unsigned G = gridDim.x * gridDim.y * gridDim.z;
    unsigned sum, cnt, mine, sp = 0u;
    for (;;) {
        sum = 0u; cnt = 0u; mine = 0u;
#pragma unroll
        for (unsigned j = 0; j < 16; ++j) { const unsigned c = xb_ld(&bar[XB_XCNT(j)]); sum += c; cnt += (c > 0u) ? 1u : 0u; mine = (j == x) ? c : mine; }
        if (sum == G) break;
        __builtin_amdgcn_s_sleep(1);
        if ((++sp & 255u) == 0u) { if (xb_ld(&bar[XB_TMO])) break; if (sp > XB_SPIN_CAP) { atomicAdd(&bar[XB_TMO], 1u); break; } }
    }
    nloc = mine > 0u ? mine : 1u; nx = cnt > 0u ? cnt : 1u;
}

__device__ __forceinline__ void xcd_barrier(const XcdBarrier& b) {
    asm volatile("s_waitcnt vmcnt(0)" ::: "memory");
    __syncthreads();
    if (threadIdx.x == 0) {
        unsigned* bar = b.bar;
        __builtin_amdgcn_s_waitcnt(0);
        unsigned nloc = b.st[0], nx = b.st[1];
        if (nloc == 0u) { xcd_barrier_complete(bar, b.x, nloc, nx); b.st[0] = nloc; b.st[1] = nx; }
        const unsigned old = xb_add(&bar[XB_XSUB(b.x)], 1u);
        const unsigned gen = old / nloc;
        if (old + 1u == (gen + 1u) * nloc) {
            __builtin_amdgcn_fence(__ATOMIC_RELEASE, "agent");
            asm volatile("s_waitcnt vmcnt(0)" ::: "memory");
            const unsigned og = xb_add(&bar[XB_TOP], 1u);
            const unsigned tg = og / nx;
            if (og + 1u == (tg + 1u) * nx) xb_add(&bar[XB_TOPGEN], 1u);
            else XB_SPIN(xb_ld(&bar[XB_TOPGEN]) == tg, bar);
            __builtin_amdgcn_fence(__ATOMIC_ACQUIRE, "agent");
            xb_add(&bar[XB_XGEN(b.x)], 1u);
            asm volatile("s_waitcnt vmcnt(0)" ::: "memory");
        } else {
            XB_SPIN(xb_ld(&bar[XB_XGEN(b.x)]) == gen, bar);
            __builtin_amdgcn_fence(__ATOMIC_ACQUIRE, "agent");
            asm volatile("s_waitcnt vmcnt(0)" ::: "memory");
        }
    }
    __syncthreads();
}

constexpr size_t WS_BAR = 7 * MiB, BAR_BYTES = 16384;
constexpr int MISC_OFF = 131072 + 320;
struct Args { const float* in[21]; float* out; unsigned char* ws; int ph_lo, ph_hi; };
enum { I_X = 0, I_F1N, I_F1GU, I_F1D, I_MIXN, I_F2N, I_F2GU, I_F2D, I_FOXIN, I_FOXBF, I_FOXOUT, I_LIN, I_LCW, I_LCB, I_LWA, I_LBA, I_LWI, I_LBI, I_LLAM, I_LOUT, I_FINN };

template <bool GU> __device__ __forceinline__ void tr_item(const float* W, int ldw, int K, int nblk, const float* gain, bf16* WT, LAS float* scr, int item, int lane) {
    const int kb = item / nblk, nb = item - kb * nblk, k0 = 64 * kb, n0 = 32 * nb;
#pragma unroll 8
    for (int i = 0; i < 32; ++i) { const int kk = 2 * i + (lane >> 5); float w = W[(size_t)(k0 + kk) * ldw + n0 + (lane & 31)]; if (gain) w *= gain[k0 + kk]; scr[kk * 33 + (lane & 31)] = w; }
    asm volatile("s_waitcnt lgkmcnt(0)" ::: "memory");
    int row0 = n0;
    if (GU) { const int c = (n0 < FF) ? n0 : n0 - FF; row0 = 256 * (c >> 7) + (c & 127) + ((n0 < FF) ? 0 : 128); }
    const int c8 = lane & 7;
#pragma unroll
    for (int j = 0; j < 4; ++j) { const int n = (lane >> 3) + 8 * j; const LAS float* s = scr + (8 * c8) * 33 + n;
        v4u o; o.x = pk2(s[0 * 33], s[1 * 33]); o.y = pk2(s[2 * 33], s[3 * 33]); o.z = pk2(s[4 * 33], s[5 * 33]); o.w = pk2(s[6 * 33], s[7 * 33]);
        *(v4u*)(WT + (size_t)(row0 + n) * K + k0 + 8 * c8) = o; }
    asm volatile("s_waitcnt lgkmcnt(0)" ::: "memory");
}

template <class Epi> __device__ __forceinline__ void run_gemm(LAS unsigned char* lds, const bf16* A, const bf16* Bt, int N, int K, const Epi& E) {
    pg8::Gemm g{A, Bt, M, N, K}; pg8::StaticOrder S; S.init(M, N, osgpr((int)gridDim.x), osgpr((int)blockIdx.x));
    pg8::gemm_phase<Epi, pg8::StaticOrder, PG8_ALIGN, PG8_SP2>(lds, g, S, E);
}

__device__ __forceinline__ float expm1_small(float x) {
    float p = 1.0f / 5040.0f; p = p * x + 1.0f / 720.0f; p = p * x + 1.0f / 120.0f; p = p * x + 1.0f / 24.0f; p = p * x + 1.0f / 6.0f; p = p * x + 0.5f; p = p * x + 1.0f; return p * x;
}
template <bool PASSB> __device__ __forceinline__ void lru_phase(LAS unsigned char* L, const Args& args, int vcu, int G, int tid, bf16* YOUT) {
    const int lane = tid & 63, wave = __builtin_amdgcn_readfirstlane(tid >> 6), fr = lane & 15, fq = lane >> 4;
    LAS bf16* Wt = (LAS bf16*)(L);
    LAS bf16* xcb = (LAS bf16*)(L + 33280);
    LAS float* xcf = (LAS float*)(L + 46592);
    LAS float* Aa = (LAS float*)(L + 67072);
    LAS float* Bb = (LAS float*)(L + 87552);
    LAS bf16* recs = (LAS bf16*)(L + 108032);
    LAS float* sub = (LAS float*)(L + 118752);
    LAS float* carry = (LAS float*)(L + 121312);
    LAS float* cst = (LAS float*)(L + 121632);
    unsigned char* ws = args.ws;
    const bf16* Wg = (const bf16*)(ws + WS_WLG); const float* sp = (const float*)(ws + WS_SP);
    const bf16* GATE = (const bf16*)(ws + WS_BIG); const bf16* REC = (const bf16*)(ws + WS_BIG + 40 * MiB);
    f32x2* SUM = (f32x2*)(ws + WS_LSUM);
    const int n = vcu & 15, ustep = G >> 4, u0 = vcu >> 4;
    unsigned zero = 0u; asm volatile("" : "+v"(zero));
    const int rr0 = tid / 10, pc0 = tid - rr0 * 10, rr1 = (tid + 512) / 10, pc1 = (tid + 512) - rr1 * 10;
#define LRU_REC_LOAD(uu, q0_, q1_) do { const int b_ = (uu) >> 7, t0_ = ((uu) & 127) * 64; q0_ = (v4u){zero, zero, zero, zero}; q1_ = q0_; \
        if (t0_ - 3 + rr0 >= 0) q0_ = *(const v4u*)(REC + ((size_t)b_ * T + t0_ - 3 + rr0) * R + n * 80 + pc0 * 8); \
        if (tid + 512 < 670) q1_ = *(const v4u*)(REC + ((size_t)b_ * T + t0_ - 3 + rr1) * R + n * 80 + pc1 * 8); } while (0)
#define LRU_SUM_LOAD(uu, sq_) do { const int b_ = (uu) >> 7, j_ = (uu) & 127, lo_ = (j_ < ustep) ? 0 : j_ - ustep; const f32x2* S_ = SUM + ((size_t)b_ * 128) * R + n * 80 + tid; \
        _Pragma("unroll") for (int i_ = 0; i_ < 16; ++i_) { sq_[i_] = (f32x2){1.f, 0.f}; if (tid < 80 && lo_ + i_ < j_) sq_[i_] = S_[(size_t)(lo_ + i_) * R]; } } while (0)
    v4u rq0, rq1; f32x2 sq[16];
    LRU_REC_LOAD(u0, rq0, rq1);
    if (PASSB) LRU_SUM_LOAD(u0, sq);
    for (int p = tid; p < 1920; p += 512) { const int row = p / 12, pc = p - row * 12; *(LAS v4u*)(Wt + row * 104 + pc * 8) = *(const v4u*)(Wg + (size_t)(n * 160 + row) * 96 + pc * 8); }
    if (tid < 128) { const int row = tid >> 1, pc = tid & 1; *(LAS v4u*)(xcb + row * 104 + 80 + pc * 8) = (v4u){zero, zero, zero, zero}; }
    if (tid < 80) { const int c = n * 80 + tid;
        cst[0 * 80 + tid] = args.in[I_LCW][0 * R + c]; cst[1 * 80 + tid] = args.in[I_LCW][1 * R + c]; cst[2 * 80 + tid] = args.in[I_LCW][2 * R + c]; cst[3 * 80 + tid] = args.in[I_LCW][3 * R + c];
        cst[4 * 80 + tid] = args.in[I_LCB][c]; cst[5 * 80 + tid] = args.in[I_LBA][c]; cst[6 * 80 + tid] = args.in[I_LBI][c]; cst[7 * 80 + tid] = sp[c]; }
    float hc = 0.f;
    for (int u = u0; u < 256; u += ustep) {
        const int b = u >> 7, j = u & 127, t0 = j * 64; const size_t rowg0 = (size_t)b * T + t0;
        *(LAS v4u*)(recs + rr0 * 80 + pc0 * 8) = rq0; if (tid + 512 < 670) *(LAS v4u*)(recs + rr1 * 80 + pc1 * 8) = rq1;
        if (PASSB && tid < 80) { if (j < ustep) hc = 0.f;
#pragma unroll
            for (int i = 0; i < 16; ++i) hc = sq[i].x * hc + sq[i].y;
            carry[tid] = hc; }
        v4u gq0 = (v4u){zero, zero, zero, zero}, gq1 = gq0;
        if (PASSB) { gq0 = *(const v4u*)(GATE + (rowg0 + rr0) * R + n * 80 + pc0 * 8); if (tid + 512 < 640) gq1 = *(const v4u*)(GATE + (rowg0 + rr1) * R + n * 80 + pc1 * 8); }
        if (u + ustep < 256) { LRU_REC_LOAD(u + ustep, rq0, rq1); if (PASSB) LRU_SUM_LOAD(u + ustep, sq); }
        __syncthreads();
#pragma unroll
        for (int i = 0; i < 10; ++i) { const int idx = tid + 512 * i, t = idx / 80, c = idx - t * 80;
            float x = cst[4 * 80 + c];
#pragma unroll
            for (int jj = 0; jj < 4; ++jj) x += cst[jj * 80 + c] * bf2f(recs[(t + jj) * 80 + c]);
            xcf[t * 80 + c] = x; xcb[t * 104 + c] = (bf16)f2bf(x); }
        __syncthreads();
        { const int mt = wave & 3, ct0 = (wave >> 2) ? 3 : 0, ct1 = (wave >> 2) ? 5 : 3, tok = 16 * mt + fr;
            for (int ct = ct0; ct < ct1; ++ct) { f32x4 ga = (f32x4){0.f, 0.f, 0.f, 0.f}, gi = ga;
#pragma unroll
                for (int kk = 0; kk < 3; ++kk) { const bf16x8 xf = *(const LAS bf16x8*)(xcb + tok * 104 + 32 * kk + 8 * fq);
                    const bf16x8 wa = *(const LAS bf16x8*)(Wt + (16 * ct + fr) * 104 + 32 * kk + 8 * fq), wi = *(const LAS bf16x8*)(Wt + (80 + 16 * ct + fr) * 104 + 32 * kk + 8 * fq);
                    ga = __builtin_amdgcn_mfma_f32_16x16x32_bf16(wa, xf, ga, 0, 0, 0); gi = __builtin_amdgcn_mfma_f32_16x16x32_bf16(wi, xf, gi, 0, 0, 0); }
                const int ch0 = 16 * ct + 4 * fq; const f32x4 xv = *(const LAS f32x4*)(xcf + tok * 80 + ch0);
                const f32x4 bav = *(const LAS f32x4*)(cst + 5 * 80 + ch0), biv = *(const LAS f32x4*)(cst + 6 * 80 + ch0), spv = *(const LAS f32x4*)(cst + 7 * 80 + ch0); f32x4 av, bv;
#pragma unroll
                for (int e = 0; e < 4; ++e) {
                    const float r = pg8::fast_sigmoid(ga[e] + bav[e]), ig = pg8::fast_sigmoid(gi[e] + biv[e]);
                    const float la = -8.0f * r * spv[e]; float a, om;
                    if (la > -0.125f) { a = 1.0f + expm1_small(la); om = -expm1_small(2.0f * la); } else { a = expf(la); om = -expm1f(2.0f * la); }
                    av[e] = a; bv[e] = __builtin_amdgcn_sqrtf(om) * (ig * xv[e]); }
                *(LAS f32x4*)(Aa + tok * 80 + ch0) = av; *(LAS f32x4*)(Bb + tok * 80 + ch0) = bv; } }
        __syncthreads();
        const int ch = tid % 80, s = tid / 80;
        if (tid < 320) { float Ap = 1.f, Bp = 0.f;
#pragma unroll
            for (int tt = 0; tt < 16; ++tt) { const int t = 16 * s + tt; const float a = Aa[t * 80 + ch], bb = Bb[t * 80 + ch]; Ap *= a; Bp = a * Bp + bb; }
            sub[(s * 80 + ch) * 2] = Ap; sub[(s * 80 + ch) * 2 + 1] = Bp; }
        __syncthreads();
        if (!PASSB) {
            if (tid < 80) { float Ap = 1.f, Bp = 0.f;
#pragma unroll
                for (int s2 = 0; s2 < 4; ++s2) { const float a = sub[(s2 * 80 + tid) * 2], bb = sub[(s2 * 80 + tid) * 2 + 1]; Ap *= a; Bp = a * Bp + bb; }
                SUM[((size_t)b * 128 + j) * R + n * 80 + tid] = (f32x2){Ap, Bp}; }
        } else {
            if (tid < 320) { float h = carry[ch];
                for (int s2 = 0; s2 < s; ++s2) h = sub[(s2 * 80 + ch) * 2] * h + sub[(s2 * 80 + ch) * 2 + 1];
#pragma unroll
                for (int tt = 0; tt < 16; ++tt) { const int t = 16 * s + tt; h = Aa[t * 80 + ch] * h + Bb[t * 80 + ch]; Bb[t * 80 + ch] = h; } }
            __syncthreads();
#define LRU_OUT(rr_, pc_, gv) do { const f32x4 h0 = *(const LAS f32x4*)(Bb + (rr_) * 80 + (pc_) * 8), h1 = *(const LAS f32x4*)(Bb + (rr_) * 80 + (pc_) * 8 + 4); v4u o; \
                o.x = pk2(h0[0] * bf2f((unsigned short)(gv.x & 0xffffu)), h0[1] * bf2f((unsigned short)(gv.x >> 16))); o.y = pk2(h0[2] * bf2f((unsigned short)(gv.y & 0xffffu)), h0[3] * bf2f((unsigned short)(gv.y >> 16))); \
                o.z = pk2(h1[0] * bf2f((unsigned short)(gv.z & 0xffffu)), h1[1] * bf2f((unsigned short)(gv.z >> 16))); o.w = pk2(h1[2] * bf2f((unsigned short)(gv.w & 0xffffu)), h1[3] * bf2f((unsigned short)(gv.w >> 16))); \
                *(v4u*)(YOUT + (rowg0 + (rr_)) * R + n * 80 + (pc_) * 8) = o; } while (0)
            LRU_OUT(rr0, pc0, gq0); if (tid + 512 < 640) LRU_OUT(rr1, pc1, gq1);
#undef LRU_OUT
        }
        __syncthreads();
    }
#undef LRU_REC_LOAD
#undef LRU_SUM_LOAD
}

__device__ __forceinline__ void p0_prologue(LAS unsigned char* lds, const Args& args, int vcu, int G, int tid) {
    const int lane = tid & 63, wave = __builtin_amdgcn_readfirstlane(tid >> 6);
    unsigned char* ws = args.ws;
    LAS float* scr = (LAS float*)(lds + wave * 16384);
    const int gw = vcu * NWAVES + wave, NGW = G * NWAVES;
    constexpr int I_GU = (D / 64) * (NGU / 32), I_DN = (FF / 64) * (D / 32), I_QKV = (D / 64) * (NQKV / 32), I_WO = (D / 64) * (D / 32), I_LI = (D / 64) * (2 * R / 32), I_LO = (R / 64) * (D / 32);
    constexpr int NITEMS = 4 * I_GU + 4 * I_DN + I_QKV + I_WO + I_LI + I_LO;
    for (int it = gw; it < NITEMS; it += NGW) {
        int r = it;
        if (r < 4 * I_GU) { const int f = r / I_GU; r -= f * I_GU; const int layer = f >> 1;
            const float* W = ((f & 1) ? args.in[I_F2GU] : args.in[I_F1GU]) + (size_t)layer * D * NGU; const float* gn = ((f & 1) ? args.in[I_F2N] : args.in[I_F1N]) + layer * D;
            tr_item<true>(W, NGU, D, NGU / 32, gn, (bf16*)(ws + WS_WGU + f * WGU_BYTES), scr, r, lane); continue; }
        r -= 4 * I_GU;
        if (r < 4 * I_DN) { const int f = r / I_DN; r -= f * I_DN; const int layer = f >> 1;
            const float* W = ((f & 1) ? args.in[I_F2D] : args.in[I_F1D]) + (size_t)layer * FF * D;
            tr_item<false>(W, D, FF, D / 32, nullptr, (bf16*)(ws + WS_WD + f * WD_BYTES), scr, r, lane); continue; }
        r -= 4 * I_DN;
        if (r < I_QKV) { tr_item<false>(args.in[I_FOXIN], NFOX, D, NQKV / 32, args.in[I_MIXN], (bf16*)(ws + WS_WQKV), scr, r, lane); continue; }
        r -= I_QKV;
        if (r < I_WO) { tr_item<false>(args.in[I_FOXOUT], D, D, D / 32, nullptr, (bf16*)(ws + WS_WO), scr, r, lane); continue; }
        r -= I_WO;
        if (r < I_LI) { tr_item<false>(args.in[I_LIN], 2 * R, D, 2 * R / 32, args.in[I_MIXN] + D, (bf16*)(ws + WS_WLIN), scr, r, lane); continue; }
        r -= I_LI;
        tr_item<false>(args.in[I_LOUT], D, R, D / 32, nullptr, (bf16*)(ws + WS_WLOUT), scr, r, lane);
    }
    const int gt = vcu * 512 + tid, NGT = G * 512;
    { bf16* wf = (bf16*)(ws + WS_WF);
        for (int i = gt; i < NH * D; i += NGT) { const int h = i >> 10, k = i & 1023; wf[i] = (bf16)f2bf(args.in[I_MIXN][k] * args.in[I_FOXIN][(size_t)k * NFOX + NQKV + h]); } }
    { bf16* wg = (bf16*)(ws + WS_WLG);
        for (int i = gt; i < 16 * 160 * 96; i += NGT) { const int k = i % 96, dd = (i / 96) % 160, n = i / (96 * 160); float v = 0.f;
            if (k < 80) v = (dd < 80) ? args.in[I_LWA][((size_t)n * 80 + k) * 80 + dd] : args.in[I_LWI][((size_t)n * 80 + k) * 80 + (dd - 80)];
            wg[i] = (bf16)f2bf(v); } }
    { float* sp = (float*)(ws + WS_SP); for (int i = gt; i < R; i += NGT) sp[i] = log1pf(expf(-args.in[I_LLAM][i])); }
    { float* ss = (float*)(ws + WS_SS); for (int i = gt; i < 7 * M; i += NGT) ss[M + i] = 0.f; }
    { float* ss0 = (float*)(ws + WS_SS); bf16* xb = (bf16*)(ws + WS_XB); const float* x = args.in[I_X];
        for (int m = gw; m < M; m += NGW) { const f32x4* xr = (const f32x4*)(x + (size_t)m * D) + lane; f32x4 v[4]; float s = 0.f;
#pragma unroll
            for (int j = 0; j < 4; ++j) { v[j] = xr[64 * j]; s += (v[j].x * v[j].x + v[j].y * v[j].y) + (v[j].z * v[j].z + v[j].w * v[j].w); }
            s = wave_sum(s); if (lane == 0) ss0[m] = s;
            unsigned long long* o8 = (unsigned long long*)(xb + (size_t)m * D) + lane;
#pragma unroll
            for (int j = 0; j < 4; ++j) o8[64 * j] = (unsigned long long)pk2(v[j].x, v[j].y) | ((unsigned long long)pk2(v[j].z, v[j].w) << 32); } }
}

__device__ __forceinline__ void flogit_phase(const Args& args, int vcu, int G, int tid) {
    const int lane = tid & 63, wave = __builtin_amdgcn_readfirstlane(tid >> 6), fr = lane & 15, fq = lane >> 4;
    unsigned char* ws = args.ws; const bf16* xb = (const bf16*)(ws + WS_XB); const bf16* wf = (const bf16*)(ws + WS_WF); const float* ss = (const float*)(ws + WS_SS) + 1 * M; float* logf_ = (float*)(ws + WS_LOGF);
    const int gw = vcu * NWAVES + wave, NGW = G * NWAVES;
    for (int grp = gw; grp < M / 16; grp += NGW) { const int row0 = grp * 16;
        const bf16* xa = xb + (size_t)(row0 + fr) * D + 8 * fq; const bf16* wb = wf + (size_t)fr * D + 8 * fq; f32x4 acc = (f32x4){0.f, 0.f, 0.f, 0.f};
#pragma unroll 8
        for (int kk = 0; kk < 32; ++kk) { const bf16x8 xf = *(const bf16x8*)(xa + 32 * kk), wv = *(const bf16x8*)(wb + 32 * kk); acc = __builtin_amdgcn_mfma_f32_16x16x32_bf16(wv, xf, acc, 0, 0, 0); }
        const int row = row0 + fr, b = row >> 13, t = row & (T - 1); const float rs = pg8::rstd_row(ss, row);
#pragma unroll
        for (int e = 0; e < 4; ++e) { const int h = 4 * fq + e; const float z = acc[e] * rs + args.in[I_FOXBF][h];
            const float lf = fminf(z, 0.f) - log1pf(expf(-fabsf(z))); logf_[(size_t)(b * NH + h) * T + t] = lf * LOG2E; } }
}

__device__ __forceinline__ void attn_cumsum(const float* lf, LAS float* Gl, LAS float* wsum, int tid) {
    const int lane = tid & 63, wave = tid >> 6; f32x4 v[4];
#pragma unroll
    for (int j = 0; j < 4; ++j) v[j] = *(const f32x4*)(lf + tid * 16 + 4 * j);
    float run = 0.f;
#pragma unroll
    for (int j = 0; j < 4; ++j) { run += v[j].x; v[j].x = run; run += v[j].y; v[j].y = run; run += v[j].z; v[j].z = run; run += v[j].w; v[j].w = run; }
    float incl = run;
#pragma unroll
    for (int o = 1; o < 64; o <<= 1) { const float nb = __shfl_up(incl, o); if (lane >= o) incl += nb; }
    if (lane == 63) wsum[wave] = incl;
    __syncthreads();
    float base = incl - run;
    for (int w = 0; w < wave; ++w) base += wsum[w];
#pragma unroll
    for (int j = 0; j < 4; ++j) *(LAS f32x4*)(Gl + tid * 16 + 4 * j) = v[j] + base;
    __syncthreads();
}

constexpr int N_PHASES = 17;
#ifndef ONLY_KIND
#define ONLY_KIND -1
#endif
#define KON(k) (ONLY_KIND < 0 || ONLY_KIND == (k))
#ifndef DUP_PH
#define DUP_PH -1
#endif
#ifndef DUP_SYNC
#define DUP_SYNC 0
#endif
__global__ void __launch_bounds__(NWAVES * 64, 2) fwd_megakernel(Args args) {
    extern __shared__ __attribute__((aligned(16))) unsigned char lds_raw[];
    LAS unsigned char* lds = (LAS unsigned char*)lds_raw;
    cg::grid_group grid = cg::this_grid();
    if (threadIdx.x < 16) ((LAS unsigned*)(lds + MISC_OFF))[threadIdx.x] = 0u;
    __syncthreads();
    XcdBarrier xbar = xcd_barrier_post((unsigned*)(args.ws + WS_BAR), (volatile LAS unsigned*)(lds + MISC_OFF));
    unsigned char* ws = args.ws;
    float* ssb = (float*)(ws + WS_SS); bf16* XB = (bf16*)(ws + WS_XB);
    bf16* HB = (bf16*)(ws + WS_BIG); bf16* QB_ = (bf16*)(ws + WS_BIG); bf16* KB = (bf16*)(ws + WS_BIG + 32 * MiB); bf16* VB = (bf16*)(ws + WS_BIG + 64 * MiB);
    bf16* GATE = (bf16*)(ws + WS_BIG); bf16* REC = (bf16*)(ws + WS_BIG + 40 * MiB);
    for (int pp = args.ph_lo; pp < args.ph_hi; ++pp) {
        int ph = pp; bool dummy = false;
        if (DUP_PH >= 0) { dummy = (pp == DUP_PH); ph = (pp <= DUP_PH) ? pp : pp - 1; }
        const int tid = otid(), G = osgpr((int)gridDim.x), bx = osgpr((int)blockIdx.x);
        const int vcu = (G % 8 == 0) ? (bx % 8) * (G / 8) + bx / 8 : bx;
        int kind = 0, f = 0, ssi = 0; const bf16* A = XB; const bf16* Bt = nullptr; int K = D; const float* xin = args.out; float alpha = 1.f;
        switch (ph) {
            case 0: kind = 0; break;
            case 1: kind = 1; f = 0; ssi = 0; break;
            case 2: kind = 2; A = HB; Bt = (const bf16*)(ws + WS_WD + 0 * WD_BYTES); K = FF; xin = args.in[I_X]; alpha = 0.5f; ssi = 1; break;
            case 3: kind = 3; break;
            case 4: kind = 4; break;
            case 5: kind = 2; A = QB_; Bt = (const bf16*)(ws + WS_WO); K = D; alpha = 1.f; ssi = 2; break;
            case 6: kind = 1; f = 1; ssi = 2; break;
            case 7: kind = 2; A = HB; Bt = (const bf16*)(ws + WS_WD + 1 * WD_BYTES); K = FF; alpha = 0.5f; ssi = 3; break;
            case 8: kind = 1; f = 2; ssi = 3; break;
            case 9: kind = 2; A = HB; Bt = (const bf16*)(ws + WS_WD + 2 * WD_BYTES); K = FF; alpha = 0.5f; ssi = 4; break;
            case 10: kind = 5; break;
            case 11: kind = 6; break;
            case 12: kind = 7; break;
            case 13: kind = 2; A = GATE; Bt = (const bf16*)(ws + WS_WLOUT); K = R; alpha = 1.f; ssi = 5; break;
            case 14: kind = 1; f = 3; ssi = 5; break;
            case 15: kind = 2; A = HB; Bt = (const bf16*)(ws + WS_WD + 3 * WD_BYTES); K = FF; alpha = 0.5f; ssi = 6; break;
            default: kind = 8; break;
        }
        if (dummy) { alpha = 0.f; if (kind == 2) ssi = 7; }
        bf16* const OB = dummy ? (bf16*)(ws + 218 * MiB) : QB_; bf16* const YB = dummy ? (bf16*)(ws + WS_BIG + 80 * MiB) : GATE;
        if (KON(0) && kind == 0) { p0_prologue(lds, args, vcu, G, tid); }
        else if (KON(1) && kind == 1) { pg8::EpiSwiGLU E{HB, ssb + (size_t)ssi * M}; run_gemm(lds, XB, (const bf16*)(ws + WS_WGU + f * WGU_BYTES), NGU, D, E); }
        else if (KON(2) && kind == 2) { pg8::EpiResid E{xin, args.out, XB, ssb + (size_t)ssi * M, alpha}; run_gemm(lds, A, Bt, D, K, E); }
        else if (KON(3) && kind == 3) { pg8::EpiQKV E{QB_, (size_t)M * D, ssb + 1 * M, attn_body::C2}; run_gemm(lds, XB, (const bf16*)(ws + WS_WQKV), NQKV, D, E); flogit_phase(args, vcu, G, tid); }
        else if (KON(4) && kind == 4) {
            LAS float* Gl = (LAS float*)(lds + 86016); LAS float* wsum = (LAS float*)(lds + 86016 + 32768);
            for (int item = vcu; item < 256; item += G) { const int bh = item >> 3, s = item & 7;
                attn_cumsum((const float*)(ws + WS_LOGF) + (size_t)bh * T, Gl, wsum, tid);
                for (int i = 0; i < 4; ++i) { const int qb = (i == 0) ? s : (i == 1) ? 15 - s : (i == 2) ? 16 + s : 31 - s;
                    attn_body::attn_unit<8>(bh >> 4, bh & 15, qb, (const attn_body::bf16*)QB_, (const attn_body::bf16*)KB, (const attn_body::bf16*)VB, (attn_body::bf16*)OB, (char*)lds_raw, (attn_body::lds_fptr)Gl); }
                __syncthreads(); }
        }
        else if (KON(5) && kind == 5) { pg8::EpiLruIn E{GATE, REC, ssb + 4 * M}; run_gemm(lds, XB, (const bf16*)(ws + WS_WLIN), 2 * R, D, E); }
        else if (KON(6) && kind == 6) { lru_phase<false>(lds, args, vcu, G, tid, YB); }
        else if (KON(7) && kind == 7) { lru_phase<true>(lds, args, vcu, G, tid, YB); }
        else if (KON(8)) { const int lane = tid & 63, wave = tid >> 6, gw = vcu * NWAVES + wave, NGW = G * NWAVES; const float* ss = ssb + 6 * M; const f32x4* gn = (const f32x4*)args.in[I_FINN] + lane;
            for (int m = gw; m < M; m += NGW) { const float rs = pg8::rstd_row(ss, m); f32x4* xr = (f32x4*)(args.out + (size_t)m * D) + lane;
#pragma unroll
                for (int j = 0; j < 4; ++j) { const f32x4 v = xr[64 * j]; xr[64 * j] = v * rs * gn[64 * j]; } } }
        if (pp + 1 < args.ph_hi) { if (pp == args.ph_lo) grid.sync(); else xcd_barrier(xbar); if (DUP_SYNC) xcd_barrier(xbar); }
    }
}

#ifndef MK_PER_PHASE_LAUNCH
#define MK_PER_PHASE_LAUNCH 0
#endif
extern "C" void kernel_launch(void* const* d_in, const int* in_sizes, int n_in, void* d_out, int out_size, void* d_ws, size_t ws_size, hipStream_t stream) {
    static int grid = 0;
    if (grid == 0) {
        if (n_in != 21 || in_sizes[0] != M * D || out_size != M * D || ws_size < WS_END) { fprintf(stderr, "kernel_launch: unexpected shapes (n_in %d, in0 %d, out %d, ws %zu); nothing launched\n", n_in, n_in > 0 ? in_sizes[0] : -1, out_size, ws_size); grid = -1; return; }
        int dev = 0, cus = 0, per_cu = 0;
        if (hipGetDevice(&dev) != hipSuccess || hipDeviceGetAttribute(&cus, hipDeviceAttributeMultiprocessorCount, dev) != hipSuccess) { grid = -1; return; }
        if (hipFuncSetAttribute((const void*)fwd_megakernel, hipFuncAttributeMaxDynamicSharedMemorySize, LDS_BYTES) != hipSuccess) { fprintf(stderr, "kernel_launch: hipFuncSetAttribute failed\n"); grid = -1; return; }
        if (hipOccupancyMaxActiveBlocksPerMultiprocessor(&per_cu, (const void*)fwd_megakernel, NWAVES * 64, LDS_BYTES) != hipSuccess || per_cu < 1) { fprintf(stderr, "kernel_launch: occupancy query says %d blocks per CU\n", per_cu); per_cu = 1; }
        (void)hipGetLastError();
        grid = cus * per_cu;
        if (grid != 256) fprintf(stderr, "kernel_launch: grid %d (this kernel's static unit orders assume 256 workgroups)\n", grid);
    }
    if (grid < 0) return;
    Args a{};
    for (int i = 0; i < 21; ++i) a.in[i] = (const float*)d_in[i];
    a.out = (float*)d_out; a.ws = (unsigned char*)d_ws;
    if (hipMemsetAsync((unsigned char*)d_ws + WS_BAR, 0, BAR_BYTES, stream) != hipSuccess) { fprintf(stderr, "kernel_launch: memset of the barrier words failed\n"); return; }
#if MK_PER_PHASE_LAUNCH
    for (int ph = 0; ph < N_PHASES; ++ph) { a.ph_lo = ph; a.ph_hi = ph + 1; hipLaunchKernelGGL(fwd_megakernel, dim3(grid), dim3(NWAVES * 64), LDS_BYTES, stream, a); }
#else
    a.ph_lo = 0; a.ph_hi = N_PHASES + ((DUP_PH >= 0) ? 1 : 0);
    void* kargs[] = {&a};
    const hipError_t e = hipLaunchCooperativeKernel((const void*)fwd_megakernel, dim3(grid), dim3(NWAVES * 64), kargs, LDS_BYTES, stream);
    if (e != hipSuccess) fprintf(stderr, "kernel_launch: cooperative launch failed: %s (grid %d)\n", hipGetErrorString(e), grid);
#endif
}
```

```cpp
#define DUP_PH -1
#define DUP_SYNC 0
#include <hip/hip_runtime.h>
#include <hip/hip_cooperative_groups.h>
#include <cstdio>
#include <cstdint>
namespace cg = cooperative_groups;
__device__ __forceinline__ int otid() { int t = (int)threadIdx.x; asm volatile("" : "+v"(t)); return t; }
__device__ __forceinline__ int osgpr(int v) { asm volatile("" : "+s"(v)); return v; }
namespace pg8 {
#define PG8_LAS __attribute__((address_space(3)))
typedef unsigned short bf16_t;
typedef short bf16x8 __attribute__((ext_vector_type(8)));
typedef float f32x4 __attribute__((ext_vector_type(4)));
typedef unsigned u32x4 __attribute__((ext_vector_type(4)));
constexpr int BM = 256, BK = 64, HALF = 128, HTB = HALF * BK * 2  , STAGE_BYTES = 8 * HTB, NXCD = 8, WGM = 8;

__host__ __device__ __forceinline__ int lds_byte(int r, int c) { const int st = (r >> 4) * 2 + (c >> 5), rr = r & 15, cc = c & 31, ob = rr * 64 + cc * 2; return st * 1024 + (ob ^ (((ob >> 9) & 1) << 5)); }
__host__ __device__ __forceinline__ void stage_rc(int b, int& R, int& C) { const int st = b / 1024, sb = b % 1024, swz = sb ^ (((sb >> 9) & 1) << 5); R = (st >> 1) * 16 + swz / 64; C = (st & 1) * 32 + (swz % 64) / 2; }
__host__ __device__ __forceinline__ int perm32(int rho) { const int n = rho >> 4, i = rho & 15; return 8 * (i >> 2) + 4 * n + (i & 3); }

struct Unit { int pm, pn; };
struct Gemm { const bf16_t* A; const bf16_t* Bt; int M, N, K; };

struct StaticOrder {
    int nM, nN, nwg, G, c;
    __host__ __device__ void init(int M, int N, int G_, int c_) { nM = M / BM; nN = N / BM; nwg = nM * nN; G = G_; c = c_; }
    __host__ __device__ bool next(int i, Unit& u) const {
        const long L = (long)i * G + c; if (L >= nwg) return false;
        int wgid = (int)L; { const int q = nwg / NXCD, r = nwg % NXCD, xcd = wgid % NXCD, off = wgid / NXCD; wgid = (xcd < r ? xcd * (q + 1) : r * (q + 1) + (xcd - r) * q) + off; }
        const int nig = WGM * nN, gid = wgid / nig, fm = gid * WGM, gsz = (nM - fm) < WGM ? (nM - fm) : WGM;
        u.pm = fm + ((wgid % nig) % gsz); u.pn = (wgid % nig) / gsz; return true;
    }
    __device__ __forceinline__ void a_ready(const Unit&) const {}
    __device__ __forceinline__ void done(const Unit&) const {}
};

__device__ __forceinline__ unsigned cvt_pk_bf16(float lo, float hi) { unsigned r; asm volatile("v_cvt_pk_bf16_f32 %0, %1, %2" : "=v"(r) : "v"(lo), "v"(hi)); return r; }
typedef float f32x2 __attribute__((ext_vector_type(2)));
__device__ __forceinline__ f32x2 gelu_pk(f32x2 v) {
    const f32x2 av = __builtin_elementwise_abs(v), d = av * 0.2316418882f + 1.0f;
    f32x2 t; t.x = __builtin_amdgcn_rcpf(d.x); t.y = __builtin_amdgcn_rcpf(d.y);
    f32x2 q = t * 0.5307027145f + (-0.7265760135f); q = q * t + 0.7107068705f; q = q * t + (-0.142248368f); q = q * t + 0.127414796f; q = q * t;
    const f32x2 s = (v * v) * (-0.72134752044f);
    f32x2 e; e.x = __builtin_amdgcn_exp2f(s.x); e.y = __builtin_amdgcn_exp2f(s.y);
    const f32x2 m = v * (q * e), r = v - m;
    f32x2 o; o.x = v.x < 0.f ? m.x : r.x; o.y = v.y < 0.f ? m.y : r.y; return o;
}

template <int ACT  > struct EpiBf16 {
    static constexpr bool PERM = true, AFTER_DRAIN = false; static_assert(ACT == 0 || ACT == 1, "EpiBf16: ACT is 0 (none) or 1 (gelu_pk)");
    bf16_t* O; int ldc; const float* bias; int split_cols; size_t split_stride; float scale0;
    __device__ __forceinline__ void operator()(const f32x4 (&acc)[2][2][4][2], const Unit& u, int wr, int wc, int fr, int fq) const {
        const int row0 = u.pm * BM + wr * 64 + fr; int colt = u.pn * BM; bf16_t* base = O;
        float sc = 1.f; if (split_cols) { const int t = colt / split_cols; base += (size_t)t * split_stride; colt -= t * split_cols; if (t == 0) sc = scale0; }
        const int col0 = colt + wc * 32 + 8 * fq, bcol0 = u.pn * BM + wc * 32 + 8 * fq;
        f32x4 bv[2][2];
#pragma unroll
        for (int bj = 0; bj < 2; ++bj)
#pragma unroll
            for (int n = 0; n < 2; ++n) bv[bj][n] = bias ? *(const f32x4*)(bias + bcol0 + bj * HALF + 4 * n) : (f32x4){0.f, 0.f, 0.f, 0.f};
#pragma unroll
        for (int ai = 0; ai < 2; ++ai)
#pragma unroll
            for (int m = 0; m < 4; ++m) { bf16_t* rowp = base + (size_t)(row0 + ai * HALF + m * 16) * ldc + col0;
#pragma unroll
                for (int bj = 0; bj < 2; ++bj) { f32x4 v0 = acc[ai][bj][m][0] + bv[bj][0], v1 = acc[ai][bj][m][1] + bv[bj][1];
                    if (ACT == 1) { f32x2 a = gelu_pk((f32x2){v0[0], v0[1]}), b = gelu_pk((f32x2){v0[2], v0[3]}), c = gelu_pk((f32x2){v1[0], v1[1]}), d = gelu_pk((f32x2){v1[2], v1[3]});
                        v0 = (f32x4){a.x, a.y, b.x, b.y}; v1 = (f32x4){c.x, c.y, d.x, d.y}; }
                    v0 = v0 * sc; v1 = v1 * sc; u32x4 w; w.x = cvt_pk_bf16(v0[0], v0[1]); w.y = cvt_pk_bf16(v0[2], v0[3]); w.z = cvt_pk_bf16(v1[0], v1[1]); w.w = cvt_pk_bf16(v1[2], v1[3]);
                    *(u32x4*)(rowp + bj * HALF) = w; } }
    }
};

typedef unsigned u32x2 __attribute__((ext_vector_type(2)));
__device__ __forceinline__ float rstd_row(const float* ss, int row) {
    const float s = __hip_atomic_load(ss + row, __ATOMIC_RELAXED, __HIP_MEMORY_SCOPE_AGENT);
    return 1.0f / sqrtf(s * (1.0f / 1024.0f) + 1e-6f);
}
__device__ __forceinline__ float fast_sigmoid(float v) { return __builtin_amdgcn_rcpf(1.0f + __builtin_amdgcn_exp2f(-1.4426950408889634f * v)); }
struct EpiSwiGLU {
    static constexpr bool PERM = true, AFTER_DRAIN = false;
    bf16_t* H; const float* ss;
    __device__ __forceinline__ void operator()(const f32x4 (&acc)[2][2][4][2], const Unit& u, int wr, int wc, int fr, int fq) const {
        const int hc0 = u.pn * 128 + wc * 32 + 8 * fq;
#pragma unroll
        for (int ai = 0; ai < 2; ++ai)
#pragma unroll
            for (int m = 0; m < 4; ++m) { const int row = u.pm * BM + ai * HALF + wr * 64 + m * 16 + fr; const float rs = rstd_row(ss, row);
                float hv[8];
#pragma unroll
                for (int n = 0; n < 2; ++n)
#pragma unroll
                    for (int e = 0; e < 4; ++e) { const float g = acc[ai][0][m][n][e] * rs, uu = acc[ai][1][m][n][e] * rs; hv[4 * n + e] = g * fast_sigmoid(g) * uu; }
                u32x4 w; w.x = cvt_pk_bf16(hv[0], hv[1]); w.y = cvt_pk_bf16(hv[2], hv[3]); w.z = cvt_pk_bf16(hv[4], hv[5]); w.w = cvt_pk_bf16(hv[6], hv[7]);
                *(u32x4*)(H + (size_t)row * 2816 + hc0) = w; }
    }
};
struct EpiResid {
    static constexpr bool PERM = false, AFTER_DRAIN = false;
    const float* xin; float* xout; bf16_t* xb; float* ss; float alpha;
    __device__ __forceinline__ void operator()(const f32x4 (&acc)[2][2][4][2], const Unit& u, int wr, int wc, int fr, int fq) const {
        const int col0 = u.pn * BM + wc * 32 + 4 * fq;
#pragma unroll
        for (int ai = 0; ai < 2; ++ai)
#pragma unroll
            for (int m = 0; m < 4; ++m) { const int row = u.pm * BM + ai * HALF + wr * 64 + m * 16 + fr; const size_t off = (size_t)row * 1024 + col0; float s = 0.f;
#pragma unroll
                for (int bj = 0; bj < 2; ++bj)
#pragma unroll
                    for (int n = 0; n < 2; ++n) { const f32x4 xi = *(const f32x4*)(xin + off + bj * HALF + n * 16); const f32x4 o = xi + acc[ai][bj][m][n] * alpha;
                        *(f32x4*)(xout + off + bj * HALF + n * 16) = o; s += (o[0] * o[0] + o[1] * o[1]) + (o[2] * o[2] + o[3] * o[3]);
                        u32x2 w; w.x = cvt_pk_bf16(o[0], o[1]); w.y = cvt_pk_bf16(o[2], o[3]); *(u32x2*)(xb + off + bj * HALF + n * 16) = w; }
                s += __shfl_xor(s, 16); s += __shfl_xor(s, 32);
                if (fq == 0) __hip_atomic_fetch_add(ss + row, s, __ATOMIC_RELAXED, __HIP_MEMORY_SCOPE_AGENT); }
    }
};
struct EpiQKV {
    static constexpr bool PERM = true, AFTER_DRAIN = false;
    bf16_t* Q; size_t split_stride; const float* ss; float scale0; float* nrm;
    __device__ __forceinline__ void operator()(const f32x4 (&acc)[2][2][4][2], const Unit& u, int wr, int wc, int fr, int fq) const {
        int colt = u.pn * BM; const int t = colt >> 10; bf16_t* base = Q + (size_t)t * split_stride; colt -= t << 10; const float sc = (t == 0) ? scale0 : 1.f;
        const int col0 = colt + wc * 32 + 8 * fq; float mx[2][2] = {{0.f, 0.f}, {0.f, 0.f}};
#pragma unroll
        for (int ai = 0; ai < 2; ++ai)
#pragma unroll
            for (int m = 0; m < 4; ++m) { const int row = u.pm * BM + ai * HALF + wr * 64 + m * 16 + fr; const float rs = rstd_row(ss, row) * sc; bf16_t* rowp = base + (size_t)row * 1024 + col0;
#pragma unroll
                for (int bj = 0; bj < 2; ++bj) { const f32x4 v0 = acc[ai][bj][m][0] * rs, v1 = acc[ai][bj][m][1] * rs;
                    { float q = (v0[0] * v0[0] + v0[1] * v0[1]) + (v0[2] * v0[2] + v0[3] * v0[3]) + (v1[0] * v1[0] + v1[1] * v1[1]) + (v1[2] * v1[2] + v1[3] * v1[3]);
                      q += __shfl_xor(q, 16); q += __shfl_xor(q, 32); mx[ai][bj] = fmaxf(mx[ai][bj], q); }
                    u32x4 w; w.x = cvt_pk_bf16(v0[0], v0[1]); w.y = cvt_pk_bf16(v0[2], v0[3]); w.z = cvt_pk_bf16(v1[0], v1[1]); w.w = cvt_pk_bf16(v1[2], v1[3]);
                    *(u32x4*)(rowp + bj * HALF) = w; } }
        if (t < 2) {
#pragma unroll
            for (int ai = 0; ai < 2; ++ai)
#pragma unroll
                for (int bj = 0; bj < 2; ++bj) { float q = mx[ai][bj]; q = fmaxf(q, __shfl_xor(q, 1)); q = fmaxf(q, __shfl_xor(q, 2)); q = fmaxf(q, __shfl_xor(q, 4)); q = fmaxf(q, __shfl_xor(q, 8));
                    const int head = (colt + bj * HALF + wc * 32) >> 6, rt = (u.pm * BM + ai * HALF + wr * 64) >> 6;
                    if (fr == 0 && fq == 0) nrm[(((size_t)t * 16 + head) * 256 + rt) * 2 + (wc & 1)] = q; } }
    }
};
__device__ __forceinline__ float gelu_tanh(float v) { const float u2 = 1.5957691216057308f * (v + 0.044715f * v * v * v); return v * fast_sigmoid(u2); }
struct EpiLruIn {
    static constexpr bool PERM = true, AFTER_DRAIN = false;
    bf16_t* GATE; bf16_t* REC; const float* ss;
    __device__ __forceinline__ void operator()(const f32x4 (&acc)[2][2][4][2], const Unit& u, int wr, int wc, int fr, int fq) const {
        const bool isg = u.pn < 5; bf16_t* base = isg ? GATE : REC; const int col0 = (isg ? u.pn : u.pn - 5) * BM + wc * 32 + 8 * fq;
#pragma unroll
        for (int ai = 0; ai < 2; ++ai)
#pragma unroll
            for (int m = 0; m < 4; ++m) { const int row = u.pm * BM + ai * HALF + wr * 64 + m * 16 + fr; const float rs = rstd_row(ss, row); bf16_t* rowp = base + (size_t)row * 1280 + col0;
#pragma unroll
                for (int bj = 0; bj < 2; ++bj) { f32x4 v0 = acc[ai][bj][m][0] * rs, v1 = acc[ai][bj][m][1] * rs;
                    if (isg) {
#pragma unroll
                        for (int e = 0; e < 4; ++e) { v0[e] = gelu_tanh(v0[e]); v1[e] = gelu_tanh(v1[e]); } }
                    u32x4 w; w.x = cvt_pk_bf16(v0[0], v0[1]); w.y = cvt_pk_bf16(v0[2], v0[3]); w.z = cvt_pk_bf16(v1[0], v1[1]); w.w = cvt_pk_bf16(v1[2], v1[3]);
                    *(u32x4*)(rowp + bj * HALF) = w; } }
    }
};
template <class Epi, class Sched, bool ALIGN_EPI = false, bool SP2 = false>
__device__ __forceinline__ void gemm_phase(PG8_LAS unsigned char* lds, const Gemm g, const Sched& S, const Epi& E) {
    const int tid = otid(), wid = __builtin_amdgcn_readfirstlane(tid >> 6), lane = tid & 63, wr = wid >> 2, wc = wid & 3, fr = lane & 15, fq = lane >> 4;
    const int K = g.K, nt = K / BK;
    unsigned voffA[2], voffB[2];
#pragma unroll
    for (int i = 0; i < 2; ++i) { int R, C; stage_rc(tid * 16 + i * 8192, R, C); const int Rb = Epi::PERM ? ((R & ~31) + perm32(R & 31)) : R;
        voffA[i] = (unsigned)(R * K + C) * 2u; voffB[i] = (unsigned)(Rb * K + C) * 2u; }
    const size_t kstep = (size_t)(BK * 2);
    const size_t hstep = (size_t)HALF * K * 2;
    const size_t tstep = 2 * hstep;
    const unsigned ldsw = (unsigned)wid * 1024u;
    const int aoff = lds_byte(wr * 64 + fr, fq * 8), boff = lds_byte(wc * 32 + fr, fq * 8);
#define PG8_SA(b, h) (((b) * 2 + (h)) * HTB)
#define PG8_SB(b, h) ((4 + (b) * 2 + (h)) * HTB)
#define PG8_STAGE(bufoff, gbase, voff) do { _Pragma("unroll") for (int _i = 0; _i < 2; ++_i) \
        __builtin_amdgcn_global_load_lds((const unsigned*)((const char*)(gbase) + (voff)[_i]), (PG8_LAS unsigned*)(lds + (bufoff) + ldsw + _i * 8192), 16, 0, 0); } while (0)
#define PG8_LDA(dst, b, h) do { _Pragma("unroll") for (int m = 0; m < 4; ++m) _Pragma("unroll") for (int k = 0; k < 2; ++k) dst[m][k] = *(const PG8_LAS bf16x8*)(lds + PG8_SA(b, h) + aoff + m * 2048 + k * 1024); } while (0)
#define PG8_LDB(dst, b, h) do { _Pragma("unroll") for (int n = 0; n < 2; ++n) _Pragma("unroll") for (int k = 0; k < 2; ++k) dst[n][k] = *(const PG8_LAS bf16x8*)(lds + PG8_SB(b, h) + boff + n * 2048 + k * 1024); } while (0)
#define PG8_MMA(ai, bj, At, Bt) do { __builtin_amdgcn_s_setprio(1); _Pragma("unroll") for (int m = 0; m < 4; ++m) _Pragma("unroll") for (int n = 0; n < 2; ++n) _Pragma("unroll") for (int k = 0; k < 2; ++k) \
        acc[ai][bj][m][n] = __builtin_amdgcn_mfma_f32_16x16x32_bf16(Bt[n][k], At[m][k], acc[ai][bj][m][n], 0, 0, 0); __builtin_amdgcn_s_setprio(0); } while (0)
#define PG8_WAIT_V(n) asm volatile("s_waitcnt vmcnt(" #n ")" ::: "memory")
#define PG8_WAIT_L(n) asm volatile("s_waitcnt lgkmcnt(" #n ")" ::: "memory")
#define PG8_BAR __builtin_amdgcn_s_barrier()
#define PG8_SCHED __builtin_amdgcn_sched_barrier(0)
    Unit cur, nxt; int ui = 0;
    if (!S.next(0, cur)) return;
    f32x4 acc[2][2][4][2];
#pragma unroll
    for (int a = 0; a < 2; ++a)
#pragma unroll
        for (int b = 0; b < 2; ++b)
#pragma unroll
            for (int m = 0; m < 4; ++m)
#pragma unroll
                for (int n = 0; n < 2; ++n) acc[a][b][m][n] = (f32x4){0.f, 0.f, 0.f, 0.f};
    bf16x8 At[4][2], B0[2][2], B1[2][2];
    const char* cA = (const char*)g.A + (size_t)cur.pm * tstep; const char* cB = (const char*)g.Bt + (size_t)cur.pn * tstep;
    S.a_ready(cur);
    if constexpr (SP2) {
        PG8_STAGE(PG8_SB(0, 0), cB, voffB); PG8_STAGE(PG8_SB(0, 1), cB + hstep, voffB); PG8_STAGE(PG8_SA(0, 0), cA, voffA); PG8_STAGE(PG8_SA(0, 1), cA + hstep, voffA);
        if (wr == 1) PG8_BAR;
        PG8_WAIT_V(2); PG8_BAR;
        PG8_STAGE(PG8_SB(1, 0), cB + kstep, voffB); PG8_STAGE(PG8_SA(1, 0), cA + kstep, voffA); PG8_STAGE(PG8_SB(1, 1), cB + hstep + kstep, voffB);
        PG8_WAIT_V(6); PG8_BAR;
    } else {
        PG8_STAGE(PG8_SB(0, 0), cB, voffB); PG8_STAGE(PG8_SA(0, 0), cA, voffA); PG8_STAGE(PG8_SB(0, 1), cB + hstep, voffB); PG8_STAGE(PG8_SA(0, 1), cA + hstep, voffA);
        if (wr == 1) PG8_BAR;
        PG8_WAIT_V(4); PG8_BAR;
        PG8_STAGE(PG8_SB(1, 0), cB + kstep, voffB); PG8_STAGE(PG8_SA(1, 0), cA + kstep, voffA); PG8_STAGE(PG8_SB(1, 1), cB + hstep + kstep, voffB);
        PG8_WAIT_V(6); PG8_BAR;
    }
    for (;;) {
        const bool has_next = S.next(ui + 1, nxt);
        const char* nA = has_next ? (const char*)g.A + (size_t)nxt.pm * tstep : cA; const char* nB = has_next ? (const char*)g.Bt + (size_t)nxt.pn * tstep : cB;
        for (int t = 0; t < nt; t += 2) {
            const bool last = (t == nt - 2);
            const char* a1 = cA + (size_t)(t + 1) * kstep;
            const char* a2 = last ? nA : cA + (size_t)(t + 2) * kstep; const char* b2 = last ? nB : cB + (size_t)(t + 2) * kstep;
            const char* a3 = a2 + kstep; const char* b3 = b2 + kstep;
            if (last && has_next) S.a_ready(nxt);
            if constexpr (SP2) {
            PG8_LDB(B0, 0, 0); PG8_LDB(B1, 0, 1); PG8_SCHED; PG8_LDA(At, 0, 0); PG8_STAGE(PG8_SA(1, 1), a1 + hstep, voffA);
            PG8_WAIT_V(8); PG8_WAIT_L(0); PG8_BAR; PG8_MMA(0, 0, At, B0); PG8_MMA(0, 1, At, B1); PG8_BAR; PG8_SCHED;
            PG8_LDA(At, 0, 1); PG8_STAGE(PG8_SB(0, 0), b2, voffB); PG8_STAGE(PG8_SB(0, 1), b2 + hstep, voffB); PG8_STAGE(PG8_SA(0, 0), a2, voffA);
            PG8_WAIT_V(8); PG8_WAIT_L(0); PG8_BAR; PG8_MMA(1, 0, At, B0); PG8_MMA(1, 1, At, B1); PG8_BAR; PG8_SCHED;
            PG8_LDB(B0, 1, 0); PG8_LDB(B1, 1, 1); PG8_SCHED; PG8_LDA(At, 1, 0); PG8_STAGE(PG8_SA(0, 1), a2 + hstep, voffA);
            PG8_WAIT_V(8); PG8_WAIT_L(0); PG8_BAR; PG8_MMA(0, 0, At, B0); PG8_MMA(0, 1, At, B1); PG8_BAR; PG8_SCHED;
            PG8_LDA(At, 1, 1); PG8_STAGE(PG8_SB(1, 0), b3, voffB); PG8_STAGE(PG8_SB(1, 1), b3 + hstep, voffB); PG8_STAGE(PG8_SA(1, 0), a3, voffA);
            PG8_WAIT_V(8); PG8_WAIT_L(0); PG8_BAR; PG8_MMA(1, 0, At, B0); PG8_MMA(1, 1, At, B1); PG8_BAR; PG8_SCHED;
            } else {
            PG8_LDB(B0, 0, 0); PG8_SCHED; PG8_LDA(At, 0, 0); PG8_STAGE(PG8_SA(1, 1), a1 + hstep, voffA);
            PG8_WAIT_L(8); PG8_BAR; PG8_WAIT_L(0); PG8_MMA(0, 0, At, B0); PG8_BAR; PG8_SCHED;
            PG8_LDB(B1, 0, 1); PG8_STAGE(PG8_SB(0, 0), b2, voffB);
            PG8_BAR; PG8_WAIT_L(0); PG8_MMA(0, 1, At, B1); PG8_BAR;
            PG8_LDA(At, 0, 1); PG8_STAGE(PG8_SA(0, 0), a2, voffA);
            PG8_BAR; PG8_WAIT_L(0); PG8_MMA(1, 0, At, B0); PG8_BAR; PG8_SCHED;
            PG8_STAGE(PG8_SB(0, 1), b2 + hstep, voffB);
            PG8_WAIT_V(6); PG8_BAR; PG8_MMA(1, 1, At, B1); PG8_BAR;
            PG8_LDB(B0, 1, 0); PG8_SCHED; PG8_LDA(At, 1, 0); PG8_STAGE(PG8_SA(0, 1), a2 + hstep, voffA);
            PG8_WAIT_L(8); PG8_BAR; PG8_WAIT_L(0); PG8_MMA(0, 0, At, B0); PG8_BAR; PG8_SCHED;
            PG8_LDB(B1, 1, 1); PG8_STAGE(PG8_SB(1, 0), b3, voffB);
            PG8_BAR; PG8_WAIT_L(0); PG8_MMA(0, 1, At, B1); PG8_BAR;
            PG8_LDA(At, 1, 1); PG8_STAGE(PG8_SA(1, 0), a3, voffA);
            PG8_BAR; PG8_WAIT_L(0); PG8_MMA(1, 0, At, B0); PG8_BAR; PG8_SCHED;
            PG8_STAGE(PG8_SB(1, 1), b3 + hstep, voffB);
            PG8_WAIT_V(6); PG8_BAR; PG8_MMA(1, 1, At, B1); PG8_BAR;
            }
        }
        if constexpr (ALIGN_EPI) { if (wr == 0) PG8_BAR; }
        if constexpr (!Epi::AFTER_DRAIN) { E(acc, cur, wr, wc, fr, fq); S.done(cur); }
        if (!has_next) break;
#pragma unroll
        for (int a = 0; a < 2; ++a)
#pragma unroll
            for (int b = 0; b < 2; ++b)
#pragma unroll
                for (int m = 0; m < 4; ++m)
#pragma unroll
                    for (int n = 0; n < 2; ++n) acc[a][b][m][n] = (f32x4){0.f, 0.f, 0.f, 0.f};
        cur = nxt; cA = nA; cB = nB; ++ui;
        if constexpr (ALIGN_EPI) { if (wr == 1) PG8_BAR; }
    }
    PG8_WAIT_V(0);
    if constexpr (!ALIGN_EPI) { if (wr == 0) PG8_BAR; }
    PG8_BAR;
    if constexpr (Epi::AFTER_DRAIN) { E.fused(acc, cur, wr, wc, fr, fq, lds, wid, lane); S.done(cur); }
#undef PG8_SA
#undef PG8_SB
#undef PG8_STAGE
#undef PG8_LDA
#undef PG8_LDB
#undef PG8_MMA
#undef PG8_WAIT_V
#undef PG8_WAIT_L
#undef PG8_BAR
#undef PG8_SCHED
}
}

#ifndef PG8_SP2
#define PG8_SP2 true
#endif
#ifndef PG8_ALIGN
#define PG8_ALIGN true
#endif
#include <hip/hip_bf16.h>
#include <cmath>
namespace attn_body {
using bf16=__hip_bfloat16;
using bf16x8=__attribute__((ext_vector_type(8)))short;
using s16x4=__attribute__((ext_vector_type(4)))short;
using f32x16=__attribute__((ext_vector_type(16)))float;
using u32x4=__attribute__((ext_vector_type(4)))unsigned;
constexpr int BATCH=2,NHEAD=16,SEQ=8192,D=64,DM=NHEAD*D;
constexpr int NW=8,QBLK=32,QB=QBLK*NW,KVBLK=64,NQB=SEQ/QB;
constexpr int ATTN_PITCH=DM, ATTN_UNIT_ROWS=QB;
__device__ __forceinline__ int crow(int r,int hi){return (r&3)+8*(r>>2)+4*hi;}
#define SBAR() __builtin_amdgcn_sched_barrier(0)
__device__ __forceinline__ void cmask(f32x16&p0,f32x16&p1,int jb,int qrel,int hi){
  const float NEG=-INFINITY; int kb=64*jb+4*hi;
  #pragma unroll
  for(int r=0;r<16;++r){int kv=kb+(r&3)+8*(r>>2); if(kv>qrel)p0[r]=NEG; if(kv+32>qrel)p1[r]=NEG;}
}

constexpr int NSLOT=3, SLOTB=8192;
constexpr int LDS_K=0, LDS_V=NSLOT*SLOTB, LDS_WS=2*NSLOT*SLOTB, LDS_OST=LDS_WS+NW*64*4, LDS_BYTES=LDS_OST+NW*4096;
constexpr float C2=0.125f*1.4426950408889634f;
__device__ __forceinline__ void glds16(const void*gsrc,unsigned lds_dst){unsigned keep;
  asm volatile("s_mov_b32 %0, m0\n\ts_mov_b32 m0, %2\n\ts_nop 0\n\tglobal_load_lds_dwordx4 %1, off\n\ts_mov_b32 m0, %0":"=&s"(keep):"v"(gsrc),"s"(lds_dst):"memory");}
__device__ __forceinline__ float max3f(float a,float b,float c){float r;asm("v_max3_f32 %0, %1, %2, %3":"=v"(r):"v"(a),"v"(b),"v"(c));return r;}
__device__ __forceinline__ float max2f(float a,float b){float r;asm("v_max_f32_e32 %0, %1, %2":"=v"(r):"v"(a),"v"(b));return r;}
__device__ __forceinline__ float fadd_s(float a,float b){float r;asm("v_add_f32_e32 %0, %1, %2":"=v"(r):"v"(a),"v"(b));return r;}
__device__ __forceinline__ float fsub_s(float a,float b){float r;asm("v_sub_f32_e32 %0, %1, %2":"=v"(r):"v"(a),"v"(b));return r;}
typedef float f32x2_t __attribute__((ext_vector_type(2))); typedef __bf16 bf16x2_t __attribute__((ext_vector_type(2)));
__device__ __forceinline__ unsigned cvtpk_s(float lo,float hi){f32x2_t v={lo,hi};bf16x2_t b=__builtin_convertvector(v,bf16x2_t);return __builtin_bit_cast(unsigned,b);}
#define WAIT_BAR(N) asm volatile("s_waitcnt vmcnt(" #N ") lgkmcnt(0)\n\ts_barrier":::"memory")

typedef __attribute__((address_space(3))) const float* lds_fptr; typedef float f32x4_t __attribute__((ext_vector_type(4))); typedef __attribute__((address_space(3))) const f32x4_t* lds_f4ptr;
__device__ __forceinline__ void qkt(f32x16&p0,f32x16&p1,const char*Kslot,const bf16x8*qr,int r32,int hi){
  const char*kb=Kslot+hi*1024+r32*16;
  #pragma unroll
  for(int d0=0;d0<4;++d0){
    const bf16x8 b0=*reinterpret_cast<const bf16x8*>(kb+d0*2048);
    const bf16x8 b1=*reinterpret_cast<const bf16x8*>(kb+d0*2048+512);
    p0=__builtin_amdgcn_mfma_f32_32x32x16_bf16(b0,qr[d0],p0,0,0,0);p1=__builtin_amdgcn_mfma_f32_32x32x16_bf16(b1,qr[d0],p1,0,0,0);}
}
typedef __attribute__((address_space(3))) const char* lds_cptr;
typedef short v4i16_t __attribute__((ext_vector_type(4)));
__device__ __forceinline__ void kload8(bf16x8*kf,lds_cptr kp){
  kf[0]=*(const __attribute__((address_space(3))) bf16x8*)(kp);      kf[1]=*(const __attribute__((address_space(3))) bf16x8*)(kp+512);
  kf[2]=*(const __attribute__((address_space(3))) bf16x8*)(kp+2048); kf[3]=*(const __attribute__((address_space(3))) bf16x8*)(kp+2560);
  kf[4]=*(const __attribute__((address_space(3))) bf16x8*)(kp+4096); kf[5]=*(const __attribute__((address_space(3))) bf16x8*)(kp+4608);
  kf[6]=*(const __attribute__((address_space(3))) bf16x8*)(kp+6144); kf[7]=*(const __attribute__((address_space(3))) bf16x8*)(kp+6656);
}
__device__ __forceinline__ void kload2(bf16x8*kf,lds_cptr kp,int j){ kf[2*j]=*(const __attribute__((address_space(3))) bf16x8*)(kp+j*2048); kf[2*j+1]=*(const __attribute__((address_space(3))) bf16x8*)(kp+j*2048+512); }
__device__ __forceinline__ s16x4 vtr(lds_cptr p){ return __builtin_bit_cast(s16x4,__builtin_amdgcn_ds_read_tr16_b64_v4i16((__attribute__((address_space(3))) v4i16_t*)p)); }
__device__ __forceinline__ float rowmax(const f32x16&p0,const f32x16&p1){
  float a=max3f(p0[0],p0[1],p1[0]),b=max3f(p0[2],p0[3],p1[1]);a=max3f(a,p1[2],p1[3]);
  #pragma unroll
  for(int r=4;r<16;r+=4){a=max3f(a,p0[r],p0[r+1]);b=max3f(b,p0[r+2],p0[r+3]);a=max3f(a,p1[r],p1[r+1]);b=max3f(b,p1[r+2],p1[r+3]);}
  const float m=max2f(a,b);
  auto rr=__builtin_amdgcn_permlane32_swap(__float_as_uint(m),__float_as_uint(m),false,false);
  return max2f(__uint_as_float(rr[0]),__uint_as_float(rr[1]));
}
__device__ __forceinline__ void pv(f32x16*o,int vb,bf16x8 pa0,bf16x8 pa1,bf16x8 pa2,bf16x8 pa3){
  #pragma unroll
  for(int d0=0;d0<2;++d0){s16x4 lo[4],hi[4];
    #pragma unroll
    for(int ks=0;ks<4;++ks){
      asm volatile("ds_read_b64_tr_b16 %0,%1 offset:%c2":"=&v"(lo[ks]):"v"(vb),"i"(d0*4096+ks*1024):"memory");
      asm volatile("ds_read_b64_tr_b16 %0,%1 offset:%c2":"=&v"(hi[ks]):"v"(vb),"i"(d0*4096+ks*1024+512):"memory");}
    asm volatile("s_waitcnt lgkmcnt(0)":::"memory");SBAR();
    #define PK(k) (bf16x8){lo[k][0],lo[k][1],lo[k][2],lo[k][3],hi[k][0],hi[k][1],hi[k][2],hi[k][3]}
    o[d0]=__builtin_amdgcn_mfma_f32_32x32x16_bf16(pa0,PK(0),o[d0],0,0,0);
    o[d0]=__builtin_amdgcn_mfma_f32_32x32x16_bf16(pa1,PK(1),o[d0],0,0,0);
    o[d0]=__builtin_amdgcn_mfma_f32_32x32x16_bf16(pa2,PK(2),o[d0],0,0,0);
    o[d0]=__builtin_amdgcn_mfma_f32_32x32x16_bf16(pa3,PK(3),o[d0],0,0,0);
    #undef PK
  }
}

#ifndef ATTN_STORE16
#define ATTN_STORE16(p,v) (*(u32x4*)(p)=(v))
#endif
template<int THRL> __device__ __forceinline__ void attn_unit(int b,int h,int qb,const bf16*Q,const bf16*__restrict__ K,const bf16*__restrict__ V,bf16*O,char*shm,lds_fptr Gp,int tstart){
  const int tid=otid(),lane=tid&63,r32=lane&31,hi=lane>>5; const int wid=__builtin_amdgcn_readfirstlane(tid>>6);
  const long rowbase=(long)b*SEQ; const int q0=qb*QB;
  const bf16*Qw=Q+(rowbase+q0+wid*QBLK)*DM+h*D;
  const bf16*Kh=K+(rowbase+(long)tstart*KVBLK)*DM+h*D,*Vh=V+(rowbase+(long)tstart*KVBLK)*DM+h*D; const lds_fptr Gk=Gp+KVBLK*tstart;
  const unsigned lds0=(unsigned)(uintptr_t)shm;
  float*wsf=(float*)(shm+LDS_WS)+wid*64;
  const bf16*ksrc=Kh+(long)lane*DM+wid*8;
  const bf16*vsrc=Vh+(long)(16*(wid&3)+(lane>>2))*DM+(wid>>2)*32+(lane&3)*8;
  const unsigned kdst=lds0+LDS_K+wid*1024, vdst=lds0+LDS_V+wid*1024;
  #define DMA_K(t,slot) glds16(ksrc+(long)(t)*KVBLK*DM,(unsigned)__builtin_amdgcn_readfirstlane(kdst+(slot)))
  #define DMA_V(t,slot) glds16(vsrc+(long)(t)*KVBLK*DM,(unsigned)__builtin_amdgcn_readfirstlane(vdst+(slot)))
  const int vb0=(int)(lds0+LDS_V)+((lane>>4)&1)*32+(lane&3)*8+(4*hi+((lane&15)>>2))*64;
  const char*Kbase=shm+LDS_K; bf16x8 kf[8];
  const lds_cptr shm3=(lds_cptr)shm; const lds_cptr kp0=shm3+LDS_K+hi*1024+r32*16; const lds_cptr vp0=shm3+LDS_V+((lane>>4)&1)*32+(lane&3)*8+(4*hi+((lane&15)>>2))*64;
  const int NT=(q0+QB)/KVBLK-tstart;
  DMA_K(0,0);DMA_V(0,0);DMA_K(1,SLOTB);
  bf16x8 qr[4];
  #pragma unroll
  for(int d0=0;d0<4;++d0)qr[d0]=*reinterpret_cast<const bf16x8*>(&Qw[(long)r32*DM+d0*16+hi*8]);
  float mhat=0.f,l_reg=0.f;f32x16 o[2];o[0]=f32x16{};o[1]=f32x16{};
  const float Gq=Gp[q0+wid*QBLK+r32]; float negmq=Gq;
  #define BIAS_LD(X0,X1,t) do{ const lds_f4ptr gp_=(lds_f4ptr)(Gk+64*(t)+4*hi); _Pragma("unroll") for(int j_=0;j_<4;++j_){ const f32x4_t a_=gp_[2*j_], b_=gp_[8+2*j_]; \
      X0[4*j_]=a_[0];X0[4*j_+1]=a_[1];X0[4*j_+2]=a_[2];X0[4*j_+3]=a_[3]; X1[4*j_]=b_[0];X1[4*j_+1]=b_[1];X1[4*j_+2]=b_[2];X1[4*j_+3]=b_[3]; } }while(0)
  #define BSUB4(X,B) do{ X[B]=negmq-X[B]; X[(B)+1]=negmq-X[(B)+1]; X[(B)+2]=negmq-X[(B)+2]; X[(B)+3]=negmq-X[(B)+3]; }while(0)
  #define BSUBALL(X0,X1) do{ _Pragma("unroll") for(int r_=0;r_<16;++r_){ X0[r_]=negmq-X0[r_]; X1[r_]=negmq-X1[r_]; } }while(0)
  const int qrel=wid*QBLK+r32;
  #define CMASK(P0,P1,t) do{int jb_=(t)-(NT-4); if(jb_>=0)cmask(P0,P1,jb_,qrel,hi);}while(0)
  bool resc=false;
  #define START(P0,P1) do{ const float rm=rowmax(P0,P1); resc=false; \
    { const float dl=__builtin_fmaxf(rm,-40.f); mhat=fadd_s(mhat,dl); \
      _Pragma("unroll") for(int r=0;r<16;++r){P0[r]=fsub_s(P0[r],dl);P1[r]=fsub_s(P1[r],dl);} \
      negmq=Gq-mhat; } \
    _Pragma("unroll") for(int r=0;r<16;++r)P0[r]=__builtin_amdgcn_exp2f(P0[r]); }while(0)
  #define RESC() do{ if(resc){ asm volatile("s_waitcnt lgkmcnt(0)":::"memory"); \
      _Pragma("unroll") for(int d_=0;d_<2;++d_) _Pragma("unroll") for(int r=0;r<16;++r)o[d_][r]*=wsf[crow(r,hi)]; } }while(0)
  f32x16 pA0,pA1,pB0,pB1;
  int sl_prev=0,sl_cur=0,sl_next=SLOTB;
  #define ROT() do{sl_prev=sl_cur;sl_cur=sl_next;sl_next=(sl_next==(NSLOT-1)*SLOTB)?0:sl_next+SLOTB;}while(0)
  DMA_K(2,2*SLOTB);
  WAIT_BAR(3);
  BIAS_LD(pA0,pA1,0); BSUBALL(pA0,pA1);
  qkt(pA0,pA1,Kbase,qr,r32,hi);asm volatile("s_nop 15\n\ts_nop 7":"+v"(pA0),"+v"(pA1));CMASK(pA0,pA1,0);
  START(pA0,pA1);
  _Pragma("unroll") for(int r=0;r<16;++r)pA1[r]=__builtin_amdgcn_exp2f(pA1[r]);
  BIAS_LD(pB0,pB1,1); BSUBALL(pB0,pB1);
  WAIT_BAR(0);
  DMA_K(3,0);DMA_V(1,SLOTB);
  ROT();
  kload8(kf,kp0+sl_cur);
  WAIT_BAR(2);
  s16x4 vlo[8],vhi[8]; u32x4 pw0,pw1,pw2,pw3;
  #define PKW(P,B) cvtpk_s(P[B],P[B+1])
  #define PAF(k) __builtin_bit_cast(bf16x8,pw##k)
  #define VFR(i) (bf16x8){vlo[i][0],vlo[i][1],vlo[i][2],vlo[i][3],vhi[i][0],vhi[i][1],vhi[i][2],vhi[i][3]}
  #define PIN(x) asm volatile("":"+v"(x))
  #define MX3(a,b,c) __builtin_fmaxf(__builtin_fmaxf((a),(b)),(c))
  #define GAPA(MF,A0,A1,A2,A3,W0,W1,PW) do{ MF; sacc+=A0; sacc+=A1; sacc+=A2; sacc+=A3; PIN(sacc); W0; W1; PIN(PW); SBAR(); }while(0)
  #define EX(v) __builtin_amdgcn_exp2f(v)
  #define GAPB(MF,X,B,GL_,Y,YB) do{ MF; X[B]=EX(X[B]); X[B+1]=EX(X[B+1]); X[B+2]=EX(X[B+2]); X[B+3]=EX(X[B+3]); PIN(X); if(GL_){ BSUB4(Y,YB); PIN(Y); } SBAR(); }while(0)
  #define VRD(i) do{ vlo[i]=vtr(vp_+(((i)>>2)*4096+((i)&3)*1024)); vhi[i]=vtr(vp_+(((i)>>2)*4096+((i)&3)*1024+512)); }while(0)
  #define KRD(G,j) do{ if(G){ kload2(kf,kp0+sl_next,j); SBAR(); } }while(0)
  #define STEP(C0,C1,P0,P1,t,GK,GV,GL) do{ SBAR(); \
    const lds_cptr vp_=vp0+sl_prev; \
    VRD(0); SBAR(); float sacc=(P0[0]+P0[1]); \
    GAPA(C0=__builtin_amdgcn_mfma_f32_32x32x16_bf16(kf[0],qr[0],C0,0,0,0), P0[2],P0[3],P0[4],P0[5],     pw0[0]=PKW(P0,0), pw0[1]=PKW(P0,2), pw0); \
    VRD(4); SBAR(); GAPA(C1=__builtin_amdgcn_mfma_f32_32x32x16_bf16(kf[1],qr[0],C1,0,0,0), P0[6],P0[7],P0[8],P0[9],     pw0[2]=PKW(P0,4), pw0[3]=PKW(P0,6), pw0); \
    VRD(1); SBAR(); GAPA(C0=__builtin_amdgcn_mfma_f32_32x32x16_bf16(kf[2],qr[1],C0,0,0,0),   P0[10],P0[11],P0[12],P0[13], pw1[0]=PKW(P0,8), pw1[1]=PKW(P0,10), pw1); \
    VRD(5); SBAR(); GAPA(C1=__builtin_amdgcn_mfma_f32_32x32x16_bf16(kf[3],qr[1],C1,0,0,0),   P0[14],P0[15],P1[0],P1[1],   pw1[2]=PKW(P0,12),pw1[3]=PKW(P0,14), pw1); \
    VRD(2); SBAR(); GAPA(C0=__builtin_amdgcn_mfma_f32_32x32x16_bf16(kf[4],qr[2],C0,0,0,0),   P1[2],P1[3],P1[4],P1[5],     pw2[0]=PKW(P1,0), pw2[1]=PKW(P1,2), pw2); \
    VRD(6); SBAR(); GAPA(C1=__builtin_amdgcn_mfma_f32_32x32x16_bf16(kf[5],qr[2],C1,0,0,0),   P1[6],P1[7],P1[8],P1[9],     pw2[2]=PKW(P1,4), pw2[3]=PKW(P1,6), pw2); \
    VRD(3); SBAR(); GAPA(C0=__builtin_amdgcn_mfma_f32_32x32x16_bf16(kf[6],qr[3],C0,0,0,0),   P1[10],P1[11],P1[12],P1[13], pw3[0]=PKW(P1,8), pw3[1]=PKW(P1,10), pw3); \
    VRD(7); SBAR(); GAPA(C1=__builtin_amdgcn_mfma_f32_32x32x16_bf16(kf[7],qr[3],C1,0,0,0),   P1[14],P1[15],0.f,0.f,       pw3[2]=PKW(P1,12),pw3[3]=PKW(P1,14), pw3); \
    l_reg+=sacc; \
    if(GK){DMA_K((t)+3,sl_cur);} if(GV){DMA_V((t)+1,sl_next);} \
    CMASK(C0,C1,t); \
    { float a=MX3(C0[0],C0[1],C1[0]),b=MX3(C0[2],C0[3],C1[1]); a=MX3(a,C1[2],C1[3]); \
      _Pragma("unroll") for(int r=4;r<16;r+=4){a=MX3(a,C0[r],C0[r+1]);b=MX3(b,C0[r+2],C0[r+3]);a=MX3(a,C1[r],C1[r+1]);b=MX3(b,C1[r+2],C1[r+3]);} \
      float rm=__builtin_fmaxf(a,b); { auto rr=__builtin_amdgcn_permlane32_swap(__float_as_uint(rm),__float_as_uint(rm),false,false); rm=__builtin_fmaxf(__uint_as_float(rr[0]),__uint_as_float(rr[1])); } \
      resc=false; \
      if(__builtin_expect(__any(rm>(float)THRL),0)){ const float dl=__builtin_fmaxf(rm,0.f); mhat+=dl; \
        _Pragma("unroll") for(int r=0;r<16;++r){C0[r]-=dl;C1[r]-=dl;} \
        negmq=Gq-mhat; \
        const float f=__builtin_amdgcn_exp2f(-dl); l_reg*=f; if(hi==0)wsf[r32]=f; resc=true; } } \
    if(GL){ BIAS_LD(P0,P1,(t)+1); } \
    SBAR(); \
    GAPB(o[0]=__builtin_amdgcn_mfma_f32_32x32x16_bf16(PAF(0),VFR(0),o[0],0,0,0), C0,0, GL,P0,0); \
    GAPB(o[1]=__builtin_amdgcn_mfma_f32_32x32x16_bf16(PAF(0),VFR(4),o[1],0,0,0), C0,4, GL,P0,4); \
    KRD(GL,0); GAPB(o[0]=__builtin_amdgcn_mfma_f32_32x32x16_bf16(PAF(1),VFR(1),o[0],0,0,0), C0,8, GL,P0,8); \
    KRD(GL,1); GAPB(o[1]=__builtin_amdgcn_mfma_f32_32x32x16_bf16(PAF(1),VFR(5),o[1],0,0,0), C0,12, GL,P0,12); \
    KRD(GL,2); GAPB(o[0]=__builtin_amdgcn_mfma_f32_32x32x16_bf16(PAF(2),VFR(2),o[0],0,0,0), C1,0, GL,P1,0); \
    KRD(GL,3); GAPB(o[1]=__builtin_amdgcn_mfma_f32_32x32x16_bf16(PAF(2),VFR(6),o[1],0,0,0), C1,4, GL,P1,4); \
    GAPB(o[0]=__builtin_amdgcn_mfma_f32_32x32x16_bf16(PAF(3),VFR(3),o[0],0,0,0), C1,8, GL,P1,8); \
    GAPB(o[1]=__builtin_amdgcn_mfma_f32_32x32x16_bf16(PAF(3),VFR(7),o[1],0,0,0), C1,12, GL,P1,12); \
    }while(0)
  int t=1;
  #undef CMASK
  #define CMASK(P0,P1,t) do{}while(0)
  for(;t+5<NT;t+=2){
    STEP(pB0,pB1,pA0,pA1,t,true,true,true);     WAIT_BAR(2); RESC(); ROT();
    STEP(pA0,pA1,pB0,pB1,t+1,true,true,true);   WAIT_BAR(2); RESC(); ROT();
  }
  #undef CMASK
  #define CMASK(P0,P1,t) do{int jb_=(t)-(NT-4); if(jb_>=0)cmask(P0,P1,jb_,qrel,hi);}while(0)
  #define ENDW(tt) do{ if((tt)+3<NT){WAIT_BAR(2);} else if((tt)+2<NT){WAIT_BAR(1);} else {WAIT_BAR(0);} }while(0)
  for(;t+1<NT;t+=2){
    STEP(pB0,pB1,pA0,pA1,t,(t+3<NT),(t+1<NT),(t+1<NT));       ENDW(t);   RESC(); ROT();
    STEP(pA0,pA1,pB0,pB1,t+1,(t+4<NT),(t+2<NT),(t+2<NT));     ENDW(t+1); RESC(); ROT();
  }
  STEP(pB0,pB1,pA0,pA1,NT-1,false,false,false); RESC();
  { float sacc=pB0[0]+pB0[1]; _Pragma("unroll") for(int r=2;r<16;++r)sacc+=pB0[r]; _Pragma("unroll") for(int r=0;r<16;++r)sacc+=pB1[r]; l_reg+=sacc;
    pw0=(u32x4){PKW(pB0,0),PKW(pB0,2),PKW(pB0,4),PKW(pB0,6)};pw1=(u32x4){PKW(pB0,8),PKW(pB0,10),PKW(pB0,12),PKW(pB0,14)};pw2=(u32x4){PKW(pB1,0),PKW(pB1,2),PKW(pB1,4),PKW(pB1,6)};pw3=(u32x4){PKW(pB1,8),PKW(pB1,10),PKW(pB1,12),PKW(pB1,14)};
    SBAR(); pv(o,vb0+sl_cur,PAF(0),PAF(1),PAF(2),PAF(3)); }
  #undef PKW
  #undef PAF
  #undef VFR
  #undef PIN
  #undef MX3
  #undef GAPA
  #undef GAPB
  #undef EX
  #undef VRD
  #undef KRD
  #undef STEP
  #undef ENDW
  {auto rr=__builtin_amdgcn_permlane32_swap(__float_as_uint(l_reg),__float_as_uint(l_reg),false,false);l_reg=__uint_as_float(rr[0])+__uint_as_float(rr[1]);}
  if(hi==0)wsf[32+r32]=l_reg;asm volatile("s_waitcnt lgkmcnt(0)":::"memory");
  float rli[16];
  #pragma unroll
  for(int r=0;r<16;++r)rli[r]=__builtin_amdgcn_rcpf(wsf[32+crow(r,hi)]);
  bf16*Ow=O+(rowbase+q0+wid*QBLK)*DM+h*D;
  { bf16*stg=(bf16*)(shm+LDS_OST)+wid*2048;
    #pragma unroll
    for(int r=0;r<16;++r){const int orow=crow(r,hi);
      #pragma unroll
      for(int d0=0;d0<2;++d0)stg[orow*64+d0*32+r32]=__float2bfloat16(o[d0][r]*rli[r]);}
    asm volatile("s_waitcnt lgkmcnt(0)":::"memory");
    #pragma unroll
    for(int i=0;i<4;++i){const int row=i*8+(lane>>3),ch=lane&7; const u32x4 v=*(const u32x4*)(stg+row*64+ch*8); ATTN_STORE16(Ow+(long)row*DM+ch*8,v);} }
  asm volatile("s_waitcnt lgkmcnt(0)\n\ts_barrier":::"memory");
  #undef DMA_K
  #undef BIAS_LD
  #undef BSUB4
  #undef BSUBALL
  #undef DMA_V
  #undef CMASK
  #undef START
  #undef RESC
  #undef ROT
}
constexpr int ATTN_LDS_BYTES=LDS_BYTES;
#undef SBAR
#undef WAIT_BAR
}
#define GAS __attribute__((address_space(1)))
#define LAS __attribute__((address_space(3)))
typedef unsigned short bf16;
typedef unsigned v4u __attribute__((ext_vector_type(4)));
typedef float f32x4 __attribute__((ext_vector_type(4)));
typedef float f32x2 __attribute__((ext_vector_type(2)));
typedef short bf16x8 __attribute__((ext_vector_type(8)));
constexpr int NWAVES = 8;
constexpr int M = 16384, D = 1024, T = 8192, FF = 2816, NGU = 5632, R = 1280, NH = 16, NQKV = 3072, NFOX = 3088;
constexpr size_t MiB = 1u << 20;
constexpr size_t WS_SS = 0;
constexpr size_t WS_LOGF = 1 * MiB;
constexpr size_t WS_LSUM = 2 * MiB;
constexpr size_t WS_WF = 5 * MiB;
constexpr size_t WS_WLG = 5 * MiB + 512 * 1024;
constexpr size_t WS_NRM = 6 * MiB + 65536;
constexpr size_t WS_SP = 6 * MiB;
constexpr size_t WS_WGU = 8 * MiB, WGU_BYTES = 11 * MiB;
constexpr size_t WS_WD = 52 * MiB, WD_BYTES = 5 * MiB + 512 * 1024;
constexpr size_t WS_WQKV = 74 * MiB, WS_WO = 80 * MiB, WS_WLIN = 82 * MiB, WS_WLOUT = 87 * MiB;
constexpr size_t WS_XB = 90 * MiB;
constexpr size_t WS_BIG = 122 * MiB;
constexpr size_t WS_END = 218 * MiB;
constexpr int LDS_BYTES = 147456;
constexpr float LOG2E = 1.4426950408889634f;

__device__ __forceinline__ unsigned f2bf(float f) { unsigned u = __builtin_bit_cast(unsigned, f); return (u + 0x7fffu + ((u >> 16) & 1u)) >> 16; }
__device__ __forceinline__ unsigned pk2(float lo, float hi) { return f2bf(lo) | (f2bf(hi) << 16); }
__device__ __forceinline__ float bf2f(unsigned short b) { return __builtin_bit_cast(float, (unsigned)b << 16); }
__device__ __forceinline__ float wave_sum(float v) {
#pragma unroll
    for (int o = 1; o < 64; o <<= 1) v += __shfl_xor(v, o);
    return v;
}

#define XB_TMO      128
#define XB_XCNT(j)  (256  + 64 * (j))
#define XB_XSUB(j)  (1280 + 64 * (j))
#define XB_XGEN(j)  (2304 + 64 * (j))
#define XB_TOP      3328
#define XB_TOPGEN   3392
#define XCD_BAR_WORDS 3456
#define XB_SPIN_CAP (1u << 18)

__device__ __forceinline__ unsigned xb_ld(unsigned* p)              { return __hip_atomic_load(p, __ATOMIC_RELAXED, __HIP_MEMORY_SCOPE_AGENT); }
__device__ __forceinline__ unsigned xb_add(unsigned* p, unsigned v) { return __hip_atomic_fetch_add(p, v, __ATOMIC_RELAXED, __HIP_MEMORY_SCOPE_AGENT); }
__device__ __forceinline__ unsigned xb_xcc_id() { return (unsigned)__builtin_amdgcn_s_getreg((3 << 11) | 20) & 0xFu; }
#define XB_SPIN(cond, bar) do { unsigned _sp = 0; while (cond) { __builtin_amdgcn_s_sleep(1); \
    if ((++_sp & 255u) == 0u) { if (xb_ld(&(bar)[XB_TMO])) break; if (_sp > XB_SPIN_CAP) { atomicAdd(&(bar)[XB_TMO], 1u); break; } } } } while (0)

struct XcdBarrier {
    unsigned* bar; unsigned x;
    volatile LAS unsigned* st;
};

__device__ __forceinline__ XcdBarrier xcd_barrier_post(unsigned* bar, volatile LAS unsigned* st) {
    XcdBarrier b; b.bar = bar; b.x = xb_xcc_id(); b.st = st;
    if (threadIdx.x == 0) (void)xb_add(&bar[XB_XCNT(b.x)], 1u);
    return b;
}
__device__ __forceinline__ void xcd_barrier_complete(unsigned* bar, unsigned x, unsigned& nloc, unsigned& nx) {
    const unsigned G = gridDim.x * gridDim.y * gridDim.z;
    unsigned sum, cnt, mine, sp = 0u;
    for (;;) {
        sum = 0u; cnt = 0u; mine = 0u;
#pragma unroll
        for (unsigned j = 0; j < 16; ++j) { const unsigned c = xb_ld(&bar[XB_XCNT(j)]); sum += c; cnt += (c > 0u) ? 1u : 0u; mine = (j == x) ? c : mine; }
        if (sum == G) break;
        __builtin_amdgcn_s_sleep(1);
        if ((++sp & 255u) == 0u) { if (xb_ld(&bar[XB_TMO])) break; if (sp > XB_SPIN_CAP) { atomicAdd(&bar[XB_TMO], 1u); break; } }
    }
    nloc = mine > 0u ? mine : 1u; nx = cnt > 0u ? cnt : 1u;
}

__device__ __forceinline__ void xcd_barrier(const XcdBarrier& b) {
    asm volatile("s_waitcnt vmcnt(0)" ::: "memory");
    __syncthreads();
    if (threadIdx.x == 0) {
        unsigned* bar = b.bar;
        __builtin_amdgcn_s_waitcnt(0);
        unsigned nloc = b.st[0], nx = b.st[1];
        if (nloc == 0u) { xcd_barrier_complete(bar, b.x, nloc, nx); b.st[0] = nloc; b.st[1] = nx; }
        const unsigned old = xb_add(&bar[XB_XSUB(b.x)], 1u);
        const unsigned gen = old / nloc;
        if (old + 1u == (gen + 1u) * nloc) {
            __builtin_amdgcn_fence(__ATOMIC_RELEASE, "agent");
            asm volatile("s_waitcnt vmcnt(0)" ::: "memory");
            const unsigned og = xb_add(&bar[XB_TOP], 1u);
            const unsigned tg = og / nx;
            if (og + 1u == (tg + 1u) * nx) xb_add(&bar[XB_TOPGEN], 1u);
            else XB_SPIN(xb_ld(&bar[XB_TOPGEN]) == tg, bar);
            __builtin_amdgcn_fence(__ATOMIC_ACQUIRE, "agent");
            xb_add(&bar[XB_XGEN(b.x)], 1u);
            asm volatile("s_waitcnt vmcnt(0)" ::: "memory");
        } else {
            XB_SPIN(xb_ld(&bar[XB_XGEN(b.x)]) == gen, bar);
            __builtin_amdgcn_fence(__ATOMIC_ACQUIRE, "agent");
            asm volatile("s_waitcnt vmcnt(0)" ::: "memory");
        }
    }
    __syncthreads();
}

constexpr size_t WS_BAR = 7 * MiB, BAR_BYTES = 16384;
constexpr int MISC_OFF = 131072 + 320;
struct Args { const float* in[21]; float* out; unsigned char* ws; int ph_lo, ph_hi; };
enum { I_X = 0, I_F1N, I_F1GU, I_F1D, I_MIXN, I_F2N, I_F2GU, I_F2D, I_FOXIN, I_FOXBF, I_FOXOUT, I_LIN, I_LCW, I_LCB, I_LWA, I_LBA, I_LWI, I_LBI, I_LLAM, I_LOUT, I_FINN };

template <bool GU> __device__ __forceinline__ void tr_item(const float* W, int ldw, int K, int nblk, const float* gain, bf16* WT, LAS float* scr, int item, int lane) {
    const int kb = item / nblk, nb = item - kb * nblk, k0 = 64 * kb, n0 = 32 * nb;
#pragma unroll 8
    for (int i = 0; i < 32; ++i) { const int kk = 2 * i + (lane >> 5); float w = W[(size_t)(k0 + kk) * ldw + n0 + (lane & 31)]; if (gain) w *= gain[k0 + kk]; scr[kk * 33 + (lane & 31)] = w; }
    asm volatile("s_waitcnt lgkmcnt(0)" ::: "memory");
    int row0 = n0;
    if (GU) { const int c = (n0 < FF) ? n0 : n0 - FF; row0 = 256 * (c >> 7) + (c & 127) + ((n0 < FF) ? 0 : 128); }
    const int c8 = lane & 7;
#pragma unroll
    for (int j = 0; j < 4; ++j) { const int n = (lane >> 3) + 8 * j; const LAS float* s = scr + (8 * c8) * 33 + n;
        v4u o; o.x = pk2(s[0 * 33], s[1 * 33]); o.y = pk2(s[2 * 33], s[3 * 33]); o.z = pk2(s[4 * 33], s[5 * 33]); o.w = pk2(s[6 * 33], s[7 * 33]);
        *(v4u*)(WT + (size_t)(row0 + n) * K + k0 + 8 * c8) = o; }
    asm volatile("s_waitcnt lgkmcnt(0)" ::: "memory");
}

template <class Epi> __device__ __forceinline__ void run_gemm(LAS unsigned char* lds, const bf16* A, const bf16* Bt, int N, int K, const Epi& E) {
    pg8::Gemm g{A, Bt, M, N, K}; pg8::StaticOrder S; S.init(M, N, osgpr((int)gridDim.x), osgpr((int)blockIdx.x));
    pg8::gemm_phase<Epi, pg8::StaticOrder, PG8_ALIGN, PG8_SP2>(lds, g, S, E);
}

__device__ __forceinline__ float expm1_small(float x) {
    float p = 1.0f / 5040.0f; p = p * x + 1.0f / 720.0f; p = p * x + 1.0f / 120.0f; p = p * x + 1.0f / 24.0f; p = p * x + 1.0f / 6.0f; p = p * x + 0.5f; p = p * x + 1.0f; return p * x;
}
template <bool PASSB> __device__ __forceinline__ void lru_phase(LAS unsigned char* L, const Args& args, int vcu, int G, int tid, bf16* YOUT) {
    const int lane = tid & 63, wave = __builtin_amdgcn_readfirstlane(tid >> 6), fr = lane & 15, fq = lane >> 4;
    LAS bf16* Wt = (LAS bf16*)(L);
    LAS bf16* xcb = (LAS bf16*)(L + 33280);
    LAS float* xcf = (LAS float*)(L + 46592);
    LAS float* Aa = (LAS float*)(L + 67072);
    LAS float* Bb = (LAS float*)(L + 87552);
    LAS bf16* recs = (LAS bf16*)(L + 108032);
    LAS float* sub = (LAS float*)(L + 118752);
    LAS float* carry = (LAS float*)(L + 121312);
    LAS float* cst = (LAS float*)(L + 121632);
    unsigned char* ws = args.ws;
    const bf16* Wg = (const bf16*)(ws + WS_WLG); const float* sp = (const float*)(ws + WS_SP);
    const bf16* GATE = (const bf16*)(ws + WS_BIG); const bf16* REC = (const bf16*)(ws + WS_BIG + 40 * MiB);
    f32x2* SUM = (f32x2*)(ws + WS_LSUM);
    const int n = vcu & 15, ustep = G >> 4, u0 = vcu >> 4;
    unsigned zero = 0u; asm volatile("" : "+v"(zero));
    const int rr0 = tid / 10, pc0 = tid - rr0 * 10, rr1 = (tid + 512) / 10, pc1 = (tid + 512) - rr1 * 10;
#define LRU_REC_LOAD(uu, q0_, q1_) do { const int b_ = (uu) >> 7, t0_ = ((uu) & 127) * 64; q0_ = (v4u){zero, zero, zero, zero}; q1_ = q0_; \
        if (t0_ - 3 + rr0 >= 0) q0_ = *(const v4u*)(REC + ((size_t)b_ * T + t0_ - 3 + rr0) * R + n * 80 + pc0 * 8); \
        if (tid + 512 < 670) q1_ = *(const v4u*)(REC + ((size_t)b_ * T + t0_ - 3 + rr1) * R + n * 80 + pc1 * 8); } while (0)
#define LRU_SUM_LOAD(uu, sq_) do { const int b_ = (uu) >> 7, j_ = (uu) & 127, lo_ = (j_ < ustep) ? 0 : j_ - ustep; const f32x2* S_ = SUM + ((size_t)b_ * 128) * R + n * 80 + tid; \
        _Pragma("unroll") for (int i_ = 0; i_ < 16; ++i_) { sq_[i_] = (f32x2){1.f, 0.f}; if (tid < 80 && lo_ + i_ < j_) sq_[i_] = S_[(size_t)(lo_ + i_) * R]; } } while (0)
    v4u rq0, rq1; f32x2 sq[16];
    LRU_REC_LOAD(u0, rq0, rq1);
    if (PASSB) LRU_SUM_LOAD(u0, sq);
    for (int p = tid; p < 1920; p += 512) { const int row = p / 12, pc = p - row * 12; *(LAS v4u*)(Wt + row * 104 + pc * 8) = *(const v4u*)(Wg + (size_t)(n * 160 + row) * 96 + pc * 8); }
    if (tid < 128) { const int row = tid >> 1, pc = tid & 1; *(LAS v4u*)(xcb + row * 104 + 80 + pc * 8) = (v4u){zero, zero, zero, zero}; }
    if (tid < 80) { const int c = n * 80 + tid;
        cst[0 * 80 + tid] = args.in[I_LCW][0 * R + c]; cst[1 * 80 + tid] = args.in[I_LCW][1 * R + c]; cst[2 * 80 + tid] = args.in[I_LCW][2 * R + c]; cst[3 * 80 + tid] = args.in[I_LCW][3 * R + c];
        cst[4 * 80 + tid] = args.in[I_LCB][c]; cst[5 * 80 + tid] = args.in[I_LBA][c]; cst[6 * 80 + tid] = args.in[I_LBI][c]; cst[7 * 80 + tid] = sp[c]; }
    float hc = 0.f;
    for (int u = u0; u < 256; u += ustep) {
        const int b = u >> 7, j = u & 127, t0 = j * 64; const size_t rowg0 = (size_t)b * T + t0;
        *(LAS v4u*)(recs + rr0 * 80 + pc0 * 8) = rq0; if (tid + 512 < 670) *(LAS v4u*)(recs + rr1 * 80 + pc1 * 8) = rq1;
        if (PASSB && tid < 80) { if (j < ustep) hc = 0.f;
#pragma unroll
            for (int i = 0; i < 16; ++i) hc = sq[i].x * hc + sq[i].y;
            carry[tid] = hc; }
        v4u gq0 = (v4u){zero, zero, zero, zero}, gq1 = gq0;
        if (PASSB) { gq0 = *(const v4u*)(GATE + (rowg0 + rr0) * R + n * 80 + pc0 * 8); if (tid + 512 < 640) gq1 = *(const v4u*)(GATE + (rowg0 + rr1) * R + n * 80 + pc1 * 8); }
        if (u + ustep < 256) { LRU_REC_LOAD(u + ustep, rq0, rq1); if (PASSB) LRU_SUM_LOAD(u + ustep, sq); }
        __syncthreads();
#pragma unroll
        for (int i = 0; i < 10; ++i) { const int idx = tid + 512 * i, t = idx / 80, c = idx - t * 80;
            float x = cst[4 * 80 + c];
#pragma unroll
            for (int jj = 0; jj < 4; ++jj) x += cst[jj * 80 + c] * bf2f(recs[(t + jj) * 80 + c]);
            xcf[t * 80 + c] = x; xcb[t * 104 + c] = (bf16)f2bf(x); }
        __syncthreads();
        { const int mt = wave & 3, ct0 = (wave >> 2) ? 3 : 0, ct1 = (wave >> 2) ? 5 : 3, tok = 16 * mt + fr;
            for (int ct = ct0; ct < ct1; ++ct) { f32x4 ga = (f32x4){0.f, 0.f, 0.f, 0.f}, gi = ga;
#pragma unroll
                for (int kk = 0; kk < 3; ++kk) { const bf16x8 xf = *(const LAS bf16x8*)(xcb + tok * 104 + 32 * kk + 8 * fq);
                    const bf16x8 wa = *(const LAS bf16x8*)(Wt + (16 * ct + fr) * 104 + 32 * kk + 8 * fq), wi = *(const LAS bf16x8*)(Wt + (80 + 16 * ct + fr) * 104 + 32 * kk + 8 * fq);
                    ga = __builtin_amdgcn_mfma_f32_16x16x32_bf16(wa, xf, ga, 0, 0, 0); gi = __builtin_amdgcn_mfma_f32_16x16x32_bf16(wi, xf, gi, 0, 0, 0); }
                const int ch0 = 16 * ct + 4 * fq; const f32x4 xv = *(const LAS f32x4*)(xcf + tok * 80 + ch0);
                const f32x4 bav = *(const LAS f32x4*)(cst + 5 * 80 + ch0), biv = *(const LAS f32x4*)(cst + 6 * 80 + ch0), spv = *(const LAS f32x4*)(cst + 7 * 80 + ch0); f32x4 av, bv;
#pragma unroll
                for (int e = 0; e < 4; ++e) {
                    const float r = pg8::fast_sigmoid(ga[e] + bav[e]), ig = pg8::fast_sigmoid(gi[e] + biv[e]);
                    const float la = -8.0f * r * spv[e]; float a, om;
                    if (la > -0.125f) { a = 1.0f + expm1_small(la); om = -expm1_small(2.0f * la); } else { a = expf(la); om = -expm1f(2.0f * la); }
                    av[e] = a; bv[e] = __builtin_amdgcn_sqrtf(om) * (ig * xv[e]); }
                *(LAS f32x4*)(Aa + tok * 80 + ch0) = av; *(LAS f32x4*)(Bb + tok * 80 + ch0) = bv; } }
        __syncthreads();
        const int ch = tid % 80, s = tid / 80;
        if (tid < 320) { float Ap = 1.f, Bp = 0.f;
#pragma unroll
            for (int tt = 0; tt < 16; ++tt) { const int t = 16 * s + tt; const float a = Aa[t * 80 + ch], bb = Bb[t * 80 + ch]; Ap *= a; Bp = a * Bp + bb; }
            sub[(s * 80 + ch) * 2] = Ap; sub[(s * 80 + ch) * 2 + 1] = Bp; }
        __syncthreads();
        if (!PASSB) {
            if (tid < 80) { float Ap = 1.f, Bp = 0.f;
#pragma unroll
                for (int s2 = 0; s2 < 4; ++s2) { const float a = sub[(s2 * 80 + tid) * 2], bb = sub[(s2 * 80 + tid) * 2 + 1]; Ap *= a; Bp = a * Bp + bb; }
                SUM[((size_t)b * 128 + j) * R + n * 80 + tid] = (f32x2){Ap, Bp}; }
        } else {
            if (tid < 320) { float h = carry[ch];
                for (int s2 = 0; s2 < s; ++s2) h = sub[(s2 * 80 + ch) * 2] * h + sub[(s2 * 80 + ch) * 2 + 1];
#pragma unroll
                for (int tt = 0; tt < 16; ++tt) { const int t = 16 * s + tt; h = Aa[t * 80 + ch] * h + Bb[t * 80 + ch]; Bb[t * 80 + ch] = h; } }
            __syncthreads();
#define LRU_OUT(rr_, pc_, gv) do { const f32x4 h0 = *(const LAS f32x4*)(Bb + (rr_) * 80 + (pc_) * 8), h1 = *(const LAS f32x4*)(Bb + (rr_) * 80 + (pc_) * 8 + 4); v4u o; \
                o.x = pk2(h0[0] * bf2f((unsigned short)(gv.x & 0xffffu)), h0[1] * bf2f((unsigned short)(gv.x >> 16))); o.y = pk2(h0[2] * bf2f((unsigned short)(gv.y & 0xffffu)), h0[3] * bf2f((unsigned short)(gv.y >> 16))); \
                o.z = pk2(h1[0] * bf2f((unsigned short)(gv.z & 0xffffu)), h1[1] * bf2f((unsigned short)(gv.z >> 16))); o.w = pk2(h1[2] * bf2f((unsigned short)(gv.w & 0xffffu)), h1[3] * bf2f((unsigned short)(gv.w >> 16))); \
                *(v4u*)(YOUT + (rowg0 + (rr_)) * R + n * 80 + (pc_) * 8) = o; } while (0)
            LRU_OUT(rr0, pc0, gq0); if (tid + 512 < 640) LRU_OUT(rr1, pc1, gq1);
#undef LRU_OUT
        }
        __syncthreads();
    }
#undef LRU_REC_LOAD
#undef LRU_SUM_LOAD
}

__device__ __forceinline__ void p0_prologue(LAS unsigned char* lds, const Args& args, int vcu, int G, int tid) {
    const int lane = tid & 63, wave = __builtin_amdgcn_readfirstlane(tid >> 6);
    unsigned char* ws = args.ws;
    LAS float* scr = (LAS float*)(lds + wave * 16384);
    const int gw = vcu * NWAVES + wave, NGW = G * NWAVES;
    constexpr int I_GU = (D / 64) * (NGU / 32), I_DN = (FF / 64) * (D / 32), I_QKV = (D / 64) * (NQKV / 32), I_WO = (D / 64) * (D / 32), I_LI = (D / 64) * (2 * R / 32), I_LO = (R / 64) * (D / 32);
    constexpr int NITEMS = 4 * I_GU + 4 * I_DN + I_QKV + I_WO + I_LI + I_LO;
    for (int it = gw; it < NITEMS; it += NGW) {
        int r = it;
        if (r < 4 * I_GU) { const int f = r / I_GU; r -= f * I_GU; const int layer = f >> 1;
            const float* W = ((f & 1) ? args.in[I_F2GU] : args.in[I_F1GU]) + (size_t)layer * D * NGU; const float* gn = ((f & 1) ? args.in[I_F2N] : args.in[I_F1N]) + layer * D;
            tr_item<true>(W, NGU, D, NGU / 32, gn, (bf16*)(ws + WS_WGU + f * WGU_BYTES), scr, r, lane); continue; }
        r -= 4 * I_GU;
        if (r < 4 * I_DN) { const int f = r / I_DN; r -= f * I_DN; const int layer = f >> 1;
            const float* W = ((f & 1) ? args.in[I_F2D] : args.in[I_F1D]) + (size_t)layer * FF * D;
            tr_item<false>(W, D, FF, D / 32, nullptr, (bf16*)(ws + WS_WD + f * WD_BYTES), scr, r, lane); continue; }
        r -= 4 * I_DN;
        if (r < I_QKV) { tr_item<false>(args.in[I_FOXIN], NFOX, D, NQKV / 32, args.in[I_MIXN], (bf16*)(ws + WS_WQKV), scr, r, lane); continue; }
        r -= I_QKV;
        if (r < I_WO) { tr_item<false>(args.in[I_FOXOUT], D, D, D / 32, nullptr, (bf16*)(ws + WS_WO), scr, r, lane); continue; }
        r -= I_WO;
        if (r < I_LI) { tr_item<false>(args.in[I_LIN], 2 * R, D, 2 * R / 32, args.in[I_MIXN] + D, (bf16*)(ws + WS_WLIN), scr, r, lane); continue; }
        r -= I_LI;
        tr_item<false>(args.in[I_LOUT], D, R, D / 32, nullptr, (bf16*)(ws + WS_WLOUT), scr, r, lane);
    }
    const int gt = vcu * 512 + tid, NGT = G * 512;
    { bf16* wf = (bf16*)(ws + WS_WF);
        for (int i = gt; i < NH * D; i += NGT) { const int h = i >> 10, k = i & 1023; wf[i] = (bf16)f2bf(args.in[I_MIXN][k] * args.in[I_FOXIN][(size_t)k * NFOX + NQKV + h]); } }
    { bf16* wg = (bf16*)(ws + WS_WLG);
        for (int i = gt; i < 16 * 160 * 96; i += NGT) { const int k = i % 96, dd = (i / 96) % 160, n = i / (96 * 160); float v = 0.f;
            if (k < 80) v = (dd < 80) ? args.in[I_LWA][((size_t)n * 80 + k) * 80 + dd] : args.in[I_LWI][((size_t)n * 80 + k) * 80 + (dd - 80)];
            wg[i] = (bf16)f2bf(v); } }
    { float* sp = (float*)(ws + WS_SP); for (int i = gt; i < R; i += NGT) sp[i] = log1pf(expf(-args.in[I_LLAM][i])); }
    { float* ss = (float*)(ws + WS_SS); for (int i = gt; i < 7 * M; i += NGT) ss[M + i] = 0.f; }
    { float* ss0 = (float*)(ws + WS_SS); bf16* xb = (bf16*)(ws + WS_XB); const float* x = args.in[I_X];
        for (int m = gw; m < M; m += NGW) { const f32x4* xr = (const f32x4*)(x + (size_t)m * D) + lane; f32x4 v[4]; float s = 0.f;
#pragma unroll
            for (int j = 0; j < 4; ++j) { v[j] = xr[64 * j]; s += (v[j].x * v[j].x + v[j].y * v[j].y) + (v[j].z * v[j].z + v[j].w * v[j].w); }
            s = wave_sum(s); if (lane == 0) ss0[m] = s;
            unsigned long long* o8 = (unsigned long long*)(xb + (size_t)m * D) + lane;
#pragma unroll
            for (int j = 0; j < 4; ++j) o8[64 * j] = (unsigned long long)pk2(v[j].x, v[j].y) | ((unsigned long long)pk2(v[j].z, v[j].w) << 32); } }
}

__device__ __forceinline__ void flogit_phase(const Args& args, int vcu, int G, int tid) {
    const int lane = tid & 63, wave = __builtin_amdgcn_readfirstlane(tid >> 6), fr = lane & 15, fq = lane >> 4;
    unsigned char* ws = args.ws; const bf16* xb = (const bf16*)(ws + WS_XB); const bf16* wf = (const bf16*)(ws + WS_WF); const float* ss = (const float*)(ws + WS_SS) + 1 * M; float* logf_ = (float*)(ws + WS_LOGF);
    const int gw = vcu * NWAVES + wave, NGW = G * NWAVES;
    for (int grp = gw; grp < M / 16; grp += NGW) { const int row0 = grp * 16;
        const bf16* xa = xb + (size_t)(row0 + fr) * D + 8 * fq; const bf16* wb = wf + (size_t)fr * D + 8 * fq; f32x4 acc = (f32x4){0.f, 0.f, 0.f, 0.f};
#pragma unroll 8
        for (int kk = 0; kk < 32; ++kk) { const bf16x8 xf = *(const bf16x8*)(xa + 32 * kk), wv = *(const bf16x8*)(wb + 32 * kk); acc = __builtin_amdgcn_mfma_f32_16x16x32_bf16(wv, xf, acc, 0, 0, 0); }
        const int row = row0 + fr, b = row >> 13, t = row & (T - 1); const float rs = pg8::rstd_row(ss, row);
#pragma unroll
        for (int e = 0; e < 4; ++e) { const int h = 4 * fq + e; const float z = acc[e] * rs + args.in[I_FOXBF][h];
            const float lf = fminf(z, 0.f) - log1pf(expf(-fabsf(z))); logf_[(size_t)(b * NH + h) * T + t] = lf * LOG2E; } }
}

__device__ __forceinline__ void attn_cumsum(const float* lf, LAS float* Gl, LAS float* wsum, int tid) {
    const int lane = tid & 63, wave = tid >> 6; f32x4 v[4];
#pragma unroll
    for (int j = 0; j < 4; ++j) v[j] = *(const f32x4*)(lf + tid * 16 + 4 * j);
    float run = 0.f;
#pragma unroll
    for (int j = 0; j < 4; ++j) { run += v[j].x; v[j].x = run; run += v[j].y; v[j].y = run; run += v[j].z; v[j].z = run; run += v[j].w; v[j].w = run; }
    float incl = run;
#pragma unroll
    for (int o = 1; o < 64; o <<= 1) { const float nb = __shfl_up(incl, o); if (lane >= o) incl += nb; }
    if (lane == 63) wsum[wave] = incl;
    __syncthreads();
    float base = incl - run;
    for (int w = 0; w < wave; ++w) base += wsum[w];
#pragma unroll
    for (int j = 0; j < 4; ++j) *(LAS f32x4*)(Gl + tid * 16 + 4 * j) = v[j] + base;
    __syncthreads();
}

constexpr int N_PHASES = 17;
#ifndef ONLY_KIND
#define ONLY_KIND -1
#endif
#define KON(k) (ONLY_KIND < 0 || ONLY_KIND == (k))
#ifndef DUP_PH
#define DUP_PH -1
#endif
#ifndef DUP_SYNC
#define DUP_SYNC 0
#endif
__global__ void __launch_bounds__(NWAVES * 64, 2) fwd_megakernel(Args args) {
    extern __shared__ __attribute__((aligned(16))) unsigned char lds_raw[];
    LAS unsigned char* lds = (LAS unsigned char*)lds_raw;
    cg::grid_group grid = cg::this_grid();
    if (threadIdx.x < 16) ((LAS unsigned*)(lds + MISC_OFF))[threadIdx.x] = 0u;
    __syncthreads();
    XcdBarrier xbar = xcd_barrier_post((unsigned*)(args.ws + WS_BAR), (volatile LAS unsigned*)(lds + MISC_OFF));
    unsigned char* ws = args.ws;
    float* ssb = (float*)(ws + WS_SS); bf16* XB = (bf16*)(ws + WS_XB);
    bf16* HB = (bf16*)(ws + WS_BIG); bf16* QB_ = (bf16*)(ws + WS_BIG); bf16* KB = (bf16*)(ws + WS_BIG + 32 * MiB); bf16* VB = (bf16*)(ws + WS_BIG + 64 * MiB);
    bf16* GATE = (bf16*)(ws + WS_BIG); bf16* REC = (bf16*)(ws + WS_BIG + 40 * MiB);
    for (int pp = args.ph_lo; pp < args.ph_hi; ++pp) {
        int ph = pp; bool dummy = false;
        if (DUP_PH >= 0) { dummy = (pp == DUP_PH); ph = (pp <= DUP_PH) ? pp : pp - 1; }
        const int tid = otid(), G = osgpr((int)gridDim.x), bx = osgpr((int)blockIdx.x);
        const int vcu = (G % 8 == 0) ? (bx % 8) * (G / 8) + bx / 8 : bx;
        int kind = 0, f = 0, ssi = 0; const bf16* A = XB; const bf16* Bt = nullptr; int K = D; const float* xin = args.out; float alpha = 1.f;
        switch (ph) {
            case 0: kind = 0; break;
            case 1: kind = 1; f = 0; ssi = 0; break;
            case 2: kind = 2; A = HB; Bt = (const bf16*)(ws + WS_WD + 0 * WD_BYTES); K = FF; xin = args.in[I_X]; alpha = 0.5f; ssi = 1; break;
            case 3: kind = 3; break;
            case 4: kind = 4; break;
            case 5: kind = 2; A = QB_; Bt = (const bf16*)(ws + WS_WO); K = D; alpha = 1.f; ssi = 2; break;
            case 6: kind = 1; f = 1; ssi = 2; break;
            case 7: kind = 2; A = HB; Bt = (const bf16*)(ws + WS_WD + 1 * WD_BYTES); K = FF; alpha = 0.5f; ssi = 3; break;
            case 8: kind = 1; f = 2; ssi = 3; break;
            case 9: kind = 2; A = HB; Bt = (const bf16*)(ws + WS_WD + 2 * WD_BYTES); K = FF; alpha = 0.5f; ssi = 4; break;
            case 10: kind = 5; break;
            case 11: kind = 6; break;
            case 12: kind = 7; break;
            case 13: kind = 2; A = GATE; Bt = (const bf16*)(ws + WS_WLOUT); K = R; alpha = 1.f; ssi = 5; break;
            case 14: kind = 1; f = 3; ssi = 5; break;
            case 15: kind = 2; A = HB; Bt = (const bf16*)(ws + WS_WD + 3 * WD_BYTES); K = FF; alpha = 0.5f; ssi = 6; break;
            default: kind = 8; break;
        }
        if (dummy) { alpha = 0.f; if (kind == 2) ssi = 7; }
        bf16* const OB = dummy ? (bf16*)(ws + 218 * MiB) : QB_; bf16* const YB = dummy ? (bf16*)(ws + WS_BIG + 80 * MiB) : GATE;
        if (KON(0) && kind == 0) { p0_prologue(lds, args, vcu, G, tid); }
        else if (KON(1) && kind == 1) { pg8::EpiSwiGLU E{HB, ssb + (size_t)ssi * M}; run_gemm(lds, XB, (const bf16*)(ws + WS_WGU + f * WGU_BYTES), NGU, D, E); }
        else if (KON(2) && kind == 2) { pg8::EpiResid E{xin, args.out, XB, ssb + (size_t)ssi * M, alpha}; run_gemm(lds, A, Bt, D, K, E); }
        else if (KON(3) && kind == 3) { pg8::EpiQKV E{QB_, (size_t)M * D, ssb + 1 * M, attn_body::C2, (float*)(ws + WS_NRM)}; run_gemm(lds, XB, (const bf16*)(ws + WS_WQKV), NQKV, D, E); flogit_phase(args, vcu, G, tid); }
        else if (KON(4) && kind == 4) {
            LAS float* Gl = (LAS float*)(lds + 86016); LAS float* wsum = (LAS float*)(lds + 86016 + 32768); LAS unsigned* tsw = (LAS unsigned*)(lds + 86016 + 32768 + 64);
            for (int item = vcu; item < 256; item += G) { const int bh = item >> 3, s = item & 7;
                attn_cumsum((const float*)(ws + WS_LOGF) + (size_t)bh * T, Gl, wsum, tid);
                for (int i = 0; i < 4; ++i) { const int qb = (i == 0) ? s : (i == 1) ? 15 - s : (i == 2) ? 16 + s : 31 - s;
                    const int hd = bh & 15, bb = bh >> 4, NTu = 4 * qb + 4, q0 = 256 * qb; const float* nq = (const float*)(ws + WS_NRM) + ((size_t)hd * 256 + bb * 128) * 2; const float* nk = nq + (size_t)16 * 256 * 2;
                    if (tid == 0) tsw[0] = (unsigned)(NTu - 4);
                    __syncthreads();
                    if (tid < 128 && tid < NTu - 4) { float qn2 = 0.f;
#pragma unroll
                        for (int r4 = 0; r4 < 4; ++r4) qn2 = fmaxf(qn2, nq[(4 * qb + r4) * 2] + nq[(4 * qb + r4) * 2 + 1]);
                        const float kn2 = nk[tid * 2] + nk[tid * 2 + 1]; const float bound = 1.01f * sqrtf(qn2 * kn2) + Gl[q0] - Gl[64 * tid + 63];
                        if (!(bound < -190.f)) atomicMin((unsigned*)tsw, (unsigned)tid); }
                    __syncthreads();
                    const int tstart = __builtin_amdgcn_readfirstlane((int)tsw[0]) & ~1;
                    attn_body::attn_unit<8>(bh >> 4, bh & 15, qb, (const attn_body::bf16*)QB_, (const attn_body::bf16*)KB, (const attn_body::bf16*)VB, (attn_body::bf16*)OB, (char*)lds_raw, (attn_body::lds_fptr)Gl, tstart); }
                __syncthreads(); }
        }
        else if (KON(5) && kind == 5) { pg8::EpiLruIn E{GATE, REC, ssb + 4 * M}; run_gemm(lds, XB, (const bf16*)(ws + WS_WLIN), 2 * R, D, E); }
        else if (KON(6) && kind == 6) { lru_phase<false>(lds, args, vcu, G, tid, YB); }
        else if (KON(7) && kind == 7) { lru_phase<true>(lds, args, vcu, G, tid, YB); }
        else if (KON(8)) { const int lane = tid & 63, wave = tid >> 6, gw = vcu * NWAVES + wave, NGW = G * NWAVES; const float* ss = ssb + 6 * M; const f32x4* gn = (const f32x4*)args.in[I_FINN] + lane;
            for (int m = gw; m < M; m += NGW) { const float rs = pg8::rstd_row(ss, m); f32x4* xr = (f32x4*)(args.out + (size_t)m * D) + lane;
#pragma unroll
                for (int j = 0; j < 4; ++j) { const f32x4 v = xr[64 * j]; xr[64 * j] = v * rs * gn[64 * j]; } } }
        if (pp + 1 < args.ph_hi) { if (pp == args.ph_lo) grid.sync(); else xcd_barrier(xbar); if (DUP_SYNC) xcd_barrier(xbar); }
    }
}

#ifndef MK_PER_PHASE_LAUNCH
#define MK_PER_PHASE_LAUNCH 0
#endif
extern "C" void kernel_launch(void* const* d_in, const int* in_sizes, int n_in, void* d_out, int out_size, void* d_ws, size_t ws_size, hipStream_t stream) {
    static int grid = 0;
    if (grid == 0) {
        if (n_in != 21 || in_sizes[0] != M * D || out_size != M * D || ws_size < WS_END) { fprintf(stderr, "kernel_launch: unexpected shapes (n_in %d, in0 %d, out %d, ws %zu); nothing launched\n", n_in, n_in > 0 ? in_sizes[0] : -1, out_size, ws_size); grid = -1; return; }
        int dev = 0, cus = 0, per_cu = 0;
        if (hipGetDevice(&dev) != hipSuccess || hipDeviceGetAttribute(&cus, hipDeviceAttributeMultiprocessorCount, dev) != hipSuccess) { grid = -1; return; }
        if (hipFuncSetAttribute((const void*)fwd_megakernel, hipFuncAttributeMaxDynamicSharedMemorySize, LDS_BYTES) != hipSuccess) { fprintf(stderr, "kernel_launch: hipFuncSetAttribute failed\n"); grid = -1; return; }
        if (hipOccupancyMaxActiveBlocksPerMultiprocessor(&per_cu, (const void*)fwd_megakernel, NWAVES * 64, LDS_BYTES) != hipSuccess || per_cu < 1) { fprintf(stderr, "kernel_launch: occupancy query says %d blocks per CU\n", per_cu); per_cu = 1; }
        (void)hipGetLastError();
        grid = cus * per_cu;
        if (grid != 256) fprintf(stderr, "kernel_launch: grid %d (this kernel's static unit orders assume 256 workgroups)\n", grid);
    }
    if (grid < 0) return;
    Args a{};
    for (int i = 0; i < 21; ++i) a.in[i] = (const float*)d_in[i];
    a.out = (float*)d_out; a.ws = (unsigned char*)d_ws;
    if (hipMemsetAsync((unsigned char*)d_ws + WS_BAR, 0, BAR_BYTES, stream) != hipSuccess) { fprintf(stderr, "kernel_launch: memset of the barrier words failed\n"); return; }
#if MK_PER_PHASE_LAUNCH
    for (int ph = 0; ph < N_PHASES; ++ph) { a.ph_lo = ph; a.ph_hi = ph + 1; hipLaunchKernelGGL(fwd_megakernel, dim3(grid), dim3(NWAVES * 64), LDS_BYTES, stream, a); }
#else
    a.ph_lo = 0; a.ph_hi = N_PHASES + ((DUP_PH >= 0) ? 1 : 0);
    void* kargs[] = {&a};
    const hipError_t e = hipLaunchCooperativeKernel((const void*)fwd_megakernel, dim3(grid), dim3(NWAVES * 64), kargs, LDS_BYTES, stream);
    if (e != hipSuccess) fprintf(stderr, "kernel_launch: cooperative launch failed: %s (grid %d)\n", hipGetErrorString(e), grid);
#endif
}
```

```cpp
#define DUP_PH -1
#define DUP_SYNC 0
#include <hip/hip_runtime.h>
#include <hip/hip_cooperative_groups.h>
#include <cstdio>
#include <cstdint>
namespace cg = cooperative_groups;
__device__ __forceinline__ int otid() { int t = (int)threadIdx.x; asm volatile("" : "+v"(t)); return t; }
__device__ __forceinline__ int osgpr(int v) { asm volatile("" : "+s"(v)); return v; }
namespace pg8 {
#define PG8_LAS __attribute__((address_space(3)))
typedef unsigned short bf16_t;
typedef short bf16x8 __attribute__((ext_vector_type(8)));
typedef float f32x4 __attribute__((ext_vector_type(4)));
typedef unsigned u32x4 __attribute__((ext_vector_type(4)));
constexpr int BM = 256, BK = 64, HALF = 128, HTB = HALF * BK * 2  , STAGE_BYTES = 8 * HTB, NXCD = 8, WGM = 8;

__host__ __device__ __forceinline__ int lds_byte(int r, int c) { const int st = (r >> 4) * 2 + (c >> 5), rr = r & 15, cc = c & 31, ob = rr * 64 + cc * 2; return st * 1024 + (ob ^ (((ob >> 9) & 1) << 5)); }
__host__ __device__ __forceinline__ void stage_rc(int b, int& R, int& C) { const int st = b / 1024, sb = b % 1024, swz = sb ^ (((sb >> 9) & 1) << 5); R = (st >> 1) * 16 + swz / 64; C = (st & 1) * 32 + (swz % 64) / 2; }
__host__ __device__ __forceinline__ int perm32(int rho) { const int n = rho >> 4, i = rho & 15; return 8 * (i >> 2) + 4 * n + (i & 3); }

struct Unit { int pm, pn; };
struct Gemm { const bf16_t* A; const bf16_t* Bt; int M, N, K; };

struct StaticOrder {
    int nM, nN, nwg, G, c;
    __host__ __device__ void init(int M, int N, int G_, int c_) { nM = M / BM; nN = N / BM; nwg = nM * nN; G = G_; c = c_; }
    __host__ __device__ bool next(int i, Unit& u) const {
        const long L = (long)i * G + c; if (L >= nwg) return false;
        int wgid = (int)L; { const int q = nwg / NXCD, r = nwg % NXCD, xcd = wgid % NXCD, off = wgid / NXCD; wgid = (xcd < r ? xcd * (q + 1) : r * (q + 1) + (xcd - r) * q) + off; }
        const int nig = WGM * nN, gid = wgid / nig, fm = gid * WGM, gsz = (nM - fm) < WGM ? (nM - fm) : WGM;
        u.pm = fm + ((wgid % nig) % gsz); u.pn = (wgid % nig) / gsz; return true;
    }
    __device__ __forceinline__ void a_ready(const Unit&) const {}
    __device__ __forceinline__ void done(const Unit&) const {}
};

__device__ __forceinline__ unsigned cvt_pk_bf16(float lo, float hi) { unsigned r; asm volatile("v_cvt_pk_bf16_f32 %0, %1, %2" : "=v"(r) : "v"(lo), "v"(hi)); return r; }
typedef float f32x2 __attribute__((ext_vector_type(2)));
__device__ __forceinline__ f32x2 gelu_pk(f32x2 v) {
    const f32x2 av = __builtin_elementwise_abs(v), d = av * 0.2316418882f + 1.0f;
    f32x2 t; t.x = __builtin_amdgcn_rcpf(d.x); t.y = __builtin_amdgcn_rcpf(d.y);
    f32x2 q = t * 0.5307027145f + (-0.7265760135f); q = q * t + 0.7107068705f; q = q * t + (-0.142248368f); q = q * t + 0.127414796f; q = q * t;
    const f32x2 s = (v * v) * (-0.72134752044f);
    f32x2 e; e.x = __builtin_amdgcn_exp2f(s.x); e.y = __builtin_amdgcn_exp2f(s.y);
    const f32x2 m = v * (q * e), r = v - m;
    f32x2 o; o.x = v.x < 0.f ? m.x : r.x; o.y = v.y < 0.f ? m.y : r.y; return o;
}

template <int ACT  > struct EpiBf16 {
    static constexpr bool PERM = true, AFTER_DRAIN = false; static_assert(ACT == 0 || ACT == 1, "EpiBf16: ACT is 0 (none) or 1 (gelu_pk)");
    bf16_t* O; int ldc; const float* bias; int split_cols; size_t split_stride; float scale0;
    __device__ __forceinline__ void operator()(const f32x4 (&acc)[2][2][4][2], const Unit& u, int wr, int wc, int fr, int fq) const {
        const int row0 = u.pm * BM + wr * 64 + fr; int colt = u.pn * BM; bf16_t* base = O;
        float sc = 1.f; if (split_cols) { const int t = colt / split_cols; base += (size_t)t * split_stride; colt -= t * split_cols; if (t == 0) sc = scale0; }
        const int col0 = colt + wc * 32 + 8 * fq, bcol0 = u.pn * BM + wc * 32 + 8 * fq;
        f32x4 bv[2][2];
#pragma unroll
        for (int bj = 0; bj < 2; ++bj)
#pragma unroll
            for (int n = 0; n < 2; ++n) bv[bj][n] = bias ? *(const f32x4*)(bias + bcol0 + bj * HALF + 4 * n) : (f32x4){0.f, 0.f, 0.f, 0.f};
#pragma unroll
        for (int ai = 0; ai < 2; ++ai)
#pragma unroll
            for (int m = 0; m < 4; ++m) { bf16_t* rowp = base + (size_t)(row0 + ai * HALF + m * 16) * ldc + col0;
#pragma unroll
                for (int bj = 0; bj < 2; ++bj) { f32x4 v0 = acc[ai][bj][m][0] + bv[bj][0], v1 = acc[ai][bj][m][1] + bv[bj][1];
                    if (ACT == 1) { f32x2 a = gelu_pk((f32x2){v0[0], v0[1]}), b = gelu_pk((f32x2){v0[2], v0[3]}), c = gelu_pk((f32x2){v1[0], v1[1]}), d = gelu_pk((f32x2){v1[2], v1[3]});
                        v0 = (f32x4){a.x, a.y, b.x, b.y}; v1 = (f32x4){c.x, c.y, d.x, d.y}; }
                    v0 = v0 * sc; v1 = v1 * sc; u32x4 w; w.x = cvt_pk_bf16(v0[0], v0[1]); w.y = cvt_pk_bf16(v0[2], v0[3]); w.z = cvt_pk_bf16(v1[0], v1[1]); w.w = cvt_pk_bf16(v1[2], v1[3]);
                    *(u32x4*)(rowp + bj * HALF) = w; } }
    }
};

typedef unsigned u32x2 __attribute__((ext_vector_type(2)));
__device__ __forceinline__ float rstd_row(const float* ss, int row) {
    const float s = __hip_atomic_load(ss + row, __ATOMIC_RELAXED, __HIP_MEMORY_SCOPE_AGENT);
    return 1.0f / sqrtf(s * (1.0f / 1024.0f) + 1e-6f);
}
__device__ __forceinline__ float fast_sigmoid(float v) { return __builtin_amdgcn_rcpf(1.0f + __builtin_amdgcn_exp2f(-1.4426950408889634f * v)); }
struct EpiSwiGLU {
    static constexpr bool PERM = true, AFTER_DRAIN = false;
    bf16_t* H; const float* ss;
    __device__ __forceinline__ void operator()(const f32x4 (&acc)[2][2][4][2], const Unit& u, int wr, int wc, int fr, int fq) const {
        const int hc0 = u.pn * 128 + wc * 32 + 8 * fq;
#pragma unroll
        for (int ai = 0; ai < 2; ++ai)
#pragma unroll
            for (int m = 0; m < 4; ++m) { const int row = u.pm * BM + ai * HALF + wr * 64 + m * 16 + fr; const float rs = rstd_row(ss, row);
                float hv[8];
#pragma unroll
                for (int n = 0; n < 2; ++n)
#pragma unroll
                    for (int e = 0; e < 4; ++e) { const float g = acc[ai][0][m][n][e] * rs, uu = acc[ai][1][m][n][e] * rs; hv[4 * n + e] = g * fast_sigmoid(g) * uu; }
                u32x4 w; w.x = cvt_pk_bf16(hv[0], hv[1]); w.y = cvt_pk_bf16(hv[2], hv[3]); w.z = cvt_pk_bf16(hv[4], hv[5]); w.w = cvt_pk_bf16(hv[6], hv[7]);
                *(u32x4*)(H + (size_t)row * 2816 + hc0) = w; }
    }
};
struct EpiResid {
    static constexpr bool PERM = false, AFTER_DRAIN = false;
    const float* xin; float* xout; bf16_t* xb; float* ss; float alpha;
    __device__ __forceinline__ void operator()(const f32x4 (&acc)[2][2][4][2], const Unit& u, int wr, int wc, int fr, int fq) const {
        const int col0 = u.pn * BM + wc * 32 + 4 * fq;
#pragma unroll
        for (int ai = 0; ai < 2; ++ai)
#pragma unroll
            for (int m = 0; m < 4; ++m) { const int row = u.pm * BM + ai * HALF + wr * 64 + m * 16 + fr; const size_t off = (size_t)row * 1024 + col0; float s = 0.f;
#pragma unroll
                for (int bj = 0; bj < 2; ++bj)
#pragma unroll
                    for (int n = 0; n < 2; ++n) { const f32x4 xi = *(const f32x4*)(xin + off + bj * HALF + n * 16); const f32x4 o = xi + acc[ai][bj][m][n] * alpha;
                        *(f32x4*)(xout + off + bj * HALF + n * 16) = o; s += (o[0] * o[0] + o[1] * o[1]) + (o[2] * o[2] + o[3] * o[3]);
                        u32x2 w; w.x = cvt_pk_bf16(o[0], o[1]); w.y = cvt_pk_bf16(o[2], o[3]); *(u32x2*)(xb + off + bj * HALF + n * 16) = w; }
                s += __shfl_xor(s, 16); s += __shfl_xor(s, 32);
                if (fq == 0) __hip_atomic_fetch_add(ss + row, s, __ATOMIC_RELAXED, __HIP_MEMORY_SCOPE_AGENT); }
    }
};
struct EpiQKV {
    static constexpr bool PERM = true, AFTER_DRAIN = false;
    bf16_t* Q; size_t split_stride; const float* ss; float scale0; float* nrm;
    __device__ __forceinline__ void operator()(const f32x4 (&acc)[2][2][4][2], const Unit& u, int wr, int wc, int fr, int fq) const {
        int colt = u.pn * BM; const int t = colt >> 10; bf16_t* base = Q + (size_t)t * split_stride; colt -= t << 10; const float sc = (t == 0) ? scale0 : 1.f;
        const int col0 = colt + wc * 32 + 8 * fq; float mx[2][2] = {{0.f, 0.f}, {0.f, 0.f}};
#pragma unroll
        for (int ai = 0; ai < 2; ++ai)
#pragma unroll
            for (int m = 0; m < 4; ++m) { const int row = u.pm * BM + ai * HALF + wr * 64 + m * 16 + fr; const float rs = rstd_row(ss, row) * sc; bf16_t* rowp = base + (size_t)row * 1024 + col0;
#pragma unroll
                for (int bj = 0; bj < 2; ++bj) { const f32x4 v0 = acc[ai][bj][m][0] * rs, v1 = acc[ai][bj][m][1] * rs;
                    { float q = (v0[0] * v0[0] + v0[1] * v0[1]) + (v0[2] * v0[2] + v0[3] * v0[3]) + (v1[0] * v1[0] + v1[1] * v1[1]) + (v1[2] * v1[2] + v1[3] * v1[3]);
                      q += __shfl_xor(q, 16); q += __shfl_xor(q, 32); mx[ai][bj] = fmaxf(mx[ai][bj], q); }
                    u32x4 w; w.x = cvt_pk_bf16(v0[0], v0[1]); w.y = cvt_pk_bf16(v0[2], v0[3]); w.z = cvt_pk_bf16(v1[0], v1[1]); w.w = cvt_pk_bf16(v1[2], v1[3]);
                    *(u32x4*)(rowp + bj * HALF) = w; } }
        if (t < 2) {
#pragma unroll
            for (int ai = 0; ai < 2; ++ai)
#pragma unroll
                for (int bj = 0; bj < 2; ++bj) { float q = mx[ai][bj]; q = fmaxf(q, __shfl_xor(q, 1)); q = fmaxf(q, __shfl_xor(q, 2)); q = fmaxf(q, __shfl_xor(q, 4)); q = fmaxf(q, __shfl_xor(q, 8));
                    const int head = (colt + bj * HALF + wc * 32) >> 6, rt = (u.pm * BM + ai * HALF + wr * 64) >> 6;
                    if (fr == 0 && fq == 0) nrm[(((size_t)t * 16 + head) * 256 + rt) * 2 + (wc & 1)] = q; } }
    }
};
__device__ __forceinline__ float gelu_tanh(float v) { const float u2 = 1.5957691216057308f * (v + 0.044715f * v * v * v); return v * fast_sigmoid(u2); }
struct EpiLruIn {
    static constexpr bool PERM = true, AFTER_DRAIN = false;
    bf16_t* GATE; bf16_t* REC; const float* ss;
    __device__ __forceinline__ void operator()(const f32x4 (&acc)[2][2][4][2], const Unit& u, int wr, int wc, int fr, int fq) const {
        const bool isg = u.pn < 5; bf16_t* base = isg ? GATE : REC; const int col0 = (isg ? u.pn : u.pn - 5) * BM + wc * 32 + 8 * fq;
#pragma unroll
        for (int ai = 0; ai < 2; ++ai)
#pragma unroll
            for (int m = 0; m < 4; ++m) { const int row = u.pm * BM + ai * HALF + wr * 64 + m * 16 + fr; const float rs = rstd_row(ss, row); bf16_t* rowp = base + (size_t)row * 1280 + col0;
#pragma unroll
                for (int bj = 0; bj < 2; ++bj) { f32x4 v0 = acc[ai][bj][m][0] * rs, v1 = acc[ai][bj][m][1] * rs;
                    if (isg) {
#pragma unroll
                        for (int e = 0; e < 4; ++e) { v0[e] = gelu_tanh(v0[e]); v1[e] = gelu_tanh(v1[e]); } }
                    u32x4 w; w.x = cvt_pk_bf16(v0[0], v0[1]); w.y = cvt_pk_bf16(v0[2], v0[3]); w.z = cvt_pk_bf16(v1[0], v1[1]); w.w = cvt_pk_bf16(v1[2], v1[3]);
                    *(u32x4*)(rowp + bj * HALF) = w; } }
    }
};
template <class Epi, class Sched, bool ALIGN_EPI = false, bool SP2 = false>
__device__ __forceinline__ void gemm_phase(PG8_LAS unsigned char* lds, const Gemm g, const Sched& S, const Epi& E) {
    const int tid = otid(), wid = __builtin_amdgcn_readfirstlane(tid >> 6), lane = tid & 63, wr = wid >> 2, wc = wid & 3, fr = lane & 15, fq = lane >> 4;
    const int K = g.K, nt = K / BK;
    unsigned voffA[2], voffB[2];
#pragma unroll
    for (int i = 0; i < 2; ++i) { int R, C; stage_rc(tid * 16 + i * 8192, R, C); const int Rb = Epi::PERM ? ((R & ~31) + perm32(R & 31)) : R;
        voffA[i] = (unsigned)(R * K + C) * 2u; voffB[i] = (unsigned)(Rb * K + C) * 2u; }
    const size_t kstep = (size_t)(BK * 2);
    const size_t hstep = (size_t)HALF * K * 2;
    const size_t tstep = 2 * hstep;
    const unsigned ldsw = (unsigned)wid * 1024u;
    const int aoff = lds_byte(wr * 64 + fr, fq * 8), boff = lds_byte(wc * 32 + fr, fq * 8);
#define PG8_SA(b, h) (((b) * 2 + (h)) * HTB)
#define PG8_SB(b, h) ((4 + (b) * 2 + (h)) * HTB)
#define PG8_STAGE(bufoff, gbase, voff) do { _Pragma("unroll") for (int _i = 0; _i < 2; ++_i) \
        __builtin_amdgcn_global_load_lds((const unsigned*)((const char*)(gbase) + (voff)[_i]), (PG8_LAS unsigned*)(lds + (bufoff) + ldsw + _i * 8192), 16, 0, 0); } while (0)
#define PG8_LDA(dst, b, h) do { _Pragma("unroll") for (int m = 0; m < 4; ++m) _Pragma("unroll") for (int k = 0; k < 2; ++k) dst[m][k] = *(const PG8_LAS bf16x8*)(lds + PG8_SA(b, h) + aoff + m * 2048 + k * 1024); } while (0)
#define PG8_LDB(dst, b, h) do { _Pragma("unroll") for (int n = 0; n < 2; ++n) _Pragma("unroll") for (int k = 0; k < 2; ++k) dst[n][k] = *(const PG8_LAS bf16x8*)(lds + PG8_SB(b, h) + boff + n * 2048 + k * 1024); } while (0)
#define PG8_MMA(ai, bj, At, Bt) do { __builtin_amdgcn_s_setprio(1); _Pragma("unroll") for (int m = 0; m < 4; ++m) _Pragma("unroll") for (int n = 0; n < 2; ++n) _Pragma("unroll") for (int k = 0; k < 2; ++k) \
        acc[ai][bj][m][n] = __builtin_amdgcn_mfma_f32_16x16x32_bf16(Bt[n][k], At[m][k], acc[ai][bj][m][n], 0, 0, 0); __builtin_amdgcn_s_setprio(0); } while (0)
#define PG8_WAIT_V(n) asm volatile("s_waitcnt vmcnt(" #n ")" ::: "memory")
#define PG8_WAIT_L(n) asm volatile("s_waitcnt lgkmcnt(" #n ")" ::: "memory")
#define PG8_BAR __builtin_amdgcn_s_barrier()
#define PG8_SCHED __builtin_amdgcn_sched_barrier(0)
    Unit cur, nxt; int ui = 0;
    if (!S.next(0, cur)) return;
    f32x4 acc[2][2][4][2];
#pragma unroll
    for (int a = 0; a < 2; ++a)
#pragma unroll
        for (int b = 0; b < 2; ++b)
#pragma unroll
            for (int m = 0; m < 4; ++m)
#pragma unroll
                for (int n = 0; n < 2; ++n) acc[a][b][m][n] = (f32x4){0.f, 0.f, 0.f, 0.f};
    bf16x8 At[4][2], B0[2][2], B1[2][2];
    const char* cA = (const char*)g.A + (size_t)cur.pm * tstep; const char* cB = (const char*)g.Bt + (size_t)cur.pn * tstep;
    S.a_ready(cur);
    if constexpr (SP2) {
        PG8_STAGE(PG8_SB(0, 0), cB, voffB); PG8_STAGE(PG8_SB(0, 1), cB + hstep, voffB); PG8_STAGE(PG8_SA(0, 0), cA, voffA); PG8_STAGE(PG8_SA(0, 1), cA + hstep, voffA);
        if (wr == 1) PG8_BAR;
        PG8_WAIT_V(2); PG8_BAR;
        PG8_STAGE(PG8_SB(1, 0), cB + kstep, voffB); PG8_STAGE(PG8_SA(1, 0), cA + kstep, voffA); PG8_STAGE(PG8_SB(1, 1), cB + hstep + kstep, voffB);
        PG8_WAIT_V(6); PG8_BAR;
    } else {
        PG8_STAGE(PG8_SB(0, 0), cB, voffB); PG8_STAGE(PG8_SA(0, 0), cA, voffA); PG8_STAGE(PG8_SB(0, 1), cB + hstep, voffB); PG8_STAGE(PG8_SA(0, 1), cA + hstep, voffA);
        if (wr == 1) PG8_BAR;
        PG8_WAIT_V(4); PG8_BAR;
        PG8_STAGE(PG8_SB(1, 0), cB + kstep, voffB); PG8_STAGE(PG8_SA(1, 0), cA + kstep, voffA); PG8_STAGE(PG8_SB(1, 1), cB + hstep + kstep, voffB);
        PG8_WAIT_V(6); PG8_BAR;
    }
    for (;;) {
        const bool has_next = S.next(ui + 1, nxt);
        const char* nA = has_next ? (const char*)g.A + (size_t)nxt.pm * tstep : cA; const char* nB = has_next ? (const char*)g.Bt + (size_t)nxt.pn * tstep : cB;
        for (int t = 0; t < nt; t += 2) {
            const bool last = (t == nt - 2);
            const char* a1 = cA + (size_t)(t + 1) * kstep;
            const char* a2 = last ? nA : cA + (size_t)(t + 2) * kstep; const char* b2 = last ? nB : cB + (size_t)(t + 2) * kstep;
            const char* a3 = a2 + kstep; const char* b3 = b2 + kstep;
            if (last && has_next) S.a_ready(nxt);
            if constexpr (SP2) {
            PG8_LDB(B0, 0, 0); PG8_LDB(B1, 0, 1); PG8_SCHED; PG8_LDA(At, 0, 0); PG8_STAGE(PG8_SA(1, 1), a1 + hstep, voffA);
            PG8_WAIT_V(8); PG8_WAIT_L(0); PG8_BAR; PG8_MMA(0, 0, At, B0); PG8_MMA(0, 1, At, B1); PG8_BAR; PG8_SCHED;
            PG8_LDA(At, 0, 1); PG8_STAGE(PG8_SB(0, 0), b2, voffB); PG8_STAGE(PG8_SB(0, 1), b2 + hstep, voffB); PG8_STAGE(PG8_SA(0, 0), a2, voffA);
            PG8_WAIT_V(8); PG8_WAIT_L(0); PG8_BAR; PG8_MMA(1, 0, At, B0); PG8_MMA(1, 1, At, B1); PG8_BAR; PG8_SCHED;
            PG8_LDB(B0, 1, 0); PG8_LDB(B1, 1, 1); PG8_SCHED; PG8_LDA(At, 1, 0); PG8_STAGE(PG8_SA(0, 1), a2 + hstep, voffA);
            PG8_WAIT_V(8); PG8_WAIT_L(0); PG8_BAR; PG8_MMA(0, 0, At, B0); PG8_MMA(0, 1, At, B1); PG8_BAR; PG8_SCHED;
            PG8_LDA(At, 1, 1); PG8_STAGE(PG8_SB(1, 0), b3, voffB); PG8_STAGE(PG8_SB(1, 1), b3 + hstep, voffB); PG8_STAGE(PG8_SA(1, 0), a3, voffA);
            PG8_WAIT_V(8); PG8_WAIT_L(0); PG8_BAR; PG8_MMA(1, 0, At, B0); PG8_MMA(1, 1, At, B1); PG8_BAR; PG8_SCHED;
            } else {
            PG8_LDB(B0, 0, 0); PG8_SCHED; PG8_LDA(At, 0, 0); PG8_STAGE(PG8_SA(1, 1), a1 + hstep, voffA);
            PG8_WAIT_L(8); PG8_BAR; PG8_WAIT_L(0); PG8_MMA(0, 0, At, B0); PG8_BAR; PG8_SCHED;
            PG8_LDB(B1, 0, 1); PG8_STAGE(PG8_SB(0, 0), b2, voffB);
            PG8_BAR; PG8_WAIT_L(0); PG8_MMA(0, 1, At, B1); PG8_BAR;
            PG8_LDA(At, 0, 1); PG8_STAGE(PG8_SA(0, 0), a2, voffA);
            PG8_BAR; PG8_WAIT_L(0); PG8_MMA(1, 0, At, B0); PG8_BAR; PG8_SCHED;
            PG8_STAGE(PG8_SB(0, 1), b2 + hstep, voffB);
            PG8_WAIT_V(6); PG8_BAR; PG8_MMA(1, 1, At, B1); PG8_BAR;
            PG8_LDB(B0, 1, 0); PG8_SCHED; PG8_LDA(At, 1, 0); PG8_STAGE(PG8_SA(0, 1), a2 + hstep, voffA);
            PG8_WAIT_L(8); PG8_BAR; PG8_WAIT_L(0); PG8_MMA(0, 0, At, B0); PG8_BAR; PG8_SCHED;
            PG8_LDB(B1, 1, 1); PG8_STAGE(PG8_SB(1, 0), b3, voffB);
            PG8_BAR; PG8_WAIT_L(0); PG8_MMA(0, 1, At, B1); PG8_BAR;
            PG8_LDA(At, 1, 1); PG8_STAGE(PG8_SA(1, 0), a3, voffA);
            PG8_BAR; PG8_WAIT_L(0); PG8_MMA(1, 0, At, B0); PG8_BAR; PG8_SCHED;
            PG8_STAGE(PG8_SB(1, 1), b3 + hstep, voffB);
            PG8_WAIT_V(6); PG8_BAR; PG8_MMA(1, 1, At, B1); PG8_BAR;
            }
        }
        if constexpr (ALIGN_EPI) { if (wr == 0) PG8_BAR; }
        if constexpr (!Epi::AFTER_DRAIN) { E(acc, cur, wr, wc, fr, fq); S.done(cur); }
        if (!has_next) break;
#pragma unroll
        for (int a = 0; a < 2; ++a)
#pragma unroll
            for (int b = 0; b < 2; ++b)
#pragma unroll
                for (int m = 0; m < 4; ++m)
#pragma unroll
                    for (int n = 0; n < 2; ++n) acc[a][b][m][n] = (f32x4){0.f, 0.f, 0.f, 0.f};
        cur = nxt; cA = nA; cB = nB; ++ui;
        if constexpr (ALIGN_EPI) { if (wr == 1) PG8_BAR; }
    }
    PG8_WAIT_V(0);
    if constexpr (!ALIGN_EPI) { if (wr == 0) PG8_BAR; }
    PG8_BAR;
    if constexpr (Epi::AFTER_DRAIN) { E.fused(acc, cur, wr, wc, fr, fq, lds, wid, lane); S.done(cur); }
#undef PG8_SA
#undef PG8_SB
#undef PG8_STAGE
#undef PG8_LDA
#undef PG8_LDB
#undef PG8_MMA
#undef PG8_WAIT_V
#undef PG8_WAIT_L
#undef PG8_BAR
#undef PG8_SCHED
}
}

#ifndef PG8_SP2
#define PG8_SP2 true
#endif
#ifndef PG8_ALIGN
#define PG8_ALIGN true
#endif
#include <hip/hip_bf16.h>
#include <cmath>
namespace attn_body {
using bf16=__hip_bfloat16;
using bf16x8=__attribute__((ext_vector_type(8)))short;
using s16x4=__attribute__((ext_vector_type(4)))short;
using f32x16=__attribute__((ext_vector_type(16)))float;
using u32x4=__attribute__((ext_vector_type(4)))unsigned;
constexpr int BATCH=2,NHEAD=16,SEQ=8192,D=64,DM=NHEAD*D;
constexpr int NW=8,QBLK=32,QB=QBLK*NW,KVBLK=64,NQB=SEQ/QB;
constexpr int ATTN_PITCH=DM, ATTN_UNIT_ROWS=QB;
__device__ __forceinline__ int crow(int r,int hi){return (r&3)+8*(r>>2)+4*hi;}
#define SBAR() __builtin_amdgcn_sched_barrier(0)
__device__ __forceinline__ void cmask(f32x16&p0,f32x16&p1,int jb,int qrel,int hi){
  const float NEG=-INFINITY; int kb=64*jb+4*hi;
  #pragma unroll
  for(int r=0;r<16;++r){int kv=kb+(r&3)+8*(r>>2); if(kv>qrel)p0[r]=NEG; if(kv+32>qrel)p1[r]=NEG;}
}

constexpr int NSLOT=3, SLOTB=8192;
constexpr int LDS_K=0, LDS_V=NSLOT*SLOTB, LDS_WS=2*NSLOT*SLOTB, LDS_OST=LDS_WS+NW*64*4, LDS_BYTES=LDS_OST+NW*4096;
constexpr float C2=0.125f*1.4426950408889634f;
__device__ __forceinline__ void glds16(const void*gsrc,unsigned lds_dst){unsigned keep;
  asm volatile("s_mov_b32 %0, m0\n\ts_mov_b32 m0, %2\n\ts_nop 0\n\tglobal_load_lds_dwordx4 %1, off\n\ts_mov_b32 m0, %0":"=&s"(keep):"v"(gsrc),"s"(lds_dst):"memory");}
__device__ __forceinline__ float max3f(float a,float b,float c){float r;asm("v_max3_f32 %0, %1, %2, %3":"=v"(r):"v"(a),"v"(b),"v"(c));return r;}
__device__ __forceinline__ float max2f(float a,float b){float r;asm("v_max_f32_e32 %0, %1, %2":"=v"(r):"v"(a),"v"(b));return r;}
__device__ __forceinline__ float fadd_s(float a,float b){float r;asm("v_add_f32_e32 %0, %1, %2":"=v"(r):"v"(a),"v"(b));return r;}
__device__ __forceinline__ float fsub_s(float a,float b){float r;asm("v_sub_f32_e32 %0, %1, %2":"=v"(r):"v"(a),"v"(b));return r;}
typedef float f32x2_t __attribute__((ext_vector_type(2))); typedef __bf16 bf16x2_t __attribute__((ext_vector_type(2)));
__device__ __forceinline__ unsigned cvtpk_s(float lo,float hi){f32x2_t v={lo,hi};bf16x2_t b=__builtin_convertvector(v,bf16x2_t);return __builtin_bit_cast(unsigned,b);}
#define WAIT_BAR(N) asm volatile("s_waitcnt vmcnt(" #N ") lgkmcnt(0)\n\ts_barrier":::"memory")

typedef __attribute__((address_space(3))) const float* lds_fptr; typedef float f32x4_t __attribute__((ext_vector_type(4))); typedef __attribute__((address_space(3))) const f32x4_t* lds_f4ptr;
__device__ __forceinline__ void qkt(f32x16&p0,f32x16&p1,const char*Kslot,const bf16x8*qr,int r32,int hi){
  const char*kb=Kslot+hi*1024+r32*16;
  #pragma unroll
  for(int d0=0;d0<4;++d0){
    const bf16x8 b0=*reinterpret_cast<const bf16x8*>(kb+d0*2048);
    const bf16x8 b1=*reinterpret_cast<const bf16x8*>(kb+d0*2048+512);
    p0=__builtin_amdgcn_mfma_f32_32x32x16_bf16(b0,qr[d0],p0,0,0,0);p1=__builtin_amdgcn_mfma_f32_32x32x16_bf16(b1,qr[d0],p1,0,0,0);}
}
typedef __attribute__((address_space(3))) const char* lds_cptr;
typedef short v4i16_t __attribute__((ext_vector_type(4)));
__device__ __forceinline__ void kload8(bf16x8*kf,lds_cptr kp){
  kf[0]=*(const __attribute__((address_space(3))) bf16x8*)(kp);      kf[1]=*(const __attribute__((address_space(3))) bf16x8*)(kp+512);
  kf[2]=*(const __attribute__((address_space(3))) bf16x8*)(kp+2048); kf[3]=*(const __attribute__((address_space(3))) bf16x8*)(kp+2560);
  kf[4]=*(const __attribute__((address_space(3))) bf16x8*)(kp+4096); kf[5]=*(const __attribute__((address_space(3))) bf16x8*)(kp+4608);
  kf[6]=*(const __attribute__((address_space(3))) bf16x8*)(kp+6144); kf[7]=*(const __attribute__((address_space(3))) bf16x8*)(kp+6656);
}
__device__ __forceinline__ void kload2(bf16x8*kf,lds_cptr kp,int j){ kf[2*j]=*(const __attribute__((address_space(3))) bf16x8*)(kp+j*2048); kf[2*j+1]=*(const __attribute__((address_space(3))) bf16x8*)(kp+j*2048+512); }
__device__ __forceinline__ s16x4 vtr(lds_cptr p){ return __builtin_bit_cast(s16x4,__builtin_amdgcn_ds_read_tr16_b64_v4i16((__attribute__((address_space(3))) v4i16_t*)p)); }
__device__ __forceinline__ float rowmax(const f32x16&p0,const f32x16&p1){
  float a=max3f(p0[0],p0[1],p1[0]),b=max3f(p0[2],p0[3],p1[1]);a=max3f(a,p1[2],p1[3]);
  #pragma unroll
  for(int r=4;r<16;r+=4){a=max3f(a,p0[r],p0[r+1]);b=max3f(b,p0[r+2],p0[r+3]);a=max3f(a,p1[r],p1[r+1]);b=max3f(b,p1[r+2],p1[r+3]);}
  const float m=max2f(a,b);
  auto rr=__builtin_amdgcn_permlane32_swap(__float_as_uint(m),__float_as_uint(m),false,false);
  return max2f(__uint_as_float(rr[0]),__uint_as_float(rr[1]));
}
__device__ __forceinline__ void pv(f32x16*o,int vb,bf16x8 pa0,bf16x8 pa1,bf16x8 pa2,bf16x8 pa3){
  #pragma unroll
  for(int d0=0;d0<2;++d0){s16x4 lo[4],hi[4];
    #pragma unroll
    for(int ks=0;ks<4;++ks){
      asm volatile("ds_read_b64_tr_b16 %0,%1 offset:%c2":"=&v"(lo[ks]):"v"(vb),"i"(d0*4096+ks*1024):"memory");
      asm volatile("ds_read_b64_tr_b16 %0,%1 offset:%c2":"=&v"(hi[ks]):"v"(vb),"i"(d0*4096+ks*1024+512):"memory");}
    asm volatile("s_waitcnt lgkmcnt(0)":::"memory");SBAR();
    #define PK(k) (bf16x8){lo[k][0],lo[k][1],lo[k][2],lo[k][3],hi[k][0],hi[k][1],hi[k][2],hi[k][3]}
    o[d0]=__builtin_amdgcn_mfma_f32_32x32x16_bf16(pa0,PK(0),o[d0],0,0,0);
    o[d0]=__builtin_amdgcn_mfma_f32_32x32x16_bf16(pa1,PK(1),o[d0],0,0,0);
    o[d0]=__builtin_amdgcn_mfma_f32_32x32x16_bf16(pa2,PK(2),o[d0],0,0,0);
    o[d0]=__builtin_amdgcn_mfma_f32_32x32x16_bf16(pa3,PK(3),o[d0],0,0,0);
    #undef PK
  }
}

#ifndef ATTN_STORE16
#define ATTN_STORE16(p,v) (*(u32x4*)(p)=(v))
#endif
template<int THRL> __device__ __forceinline__ void attn_unit(int b,int h,int qb,const bf16*Q,const bf16*__restrict__ K,const bf16*__restrict__ V,bf16*O,char*shm,lds_fptr Gp,int tstart){
  const int tid=otid(),lane=tid&63,r32=lane&31,hi=lane>>5; const int wid=__builtin_amdgcn_readfirstlane(tid>>6);
  const long rowbase=(long)b*SEQ; const int q0=qb*QB;
  const bf16*Qw=Q+(rowbase+q0+wid*QBLK)*DM+h*D;
  const bf16*Kh=K+(rowbase+(long)tstart*KVBLK)*DM+h*D,*Vh=V+(rowbase+(long)tstart*KVBLK)*DM+h*D; const lds_fptr Gk=Gp+KVBLK*tstart;
  const unsigned lds0=(unsigned)(uintptr_t)shm;
  float*wsf=(float*)(shm+LDS_WS)+wid*64;
  const bf16*ksrc=Kh+(long)lane*DM+wid*8;
  const bf16*vsrc=Vh+(long)(16*(wid&3)+(lane>>2))*DM+(wid>>2)*32+(lane&3)*8;
  const unsigned kdst=lds0+LDS_K+wid*1024, vdst=lds0+LDS_V+wid*1024;
  #define DMA_K(t,slot) glds16(ksrc+(long)(t)*KVBLK*DM,(unsigned)__builtin_amdgcn_readfirstlane(kdst+(slot)))
  #define DMA_V(t,slot) glds16(vsrc+(long)(t)*KVBLK*DM,(unsigned)__builtin_amdgcn_readfirstlane(vdst+(slot)))
  const int vb0=(int)(lds0+LDS_V)+((lane>>4)&1)*32+(lane&3)*8+(4*hi+((lane&15)>>2))*64;
  const char*Kbase=shm+LDS_K; bf16x8 kf[8];
  const lds_cptr shm3=(lds_cptr)shm; const lds_cptr kp0=shm3+LDS_K+hi*1024+r32*16; const lds_cptr vp0=shm3+LDS_V+((lane>>4)&1)*32+(lane&3)*8+(4*hi+((lane&15)>>2))*64;
  const int NT=(q0+QB)/KVBLK-tstart;
  DMA_K(0,0);DMA_V(0,0);DMA_K(1,SLOTB);
  bf16x8 qr[4];
  #pragma unroll
  for(int d0=0;d0<4;++d0)qr[d0]=*reinterpret_cast<const bf16x8*>(&Qw[(long)r32*DM+d0*16+hi*8]);
  float mhat=0.f,l_reg=0.f;f32x16 o[2];o[0]=f32x16{};o[1]=f32x16{};
  const float Gq=Gp[q0+wid*QBLK+r32]; float negmq=Gq;
  #define BIAS_LD(X0,X1,t) do{ const lds_f4ptr gp_=(lds_f4ptr)(Gk+64*(t)+4*hi); _Pragma("unroll") for(int j_=0;j_<4;++j_){ const f32x4_t a_=gp_[2*j_], b_=gp_[8+2*j_]; \
      X0[4*j_]=a_[0];X0[4*j_+1]=a_[1];X0[4*j_+2]=a_[2];X0[4*j_+3]=a_[3]; X1[4*j_]=b_[0];X1[4*j_+1]=b_[1];X1[4*j_+2]=b_[2];X1[4*j_+3]=b_[3]; } }while(0)
  #define BSUB4(X,B) do{ X[B]=negmq-X[B]; X[(B)+1]=negmq-X[(B)+1]; X[(B)+2]=negmq-X[(B)+2]; X[(B)+3]=negmq-X[(B)+3]; }while(0)
  #define BSUBALL(X0,X1) do{ _Pragma("unroll") for(int r_=0;r_<16;++r_){ X0[r_]=negmq-X0[r_]; X1[r_]=negmq-X1[r_]; } }while(0)
  const int qrel=wid*QBLK+r32;
  #define CMASK(P0,P1,t) do{int jb_=(t)-(NT-4); if(jb_>=0)cmask(P0,P1,jb_,qrel,hi);}while(0)
  bool resc=false;
  #define START(P0,P1) do{ const float rm=rowmax(P0,P1); resc=false; \
    { const float dl=__builtin_fmaxf(rm,-40.f); mhat=fadd_s(mhat,dl); \
      _Pragma("unroll") for(int r=0;r<16;++r){P0[r]=fsub_s(P0[r],dl);P1[r]=fsub_s(P1[r],dl);} \
      negmq=Gq-mhat; } \
    _Pragma("unroll") for(int r=0;r<16;++r)P0[r]=__builtin_amdgcn_exp2f(P0[r]); }while(0)
  #define RESC() do{ if(resc){ asm volatile("s_waitcnt lgkmcnt(0)":::"memory"); \
      _Pragma("unroll") for(int d_=0;d_<2;++d_) _Pragma("unroll") for(int r=0;r<16;++r)o[d_][r]*=wsf[crow(r,hi)]; } }while(0)
  f32x16 pA0,pA1,pB0,pB1;
  int sl_prev=0,sl_cur=0,sl_next=SLOTB;
  #define ROT() do{sl_prev=sl_cur;sl_cur=sl_next;sl_next=(sl_next==(NSLOT-1)*SLOTB)?0:sl_next+SLOTB;}while(0)
  DMA_K(2,2*SLOTB);
  WAIT_BAR(3);
  BIAS_LD(pA0,pA1,0); BSUBALL(pA0,pA1);
  qkt(pA0,pA1,Kbase,qr,r32,hi);asm volatile("s_nop 15\n\ts_nop 7":"+v"(pA0),"+v"(pA1));CMASK(pA0,pA1,0);
  START(pA0,pA1);
  _Pragma("unroll") for(int r=0;r<16;++r)pA1[r]=__builtin_amdgcn_exp2f(pA1[r]);
  BIAS_LD(pB0,pB1,1); BSUBALL(pB0,pB1);
  WAIT_BAR(0);
  DMA_K(3,0);DMA_V(1,SLOTB);
  ROT();
  kload8(kf,kp0+sl_cur);
  WAIT_BAR(2);
  s16x4 vlo[8],vhi[8]; u32x4 pw0,pw1,pw2,pw3;
  #define PKW(P,B) cvtpk_s(P[B],P[B+1])
  #define PAF(k) __builtin_bit_cast(bf16x8,pw##k)
  #define VFR(i) (bf16x8){vlo[i][0],vlo[i][1],vlo[i][2],vlo[i][3],vhi[i][0],vhi[i][1],vhi[i][2],vhi[i][3]}
  #define PIN(x) asm volatile("":"+v"(x))
  #define MX3(a,b,c) __builtin_fmaxf(__builtin_fmaxf((a),(b)),(c))
  #define GAPA(MF,A0,A1,A2,A3,W0,W1,PW) do{ MF; sacc+=A0; sacc+=A1; sacc+=A2; sacc+=A3; PIN(sacc); W0; W1; PIN(PW); SBAR(); }while(0)
  #define EX(v) __builtin_amdgcn_exp2f(v)
  #define GAPB(MF,X,B,GL_,Y,YB) do{ MF; X[B]=EX(X[B]); X[B+1]=EX(X[B+1]); X[B+2]=EX(X[B+2]); X[B+3]=EX(X[B+3]); PIN(X); if(GL_){ BSUB4(Y,YB); PIN(Y); } SBAR(); }while(0)
  #define VRD(i) do{ vlo[i]=vtr(vp_+(((i)>>2)*4096+((i)&3)*1024)); vhi[i]=vtr(vp_+(((i)>>2)*4096+((i)&3)*1024+512)); }while(0)
  #define KRD(G,j) do{ if(G){ kload2(kf,kp0+sl_next,j); SBAR(); } }while(0)
  #define STEP(C0,C1,P0,P1,t,GK,GV,GL) do{ SBAR(); \
    const lds_cptr vp_=vp0+sl_prev; \
    VRD(0); SBAR(); float sacc=(P0[0]+P0[1]); \
    GAPA(C0=__builtin_amdgcn_mfma_f32_32x32x16_bf16(kf[0],qr[0],C0,0,0,0), P0[2],P0[3],P0[4],P0[5],     pw0[0]=PKW(P0,0), pw0[1]=PKW(P0,2), pw0); \
    VRD(4); SBAR(); GAPA(C1=__builtin_amdgcn_mfma_f32_32x32x16_bf16(kf[1],qr[0],C1,0,0,0), P0[6],P0[7],P0[8],P0[9],     pw0[2]=PKW(P0,4), pw0[3]=PKW(P0,6), pw0); \
    VRD(1); SBAR(); GAPA(C0=__builtin_amdgcn_mfma_f32_32x32x16_bf16(kf[2],qr[1],C0,0,0,0),   P0[10],P0[11],P0[12],P0[13], pw1[0]=PKW(P0,8), pw1[1]=PKW(P0,10), pw1); \
    VRD(5); SBAR(); GAPA(C1=__builtin_amdgcn_mfma_f32_32x32x16_bf16(kf[3],qr[1],C1,0,0,0),   P0[14],P0[15],P1[0],P1[1],   pw1[2]=PKW(P0,12),pw1[3]=PKW(P0,14), pw1); \
    VRD(2); SBAR(); GAPA(C0=__builtin_amdgcn_mfma_f32_32x32x16_bf16(kf[4],qr[2],C0,0,0,0),   P1[2],P1[3],P1[4],P1[5],     pw2[0]=PKW(P1,0), pw2[1]=PKW(P1,2), pw2); \
    VRD(6); SBAR(); GAPA(C1=__builtin_amdgcn_mfma_f32_32x32x16_bf16(kf[5],qr[2],C1,0,0,0),   P1[6],P1[7],P1[8],P1[9],     pw2[2]=PKW(P1,4), pw2[3]=PKW(P1,6), pw2); \
    VRD(3); SBAR(); GAPA(C0=__builtin_amdgcn_mfma_f32_32x32x16_bf16(kf[6],qr[3],C0,0,0,0),   P1[10],P1[11],P1[12],P1[13], pw3[0]=PKW(P1,8), pw3[1]=PKW(P1,10), pw3); \
    VRD(7); SBAR(); GAPA(C1=__builtin_amdgcn_mfma_f32_32x32x16_bf16(kf[7],qr[3],C1,0,0,0),   P1[14],P1[15],0.f,0.f,       pw3[2]=PKW(P1,12),pw3[3]=PKW(P1,14), pw3); \
    l_reg+=sacc; \
    if(GK){DMA_K((t)+3,sl_cur);} if(GV){DMA_V((t)+1,sl_next);} \
    CMASK(C0,C1,t); \
    { float a=MX3(C0[0],C0[1],C1[0]),b=MX3(C0[2],C0[3],C1[1]); a=MX3(a,C1[2],C1[3]); \
      _Pragma("unroll") for(int r=4;r<16;r+=4){a=MX3(a,C0[r],C0[r+1]);b=MX3(b,C0[r+2],C0[r+3]);a=MX3(a,C1[r],C1[r+1]);b=MX3(b,C1[r+2],C1[r+3]);} \
      float rm=__builtin_fmaxf(a,b); { auto rr=__builtin_amdgcn_permlane32_swap(__float_as_uint(rm),__float_as_uint(rm),false,false); rm=__builtin_fmaxf(__uint_as_float(rr[0]),__uint_as_float(rr[1])); } \
      resc=false; \
      if(__builtin_expect(__any(rm>(float)THRL),0)){ const float dl=__builtin_fmaxf(rm,0.f); mhat+=dl; \
        _Pragma("unroll") for(int r=0;r<16;++r){C0[r]-=dl;C1[r]-=dl;} \
        negmq=Gq-mhat; \
        const float f=__builtin_amdgcn_exp2f(-dl); l_reg*=f; if(hi==0)wsf[r32]=f; resc=true; } } \
    if(GL){ BIAS_LD(P0,P1,(t)+1); } \
    SBAR(); \
    GAPB(o[0]=__builtin_amdgcn_mfma_f32_32x32x16_bf16(PAF(0),VFR(0),o[0],0,0,0), C0,0, GL,P0,0); \
    GAPB(o[1]=__builtin_amdgcn_mfma_f32_32x32x16_bf16(PAF(0),VFR(4),o[1],0,0,0), C0,4, GL,P0,4); \
    KRD(GL,0); GAPB(o[0]=__builtin_amdgcn_mfma_f32_32x32x16_bf16(PAF(1),VFR(1),o[0],0,0,0), C0,8, GL,P0,8); \
    KRD(GL,1); GAPB(o[1]=__builtin_amdgcn_mfma_f32_32x32x16_bf16(PAF(1),VFR(5),o[1],0,0,0), C0,12, GL,P0,12); \
    KRD(GL,2); GAPB(o[0]=__builtin_amdgcn_mfma_f32_32x32x16_bf16(PAF(2),VFR(2),o[0],0,0,0), C1,0, GL,P1,0); \
    KRD(GL,3); GAPB(o[1]=__builtin_amdgcn_mfma_f32_32x32x16_bf16(PAF(2),VFR(6),o[1],0,0,0), C1,4, GL,P1,4); \
    GAPB(o[0]=__builtin_amdgcn_mfma_f32_32x32x16_bf16(PAF(3),VFR(3),o[0],0,0,0), C1,8, GL,P1,8); \
    GAPB(o[1]=__builtin_amdgcn_mfma_f32_32x32x16_bf16(PAF(3),VFR(7),o[1],0,0,0), C1,12, GL,P1,12); \
    }while(0)
  int t=1;
  #undef CMASK
  #define CMASK(P0,P1,t) do{}while(0)
  for(;t+5<NT;t+=2){
    STEP(pB0,pB1,pA0,pA1,t,true,true,true);     WAIT_BAR(2); RESC(); ROT();
    STEP(pA0,pA1,pB0,pB1,t+1,true,true,true);   WAIT_BAR(2); RESC(); ROT();
  }
  #undef CMASK
  #define CMASK(P0,P1,t) do{int jb_=(t)-(NT-4); if(jb_>=0)cmask(P0,P1,jb_,qrel,hi);}while(0)
  #define ENDW(tt) do{ if((tt)+3<NT){WAIT_BAR(2);} else if((tt)+2<NT){WAIT_BAR(1);} else {WAIT_BAR(0);} }while(0)
  for(;t+1<NT;t+=2){
    STEP(pB0,pB1,pA0,pA1,t,(t+3<NT),(t+1<NT),(t+1<NT));       ENDW(t);   RESC(); ROT();
    STEP(pA0,pA1,pB0,pB1,t+1,(t+4<NT),(t+2<NT),(t+2<NT));     ENDW(t+1); RESC(); ROT();
  }
  STEP(pB0,pB1,pA0,pA1,NT-1,false,false,false); RESC();
  { float sacc=pB0[0]+pB0[1]; _Pragma("unroll") for(int r=2;r<16;++r)sacc+=pB0[r]; _Pragma("unroll") for(int r=0;r<16;++r)sacc+=pB1[r]; l_reg+=sacc;
    pw0=(u32x4){PKW(pB0,0),PKW(pB0,2),PKW(pB0,4),PKW(pB0,6)};pw1=(u32x4){PKW(pB0,8),PKW(pB0,10),PKW(pB0,12),PKW(pB0,14)};pw2=(u32x4){PKW(pB1,0),PKW(pB1,2),PKW(pB1,4),PKW(pB1,6)};pw3=(u32x4){PKW(pB1,8),PKW(pB1,10),PKW(pB1,12),PKW(pB1,14)};
    SBAR(); pv(o,vb0+sl_cur,PAF(0),PAF(1),PAF(2),PAF(3)); }
  #undef PKW
  #undef PAF
  #undef VFR
  #undef PIN
  #undef MX3
  #undef GAPA
  #undef GAPB
  #undef EX
  #undef VRD
  #undef KRD
  #undef STEP
  #undef ENDW
  {auto rr=__builtin_amdgcn_permlane32_swap(__float_as_uint(l_reg),__float_as_uint(l_reg),false,false);l_reg=__uint_as_float(rr[0])+__uint_as_float(rr[1]);}
  if(hi==0)wsf[32+r32]=l_reg;asm volatile("s_waitcnt lgkmcnt(0)":::"memory");
  float rli[16];
  #pragma unroll
  for(int r=0;r<16;++r)rli[r]=__builtin_amdgcn_rcpf(wsf[32+crow(r,hi)]);
  bf16*Ow=O+(rowbase+q0+wid*QBLK)*DM+h*D;
  { bf16*stg=(bf16*)(shm+LDS_OST)+wid*2048;
    #pragma unroll
    for(int r=0;r<16;++r){const int orow=crow(r,hi);
      #pragma unroll
      for(int d0=0;d0<2;++d0)stg[orow*64+d0*32+r32]=__float2bfloat16(o[d0][r]*rli[r]);}
    asm volatile("s_waitcnt lgkmcnt(0)":::"memory");
    #pragma unroll
    for(int i=0;i<4;++i){const int row=i*8+(lane>>3),ch=lane&7; const u32x4 v=*(const u32x4*)(stg+row*64+ch*8); ATTN_STORE16(Ow+(long)row*DM+ch*8,v);} }
  asm volatile("s_waitcnt lgkmcnt(0)\n\ts_barrier":::"memory");
  #undef DMA_K
  #undef BIAS_LD
  #undef BSUB4
  #undef BSUBALL
  #undef DMA_V
  #undef CMASK
  #undef START
  #undef RESC
  #undef ROT
}
constexpr int ATTN_LDS_BYTES=LDS_BYTES;
#undef SBAR
#undef WAIT_BAR
}
#define GAS __attribute__((address_space(1)))
#define LAS __attribute__((address_space(3)))
typedef unsigned short bf16;
typedef unsigned v4u __attribute__((ext_vector_type(4)));
typedef float f32x4 __attribute__((ext_vector_type(4)));
typedef float f32x2 __attribute__((ext_vector_type(2)));
typedef short bf16x8 __attribute__((ext_vector_type(8)));
constexpr int NWAVES = 8;
constexpr int M = 16384, D = 1024, T = 8192, FF = 2816, NGU = 5632, R = 1280, NH = 16, NQKV = 3072, NFOX = 3088;
constexpr size_t MiB = 1u << 20;
constexpr size_t WS_SS = 0;
constexpr size_t WS_LOGF = 1 * MiB;
constexpr size_t WS_LSUM = 2 * MiB;
constexpr size_t WS_WF = 5 * MiB;
constexpr size_t WS_WLG = 5 * MiB + 512 * 1024;
constexpr size_t WS_NRM = 6 * MiB + 65536;
constexpr size_t WS_SP = 6 * MiB;
constexpr size_t WS_WGU = 8 * MiB, WGU_BYTES = 11 * MiB;
constexpr size_t WS_WD = 52 * MiB, WD_BYTES = 5 * MiB + 512 * 1024;
constexpr size_t WS_WQKV = 74 * MiB, WS_WO = 80 * MiB, WS_WLIN = 82 * MiB, WS_WLOUT = 87 * MiB;
constexpr size_t WS_XB = 90 * MiB;
constexpr size_t WS_BIG = 122 * MiB;
constexpr size_t WS_END = 218 * MiB;
constexpr int LDS_BYTES = 147456;
constexpr float LOG2E = 1.4426950408889634f;

__device__ __forceinline__ unsigned f2bf(float f) { unsigned u = __builtin_bit_cast(unsigned, f); return (u + 0x7fffu + ((u >> 16) & 1u)) >> 16; }
__device__ __forceinline__ unsigned pk2(float lo, float hi) { return f2bf(lo) | (f2bf(hi) << 16); }
__device__ __forceinline__ float bf2f(unsigned short b) { return __builtin_bit_cast(float, (unsigned)b << 16); }
__device__ __forceinline__ float wave_sum(float v) {
#pragma unroll
    for (int o = 1; o < 64; o <<= 1) v += __shfl_xor(v, o);
    return v;
}

#define XB_TMO      128
#define XB_XCNT(j)  (256  + 64 * (j))
#define XB_XSUB(j)  (1280 + 64 * (j))
#define XB_XGEN(j)  (2304 + 64 * (j))
#define XB_TOP      3328
#define XB_TOPGEN   3392
#define XCD_BAR_WORDS 3456
#define XB_SPIN_CAP (1u << 18)

__device__ __forceinline__ unsigned xb_ld(unsigned* p)              { return __hip_atomic_load(p, __ATOMIC_RELAXED, __HIP_MEMORY_SCOPE_AGENT); }
__device__ __forceinline__ unsigned xb_add(unsigned* p, unsigned v) { return __hip_atomic_fetch_add(p, v, __ATOMIC_RELAXED, __HIP_MEMORY_SCOPE_AGENT); }
__device__ __forceinline__ unsigned xb_xcc_id() { return (unsigned)__builtin_amdgcn_s_getreg((3 << 11) | 20) & 0xFu; }
#define XB_SPIN(cond, bar) do { unsigned _sp = 0; while (cond) { __builtin_amdgcn_s_sleep(1); \
    if ((++_sp & 255u) == 0u) { if (xb_ld(&(bar)[XB_TMO])) break; if (_sp > XB_SPIN_CAP) { atomicAdd(&(bar)[XB_TMO], 1u); break; } } } } while (0)

struct XcdBarrier {
    unsigned* bar; unsigned x;
    volatile LAS unsigned* st;
};

__device__ __forceinline__ XcdBarrier xcd_barrier_post(unsigned* bar, volatile LAS unsigned* st) {
    XcdBarrier b; b.bar = bar; b.x = xb_xcc_id(); b.st = st;
    if (threadIdx.x == 0) (void)xb_add(&bar[XB_XCNT(b.x)], 1u);
    return b;
}
__device__ __forceinline__ void xcd_barrier_complete(unsigned* bar, unsigned x, unsigned& nloc, unsigned& nx) {
    const unsigned G = gridDim.x * gridDim.y * gridDim.z;
    unsigned sum, cnt, mine, sp = 0u;
    for (;;) {
        sum = 0u; cnt = 0u; mine = 0u;
#pragma unroll
        for (unsigned j = 0; j < 16; ++j) { const unsigned c = xb_ld(&bar[XB_XCNT(j)]); sum += c; cnt += (c > 0u) ? 1u : 0u; mine = (j == x) ? c : mine; }
        if (sum == G) break;
        __builtin_amdgcn_s_sleep(1);
        if ((++sp & 255u) == 0u) { if (xb_ld(&bar[XB_TMO])) break; if (sp > XB_SPIN_CAP) { atomicAdd(&bar[XB_TMO], 1u); break; } }
    }
    nloc = mine > 0u ? mine : 1u; nx = cnt > 0u ? cnt : 1u;
}

__device__ __forceinline__ void xcd_barrier(const XcdBarrier& b) {
    asm volatile("s_waitcnt vmcnt(0)" ::: "memory");
    __syncthreads();
    if (threadIdx.x == 0) {
        unsigned* bar = b.bar;
        __builtin_amdgcn_s_waitcnt(0);
        unsigned nloc = b.st[0], nx = b.st[1];
        if (nloc == 0u) { xcd_barrier_complete(bar, b.x, nloc, nx); b.st[0] = nloc; b.st[1] = nx; }
        const unsigned old = xb_add(&bar[XB_XSUB(b.x)], 1u);
        const unsigned gen = old / nloc;
        if (old + 1u == (gen + 1u) * nloc) {
            __builtin_amdgcn_fence(__ATOMIC_RELEASE, "agent");
            asm volatile("s_waitcnt vmcnt(0)" ::: "memory");
            const unsigned og = xb_add(&bar[XB_TOP], 1u);
            const unsigned tg = og / nx;
            if (og + 1u == (tg + 1u) * nx) xb_add(&bar[XB_TOPGEN], 1u);
            else XB_SPIN(xb_ld(&bar[XB_TOPGEN]) == tg, bar);
            __builtin_amdgcn_fence(__ATOMIC_ACQUIRE, "agent");
            xb_add(&bar[XB_XGEN(b.x)], 1u);
            asm volatile("s_waitcnt vmcnt(0)" ::: "memory");
        } else {
            XB_SPIN(xb_ld(&bar[XB_XGEN(b.x)]) == gen, bar);
            __builtin_amdgcn_fence(__ATOMIC_ACQUIRE, "agent");
            asm volatile("s_waitcnt vmcnt(0)" ::: "memory");
        }
    }
    __syncthreads();
}

constexpr size_t WS_BAR = 7 * MiB, BAR_BYTES = 16384;
constexpr int MISC_OFF = 131072 + 320;
struct Args { const float* in[21]; float* out; unsigned char* ws; int ph_lo, ph_hi; };
enum { I_X = 0, I_F1N, I_F1GU, I_F1D, I_MIXN, I_F2N, I_F2GU, I_F2D, I_FOXIN, I_FOXBF, I_FOXOUT, I_LIN, I_LCW, I_LCB, I_LWA, I_LBA, I_LWI, I_LBI, I_LLAM, I_LOUT, I_FINN };

template <bool GU> __device__ __forceinline__ void tr_item(const float* W, int ldw, int K, int nblk, const float* gain, bf16* WT, LAS float* scr, int item, int lane) {
    const int kb = item / nblk, nb = item - kb * nblk, k0 = 64 * kb, n0 = 32 * nb;
#pragma unroll 8
    for (int i = 0; i < 32; ++i) { const int kk = 2 * i + (lane >> 5); float w = W[(size_t)(k0 + kk) * ldw + n0 + (lane & 31)]; if (gain) w *= gain[k0 + kk]; scr[kk * 33 + (lane & 31)] = w; }
    asm volatile("s_waitcnt lgkmcnt(0)" ::: "memory");
    int row0 = n0;
    if (GU) { const int c = (n0 < FF) ? n0 : n0 - FF; row0 = 256 * (c >> 7) + (c & 127) + ((n0 < FF) ? 0 : 128); }
    const int c8 = lane & 7;
#pragma unroll
    for (int j = 0; j < 4; ++j) { const int n = (lane >> 3) + 8 * j; const LAS float* s = scr + (8 * c8) * 33 + n;
        v4u o; o.x = pk2(s[0 * 33], s[1 * 33]); o.y = pk2(s[2 * 33], s[3 * 33]); o.z = pk2(s[4 * 33], s[5 * 33]); o.w = pk2(s[6 * 33], s[7 * 33]);
        *(v4u*)(WT + (size_t)(row0 + n) * K + k0 + 8 * c8) = o; }
    asm volatile("s_waitcnt lgkmcnt(0)" ::: "memory");
}

template <class Epi> __device__ __forceinline__ void run_gemm(LAS unsigned char* lds, const bf16* A, const bf16* Bt, int N, int K, const Epi& E) {
    pg8::Gemm g{A, Bt, M, N, K}; pg8::StaticOrder S; S.init(M, N, osgpr((int)gridDim.x), osgpr((int)blockIdx.x));
    pg8::gemm_phase<Epi, pg8::StaticOrder, PG8_ALIGN, PG8_SP2>(lds, g, S, E);
}

__device__ __forceinline__ float expm1_small(float x) {
    float p = 1.0f / 5040.0f; p = p * x + 1.0f / 720.0f; p = p * x + 1.0f / 120.0f; p = p * x + 1.0f / 24.0f; p = p * x + 1.0f / 6.0f; p = p * x + 0.5f; p = p * x + 1.0f; return p * x;
}
template <bool PASSB> __device__ __forceinline__ void lru_phase(LAS unsigned char* L, const Args& args, int vcu, int G, int tid, bf16* YOUT) {
    const int lane = tid & 63, wave = __builtin_amdgcn_readfirstlane(tid >> 6), fr = lane & 15, fq = lane >> 4;
    LAS bf16* Wt = (LAS bf16*)(L);
    LAS bf16* xcb = (LAS bf16*)(L + 33280);
    LAS float* xcf = (LAS float*)(L + 46592);
    LAS float* Aa = (LAS float*)(L + 67072);
    LAS float* Bb = (LAS float*)(L + 87552);
    LAS bf16* recs = (LAS bf16*)(L + 108032);
    LAS float* sub = (LAS float*)(L + 118752);
    LAS float* carry = (LAS float*)(L + 121312);
    LAS float* cst = (LAS float*)(L + 121632);
    unsigned char* ws = args.ws;
    const bf16* Wg = (const bf16*)(ws + WS_WLG); const float* sp = (const float*)(ws + WS_SP);
    const bf16* GATE = (const bf16*)(ws + WS_BIG); const bf16* REC = (const bf16*)(ws + WS_BIG + 40 * MiB);
    f32x2* SUM = (f32x2*)(ws + WS_LSUM);
    const int n = vcu & 15, ustep = G >> 4, u0 = vcu >> 4;
    unsigned zero = 0u; asm volatile("" : "+v"(zero));
    const int rr0 = tid / 10, pc0 = tid - rr0 * 10, rr1 = (tid + 512) / 10, pc1 = (tid + 512) - rr1 * 10;
#define LRU_REC_LOAD(uu, q0_, q1_) do { const int b_ = (uu) >> 7, t0_ = ((uu) & 127) * 64; q0_ = (v4u){zero, zero, zero, zero}; q1_ = q0_; \
        if (t0_ - 3 + rr0 >= 0) q0_ = *(const v4u*)(REC + ((size_t)b_ * T + t0_ - 3 + rr0) * R + n * 80 + pc0 * 8); \
        if (tid + 512 < 670) q1_ = *(const v4u*)(REC + ((size_t)b_ * T + t0_ - 3 + rr1) * R + n * 80 + pc1 * 8); } while (0)
#define LRU_SUM_LOAD(uu, sq_) do { const int b_ = (uu) >> 7, j_ = (uu) & 127, lo_ = (j_ < ustep) ? 0 : j_ - ustep; const f32x2* S_ = SUM + ((size_t)b_ * 128) * R + n * 80 + tid; \
        _Pragma("unroll") for (int i_ = 0; i_ < 16; ++i_) { sq_[i_] = (f32x2){1.f, 0.f}; if (tid < 80 && lo_ + i_ < j_) sq_[i_] = S_[(size_t)(lo_ + i_) * R]; } } while (0)
    v4u rq0, rq1; f32x2 sq[16];
    LRU_REC_LOAD(u0, rq0, rq1);
    if (PASSB) LRU_SUM_LOAD(u0, sq);
    for (int p = tid; p < 1920; p += 512) { const int row = p / 12, pc = p - row * 12; *(LAS v4u*)(Wt + row * 104 + pc * 8) = *(const v4u*)(Wg + (size_t)(n * 160 + row) * 96 + pc * 8); }
    if (tid < 128) { const int row = tid >> 1, pc = tid & 1; *(LAS v4u*)(xcb + row * 104 + 80 + pc * 8) = (v4u){zero, zero, zero, zero}; }
    if (tid < 80) { const int c = n * 80 + tid;
        cst[0 * 80 + tid] = args.in[I_LCW][0 * R + c]; cst[1 * 80 + tid] = args.in[I_LCW][1 * R + c]; cst[2 * 80 + tid] = args.in[I_LCW][2 * R + c]; cst[3 * 80 + tid] = args.in[I_LCW][3 * R + c];
        cst[4 * 80 + tid] = args.in[I_LCB][c]; cst[5 * 80 + tid] = args.in[I_LBA][c]; cst[6 * 80 + tid] = args.in[I_LBI][c]; cst[7 * 80 + tid] = sp[c]; }
    float hc = 0.f;
    for (int u = u0; u < 256; u += ustep) {
        const int b = u >> 7, j = u & 127, t0 = j * 64; const size_t rowg0 = (size_t)b * T + t0;
        *(LAS v4u*)(recs + rr0 * 80 + pc0 * 8) = rq0; if (tid + 512 < 670) *(LAS v4u*)(recs + rr1 * 80 + pc1 * 8) = rq1;
        if (PASSB && tid < 80) { if (j < ustep) hc = 0.f;
#pragma unroll
            for (int i = 0; i < 16; ++i) hc = sq[i].x * hc + sq[i].y;
            carry[tid] = hc; }
        v4u gq0 = (v4u){zero, zero, zero, zero}, gq1 = gq0;
        if (PASSB) { gq0 = *(const v4u*)(GATE + (rowg0 + rr0) * R + n * 80 + pc0 * 8); if (tid + 512 < 640) gq1 = *(const v4u*)(GATE + (rowg0 + rr1) * R + n * 80 + pc1 * 8); }
        if (u + ustep < 256) { LRU_REC_LOAD(u + ustep, rq0, rq1); if (PASSB) LRU_SUM_LOAD(u + ustep, sq); }
        __syncthreads();
#pragma unroll
        for (int i = 0; i < 10; ++i) { const int idx = tid + 512 * i, t = idx / 80, c = idx - t * 80;
            float x = cst[4 * 80 + c];
#pragma unroll
            for (int jj = 0; jj < 4; ++jj) x += cst[jj * 80 + c] * bf2f(recs[(t + jj) * 80 + c]);
            xcf[t * 80 + c] = x; xcb[t * 104 + c] = (bf16)f2bf(x); }
        __syncthreads();
        { const int mt = wave & 3, ct0 = (wave >> 2) ? 3 : 0, ct1 = (wave >> 2) ? 5 : 3, tok = 16 * mt + fr;
            for (int ct = ct0; ct < ct1; ++ct) { f32x4 ga = (f32x4){0.f, 0.f, 0.f, 0.f}, gi = ga;
#pragma unroll
                for (int kk = 0; kk < 3; ++kk) { const bf16x8 xf = *(const LAS bf16x8*)(xcb + tok * 104 + 32 * kk + 8 * fq);
                    const bf16x8 wa = *(const LAS bf16x8*)(Wt + (16 * ct + fr) * 104 + 32 * kk + 8 * fq), wi = *(const LAS bf16x8*)(Wt + (80 + 16 * ct + fr) * 104 + 32 * kk + 8 * fq);
                    ga = __builtin_amdgcn_mfma_f32_16x16x32_bf16(wa, xf, ga, 0, 0, 0); gi = __builtin_amdgcn_mfma_f32_16x16x32_bf16(wi, xf, gi, 0, 0, 0); }
                const int ch0 = 16 * ct + 4 * fq; const f32x4 xv = *(const LAS f32x4*)(xcf + tok * 80 + ch0);
                const f32x4 bav = *(const LAS f32x4*)(cst + 5 * 80 + ch0), biv = *(const LAS f32x4*)(cst + 6 * 80 + ch0), spv = *(const LAS f32x4*)(cst + 7 * 80 + ch0); f32x4 av, bv;
#pragma unroll
                for (int e = 0; e < 4; ++e) {
                    const float r = pg8::fast_sigmoid(ga[e] + bav[e]), ig = pg8::fast_sigmoid(gi[e] + biv[e]);
                    const float la = -8.0f * r * spv[e]; float a, om;
                    if (la > -0.125f) { a = 1.0f + expm1_small(la); om = -expm1_small(2.0f * la); } else { a = expf(la); om = -expm1f(2.0f * la); }
                    av[e] = a; bv[e] = __builtin_amdgcn_sqrtf(om) * (ig * xv[e]); }
                *(LAS f32x4*)(Aa + tok * 80 + ch0) = av; *(LAS f32x4*)(Bb + tok * 80 + ch0) = bv; } }
        __syncthreads();
        const int ch = tid % 80, s = tid / 80;
        if (tid < 320) { float Ap = 1.f, Bp = 0.f;
#pragma unroll
            for (int tt = 0; tt < 16; ++tt) { const int t = 16 * s + tt; const float a = Aa[t * 80 + ch], bb = Bb[t * 80 + ch]; Ap *= a; Bp = a * Bp + bb; }
            sub[(s * 80 + ch) * 2] = Ap; sub[(s * 80 + ch) * 2 + 1] = Bp; }
        __syncthreads();
        if (!PASSB) {
            if (tid < 80) { float Ap = 1.f, Bp = 0.f;
#pragma unroll
                for (int s2 = 0; s2 < 4; ++s2) { const float a = sub[(s2 * 80 + tid) * 2], bb = sub[(s2 * 80 + tid) * 2 + 1]; Ap *= a; Bp = a * Bp + bb; }
                SUM[((size_t)b * 128 + j) * R + n * 80 + tid] = (f32x2){Ap, Bp}; }
        } else {
            if (tid < 320) { float h = carry[ch];
                for (int s2 = 0; s2 < s; ++s2) h = sub[(s2 * 80 + ch) * 2] * h + sub[(s2 * 80 + ch) * 2 + 1];
#pragma unroll
                for (int tt = 0; tt < 16; ++tt) { const int t = 16 * s + tt; h = Aa[t * 80 + ch] * h + Bb[t * 80 + ch]; Bb[t * 80 + ch] = h; } }
            __syncthreads();
#define LRU_OUT(rr_, pc_, gv) do { const f32x4 h0 = *(const LAS f32x4*)(Bb + (rr_) * 80 + (pc_) * 8), h1 = *(const LAS f32x4*)(Bb + (rr_) * 80 + (pc_) * 8 + 4); v4u o; \
                o.x = pk2(h0[0] * bf2f((unsigned short)(gv.x & 0xffffu)), h0[1] * bf2f((unsigned short)(gv.x >> 16))); o.y = pk2(h0[2] * bf2f((unsigned short)(gv.y & 0xffffu)), h0[3] * bf2f((unsigned short)(gv.y >> 16))); \
                o.z = pk2(h1[0] * bf2f((unsigned short)(gv.z & 0xffffu)), h1[1] * bf2f((unsigned short)(gv.z >> 16))); o.w = pk2(h1[2] * bf2f((unsigned short)(gv.w & 0xffffu)), h1[3] * bf2f((unsigned short)(gv.w >> 16))); \
                *(v4u*)(YOUT + (rowg0 + (rr_)) * R + n * 80 + (pc_) * 8) = o; } while (0)
            LRU_OUT(rr0, pc0, gq0); if (tid + 512 < 640) LRU_OUT(rr1, pc1, gq1);
#undef LRU_OUT
        }
        __syncthreads();
    }
#undef LRU_REC_LOAD
#undef LRU_SUM_LOAD
}

__device__ __forceinline__ void p0_prologue(LAS unsigned char* lds, const Args& args, int vcu, int G, int tid) {
    const int lane = tid & 63, wave = __builtin_amdgcn_readfirstlane(tid >> 6);
    unsigned char* ws = args.ws;
    LAS float* scr = (LAS float*)(lds + wave * 16384);
    const int gw = vcu * NWAVES + wave, NGW = G * NWAVES;
    constexpr int I_GU = (D / 64) * (NGU / 32), I_DN = (FF / 64) * (D / 32), I_QKV = (D / 64) * (NQKV / 32), I_WO = (D / 64) * (D / 32), I_LI = (D / 64) * (2 * R / 32), I_LO = (R / 64) * (D / 32);
    constexpr int NITEMS = 4 * I_GU + 4 * I_DN + I_QKV + I_WO + I_LI + I_LO;
#define TR_DECODE(it_, W_, gn_, WT_, ldw_, K_, nblk_, gu_, r_) do { int q_ = (it_); gu_ = 0; gn_ = nullptr; \
        if (q_ < 4 * I_GU) { const int f = q_ / I_GU; q_ -= f * I_GU; const int layer = f >> 1; \
            W_ = ((f & 1) ? args.in[I_F2GU] : args.in[I_F1GU]) + (size_t)layer * D * NGU; gn_ = ((f & 1) ? args.in[I_F2N] : args.in[I_F1N]) + layer * D; \
            WT_ = (bf16*)(ws + WS_WGU + f * WGU_BYTES); ldw_ = NGU; K_ = D; nblk_ = NGU / 32; gu_ = 1; } \
        else if ((q_ -= 4 * I_GU) < 4 * I_DN) { const int f = q_ / I_DN; q_ -= f * I_DN; const int layer = f >> 1; \
            W_ = ((f & 1) ? args.in[I_F2D] : args.in[I_F1D]) + (size_t)layer * FF * D; WT_ = (bf16*)(ws + WS_WD + f * WD_BYTES); ldw_ = D; K_ = FF; nblk_ = D / 32; } \
        else if ((q_ -= 4 * I_DN) < I_QKV) { W_ = args.in[I_FOXIN]; gn_ = args.in[I_MIXN]; WT_ = (bf16*)(ws + WS_WQKV); ldw_ = NFOX; K_ = D; nblk_ = NQKV / 32; } \
        else if ((q_ -= I_QKV) < I_WO) { W_ = args.in[I_FOXOUT]; WT_ = (bf16*)(ws + WS_WO); ldw_ = D; K_ = D; nblk_ = D / 32; } \
        else if ((q_ -= I_WO) < I_LI) { W_ = args.in[I_LIN]; gn_ = args.in[I_MIXN] + D; WT_ = (bf16*)(ws + WS_WLIN); ldw_ = 2 * R; K_ = D; nblk_ = 2 * R / 32; } \
        else { q_ -= I_LI; W_ = args.in[I_LOUT]; WT_ = (bf16*)(ws + WS_WLOUT); ldw_ = D; K_ = R; nblk_ = D / 32; } \
        r_ = q_; } while (0)
#define TR_LOAD(v_, W_, ldw_, nblk_, r_) do { const int kb_ = (r_) / (nblk_), nb_ = (r_) - kb_ * (nblk_); const float* p_ = (W_) + (size_t)(64 * kb_ + (lane >> 3)) * (ldw_) + 32 * nb_ + 4 * (lane & 7); \
        _Pragma("unroll") for (int i_ = 0; i_ < 8; ++i_) v_[i_] = *(const f32x4*)(p_ + (size_t)(8 * i_) * (ldw_)); } while (0)
    {
        const float* W = nullptr; const float* gn = nullptr; bf16* WT = nullptr; int ldw = 0, K = 0, nblk = 1, gu = 0, r = 0; f32x4 cur[8];
        int it = gw;
        if (it < NITEMS) { TR_DECODE(it, W, gn, WT, ldw, K, nblk, gu, r); TR_LOAD(cur, W, ldw, nblk, r); }
        while (it < NITEMS) {
            const int itn = it + NGW; const float* Wn = nullptr; const float* gnn = nullptr; bf16* WTn = nullptr; int ldwn = 0, Kn = 0, nblkn = 1, gun = 0, rn = 0; f32x4 nxt[8];
            if (itn < NITEMS) { TR_DECODE(itn, Wn, gnn, WTn, ldwn, Kn, nblkn, gun, rn); TR_LOAD(nxt, Wn, ldwn, nblkn, rn); }
            const int kb = r / nblk, nb = r - kb * nblk, k0 = 64 * kb, n0 = 32 * nb;
#pragma unroll
            for (int i = 0; i < 8; ++i) { const int kk = 8 * i + (lane >> 3); const float g = gn ? gn[k0 + kk] : 1.0f; LAS float* sp_ = scr + kk * 33 + 4 * (lane & 7);
                sp_[0] = cur[i][0] * g; sp_[1] = cur[i][1] * g; sp_[2] = cur[i][2] * g; sp_[3] = cur[i][3] * g; }
            asm volatile("s_waitcnt lgkmcnt(0)" ::: "memory");
            int row0 = n0;
            if (gu) { const int c = (n0 < FF) ? n0 : n0 - FF; row0 = 256 * (c >> 7) + (c & 127) + ((n0 < FF) ? 0 : 128); }
            const int c8 = lane & 7;
#pragma unroll
            for (int j = 0; j < 4; ++j) { const int n = (lane >> 3) + 8 * j; const LAS float* s_ = scr + (8 * c8) * 33 + n;
                v4u o; o.x = pg8::cvt_pk_bf16(s_[0 * 33], s_[1 * 33]); o.y = pg8::cvt_pk_bf16(s_[2 * 33], s_[3 * 33]); o.z = pg8::cvt_pk_bf16(s_[4 * 33], s_[5 * 33]); o.w = pg8::cvt_pk_bf16(s_[6 * 33], s_[7 * 33]);
                *(v4u*)(WT + (size_t)(row0 + n) * K + k0 + 8 * c8) = o; }
            asm volatile("s_waitcnt lgkmcnt(0)" ::: "memory");
            it = itn; W = Wn; gn = gnn; WT = WTn; ldw = ldwn; K = Kn; nblk = nblkn; gu = gun; r = rn;
#pragma unroll
            for (int i = 0; i < 8; ++i) cur[i] = nxt[i];
        }
    }
#undef TR_DECODE
#undef TR_LOAD
    const int gt = vcu * 512 + tid, NGT = G * 512;
    { bf16* wf = (bf16*)(ws + WS_WF);
        for (int i = gt; i < NH * D; i += NGT) { const int h = i >> 10, k = i & 1023; wf[i] = (bf16)f2bf(args.in[I_MIXN][k] * args.in[I_FOXIN][(size_t)k * NFOX + NQKV + h]); } }
    { bf16* wg = (bf16*)(ws + WS_WLG);
        for (int i = gt; i < 16 * 160 * 96; i += NGT) { const int k = i % 96, dd = (i / 96) % 160, n = i / (96 * 160); float v = 0.f;
            if (k < 80) v = (dd < 80) ? args.in[I_LWA][((size_t)n * 80 + k) * 80 + dd] : args.in[I_LWI][((size_t)n * 80 + k) * 80 + (dd - 80)];
            wg[i] = (bf16)f2bf(v); } }
    { float* sp = (float*)(ws + WS_SP); for (int i = gt; i < R; i += NGT) sp[i] = log1pf(expf(-args.in[I_LLAM][i])); }
    { float* ss = (float*)(ws + WS_SS); for (int i = gt; i < 7 * M; i += NGT) ss[M + i] = 0.f; }
    { float* ss0 = (float*)(ws + WS_SS); bf16* xb = (bf16*)(ws + WS_XB); const float* x = args.in[I_X];
        for (int m = gw; m < M; m += NGW) { const f32x4* xr = (const f32x4*)(x + (size_t)m * D) + lane; f32x4 v[4]; float s = 0.f;
#pragma unroll
            for (int j = 0; j < 4; ++j) { v[j] = xr[64 * j]; s += (v[j].x * v[j].x + v[j].y * v[j].y) + (v[j].z * v[j].z + v[j].w * v[j].w); }
            s = wave_sum(s); if (lane == 0) ss0[m] = s;
            unsigned long long* o8 = (unsigned long long*)(xb + (size_t)m * D) + lane;
#pragma unroll
            for (int j = 0; j < 4; ++j) o8[64 * j] = (unsigned long long)pk2(v[j].x, v[j].y) | ((unsigned long long)pk2(v[j].z, v[j].w) << 32); } }
}

__device__ __forceinline__ void flogit_phase(const Args& args, int vcu, int G, int tid) {
    const int lane = tid & 63, wave = __builtin_amdgcn_readfirstlane(tid >> 6), fr = lane & 15, fq = lane >> 4;
    unsigned char* ws = args.ws; const bf16* xb = (const bf16*)(ws + WS_XB); const bf16* wf = (const bf16*)(ws + WS_WF); const float* ss = (const float*)(ws + WS_SS) + 1 * M; float* logf_ = (float*)(ws + WS_LOGF);
    const int gw = vcu * NWAVES + wave, NGW = G * NWAVES;
    for (int grp = gw; grp < M / 16; grp += NGW) { const int row0 = grp * 16;
        const bf16* xa = xb + (size_t)(row0 + fr) * D + 8 * fq; const bf16* wb = wf + (size_t)fr * D + 8 * fq; f32x4 acc = (f32x4){0.f, 0.f, 0.f, 0.f};
#pragma unroll 8
        for (int kk = 0; kk < 32; ++kk) { const bf16x8 xf = *(const bf16x8*)(xa + 32 * kk), wv = *(const bf16x8*)(wb + 32 * kk); acc = __builtin_amdgcn_mfma_f32_16x16x32_bf16(wv, xf, acc, 0, 0, 0); }
        const int row = row0 + fr, b = row >> 13, t = row & (T - 1); const float rs = pg8::rstd_row(ss, row);
#pragma unroll
        for (int e = 0; e < 4; ++e) { const int h = 4 * fq + e; const float z = acc[e] * rs + args.in[I_FOXBF][h];
            const float lf = fminf(z, 0.f) - log1pf(expf(-fabsf(z))); logf_[(size_t)(b * NH + h) * T + t] = lf * LOG2E; } }
}

__device__ __forceinline__ void attn_cumsum(const float* lf, LAS float* Gl, LAS float* wsum, int tid) {
    const int lane = tid & 63, wave = tid >> 6; f32x4 v[4];
#pragma unroll
    for (int j = 0; j < 4; ++j) v[j] = *(const f32x4*)(lf + tid * 16 + 4 * j);
    float run = 0.f;
#pragma unroll
    for (int j = 0; j < 4; ++j) { run += v[j].x; v[j].x = run; run += v[j].y; v[j].y = run; run += v[j].z; v[j].z = run; run += v[j].w; v[j].w = run; }
    float incl = run;
#pragma unroll
    for (int o = 1; o < 64; o <<= 1) { const float nb = __shfl_up(incl, o); if (lane >= o) incl += nb; }
    if (lane == 63) wsum[wave] = incl;
    __syncthreads();
    float base = incl - run;
    for (int w = 0; w < wave; ++w) base += wsum[w];
#pragma unroll
    for (int j = 0; j < 4; ++j) *(LAS f32x4*)(Gl + tid * 16 + 4 * j) = v[j] + base;
    __syncthreads();
}

constexpr int N_PHASES = 17;
#ifndef ONLY_KIND
#define ONLY_KIND -1
#endif
#define KON(k) (ONLY_KIND < 0 || ONLY_KIND == (k))
#ifndef DUP_PH
#define DUP_PH -1
#endif
#ifndef DUP_SYNC
#define DUP_SYNC 0
#endif
__global__ void __launch_bounds__(NWAVES * 64, 2) fwd_megakernel(Args args) {
    extern __shared__ __attribute__((aligned(16))) unsigned char lds_raw[];
    LAS unsigned char* lds = (LAS unsigned char*)lds_raw;
    cg::grid_group grid = cg::this_grid();
    if (threadIdx.x < 16) ((LAS unsigned*)(lds + MISC_OFF))[threadIdx.x] = 0u;
    __syncthreads();
    XcdBarrier xbar = xcd_barrier_post((unsigned*)(args.ws + WS_BAR), (volatile LAS unsigned*)(lds + MISC_OFF));
    unsigned char* ws = args.ws;
    float* ssb = (float*)(ws + WS_SS); bf16* XB = (bf16*)(ws + WS_XB);
    bf16* HB = (bf16*)(ws + WS_BIG); bf16* QB_ = (bf16*)(ws + WS_BIG); bf16* KB = (bf16*)(ws + WS_BIG + 32 * MiB); bf16* VB = (bf16*)(ws + WS_BIG + 64 * MiB);
    bf16* GATE = (bf16*)(ws + WS_BIG); bf16* REC = (bf16*)(ws + WS_BIG + 40 * MiB);
    for (int pp = args.ph_lo; pp < args.ph_hi; ++pp) {
        int ph = pp; bool dummy = false;
        if (DUP_PH >= 0) { dummy = (pp == DUP_PH); ph = (pp <= DUP_PH) ? pp : pp - 1; }
        const int tid = otid(), G = osgpr((int)gridDim.x), bx = osgpr((int)blockIdx.x);
        const int vcu = (G % 8 == 0) ? (bx % 8) * (G / 8) + bx / 8 : bx;
        int kind = 0, f = 0, ssi = 0; const bf16* A = XB; const bf16* Bt = nullptr; int K = D; const float* xin = args.out; float alpha = 1.f;
        switch (ph) {
            case 0: kind = 0; break;
            case 1: kind = 1; f = 0; ssi = 0; break;
            case 2: kind = 2; A = HB; Bt = (const bf16*)(ws + WS_WD + 0 * WD_BYTES); K = FF; xin = args.in[I_X]; alpha = 0.5f; ssi = 1; break;
            case 3: kind = 3; break;
            case 4: kind = 4; break;
            case 5: kind = 2; A = QB_; Bt = (const bf16*)(ws + WS_WO); K = D; alpha = 1.f; ssi = 2; break;
            case 6: kind = 1; f = 1; ssi = 2; break;
            case 7: kind = 2; A = HB; Bt = (const bf16*)(ws + WS_WD + 1 * WD_BYTES); K = FF; alpha = 0.5f; ssi = 3; break;
            case 8: kind = 1; f = 2; ssi = 3; break;
            case 9: kind = 2; A = HB; Bt = (const bf16*)(ws + WS_WD + 2 * WD_BYTES); K = FF; alpha = 0.5f; ssi = 4; break;
            case 10: kind = 5; break;
            case 11: kind = 6; break;
            case 12: kind = 7; break;
            case 13: kind = 2; A = GATE; Bt = (const bf16*)(ws + WS_WLOUT); K = R; alpha = 1.f; ssi = 5; break;
            case 14: kind = 1; f = 3; ssi = 5; break;
            case 15: kind = 2; A = HB; Bt = (const bf16*)(ws + WS_WD + 3 * WD_BYTES); K = FF; alpha = 0.5f; ssi = 6; break;
            default: kind = 8; break;
        }
        if (dummy) { alpha = 0.f; if (kind == 2) ssi = 7; }
        bf16* const OB = dummy ? (bf16*)(ws + 218 * MiB) : QB_; bf16* const YB = dummy ? (bf16*)(ws + WS_BIG + 80 * MiB) : GATE;
        if (KON(0) && kind == 0) { p0_prologue(lds, args, vcu, G, tid); }
        else if (KON(1) && kind == 1) { pg8::EpiSwiGLU E{HB, ssb + (size_t)ssi * M}; run_gemm(lds, XB, (const bf16*)(ws + WS_WGU + f * WGU_BYTES), NGU, D, E); }
        else if (KON(2) && kind == 2) { pg8::EpiResid E{xin, args.out, XB, ssb + (size_t)ssi * M, alpha}; run_gemm(lds, A, Bt, D, K, E); }
        else if (KON(3) && kind == 3) { pg8::EpiQKV E{QB_, (size_t)M * D, ssb + 1 * M, attn_body::C2, (float*)(ws + WS_NRM)}; run_gemm(lds, XB, (const bf16*)(ws + WS_WQKV), NQKV, D, E); flogit_phase(args, vcu, G, tid); }
        else if (KON(4) && kind == 4) {
            LAS float* Gl = (LAS float*)(lds + 86016); LAS float* wsum = (LAS float*)(lds + 86016 + 32768); LAS unsigned* tsw = (LAS unsigned*)(lds + 86016 + 32768 + 64);
            for (int item = vcu; item < 256; item += G) { const int bh = item >> 3, s = item & 7;
                attn_cumsum((const float*)(ws + WS_LOGF) + (size_t)bh * T, Gl, wsum, tid);
                for (int i = 0; i < 4; ++i) { const int qb = (i == 0) ? s : (i == 1) ? 15 - s : (i == 2) ? 16 + s : 31 - s;
                    const int hd = bh & 15, bb = bh >> 4, NTu = 4 * qb + 4, q0 = 256 * qb; const float* nq = (const float*)(ws + WS_NRM) + ((size_t)hd * 256 + bb * 128) * 2; const float* nk = nq + (size_t)16 * 256 * 2;
                    if (tid == 0) tsw[0] = (unsigned)(NTu - 4);
                    __syncthreads();
                    if (tid < 128 && tid < NTu - 4) { float qn2 = 0.f;
#pragma unroll
                        for (int r4 = 0; r4 < 4; ++r4) qn2 = fmaxf(qn2, nq[(4 * qb + r4) * 2] + nq[(4 * qb + r4) * 2 + 1]);
                        const float kn2 = nk[tid * 2] + nk[tid * 2 + 1]; const float bound = 1.01f * sqrtf(qn2 * kn2) + Gl[q0] - Gl[64 * tid + 63];
                        if (!(bound < -190.f)) atomicMin((unsigned*)tsw, (unsigned)tid); }
                    __syncthreads();
                    const int tstart = __builtin_amdgcn_readfirstlane((int)tsw[0]) & ~1;
                    attn_body::attn_unit<8>(bh >> 4, bh & 15, qb, (const attn_body::bf16*)QB_, (const attn_body::bf16*)KB, (const attn_body::bf16*)VB, (attn_body::bf16*)OB, (char*)lds_raw, (attn_body::lds_fptr)Gl, tstart); }
                __syncthreads(); }
        }
        else if (KON(5) && kind == 5) { pg8::EpiLruIn E{GATE, REC, ssb + 4 * M}; run_gemm(lds, XB, (const bf16*)(ws + WS_WLIN), 2 * R, D, E); }
        else if (KON(6) && kind == 6) { lru_phase<false>(lds, args, vcu, G, tid, YB); }
        else if (KON(7) && kind == 7) { lru_phase<true>(lds, args, vcu, G, tid, YB); }
        else if (KON(8)) { const int lane = tid & 63, wave = tid >> 6, gw = vcu * NWAVES + wave, NGW = G * NWAVES; const float* ss = ssb + 6 * M; const f32x4* gn = (const f32x4*)args.in[I_FINN] + lane;
            for (int m = gw; m < M; m += NGW) { const float rs = pg8::rstd_row(ss, m); f32x4* xr = (f32x4*)(args.out + (size_t)m * D) + lane;
#pragma unroll
                for (int j = 0; j < 4; ++j) { const f32x4 v = xr[64 * j]; xr[64 * j] = v * rs * gn[64 * j]; } } }
        if (pp + 1 < args.ph_hi) { if (pp == args.ph_lo) grid.sync(); else xcd_barrier(xbar); if (DUP_SYNC) xcd_barrier(xbar); }
    }
}

#ifndef MK_PER_PHASE_LAUNCH
#define MK_PER_PHASE_LAUNCH 0
#endif
extern "C" void kernel_launch(void* const* d_in, const int* in_sizes, int n_in, void* d_out, int out_size, void* d_ws, size_t ws_size, hipStream_t stream) {
    static int grid = 0;
    if (grid == 0) {
        if (n_in != 21 || in_sizes[0] != M * D || out_size != M * D || ws_size < WS_END) { fprintf(stderr, "kernel_launch: unexpected shapes (n_in %d, in0 %d, out %d, ws %zu); nothing launched\n", n_in, n_in > 0 ? in_sizes[0] : -1, out_size, ws_size); grid = -1; return; }
        int dev = 0, cus = 0, per_cu = 0;
        if (hipGetDevice(&dev) != hipSuccess || hipDeviceGetAttribute(&cus, hipDeviceAttributeMultiprocessorCount, dev) != hipSuccess) { grid = -1; return; }
        if (hipFuncSetAttribute((const void*)fwd_megakernel, hipFuncAttributeMaxDynamicSharedMemorySize, LDS_BYTES) != hipSuccess) { fprintf(stderr, "kernel_launch: hipFuncSetAttribute failed\n"); grid = -1; return; }
        if (hipOccupancyMaxActiveBlocksPerMultiprocessor(&per_cu, (const void*)fwd_megakernel, NWAVES * 64, LDS_BYTES) != hipSuccess || per_cu < 1) { fprintf(stderr, "kernel_launch: occupancy query says %d blocks per CU\n", per_cu); per_cu = 1; }
        (void)hipGetLastError();
        grid = cus * per_cu;
        if (grid != 256) fprintf(stderr, "kernel_launch: grid %d (this kernel's static unit orders assume 256 workgroups)\n", grid);
    }
    if (grid < 0) return;
    Args a{};
    for (int i = 0; i < 21; ++i) a.in[i] = (const float*)d_in[i];
    a.out = (float*)d_out; a.ws = (unsigned char*)d_ws;
    if (hipMemsetAsync((unsigned char*)d_ws + WS_BAR, 0, BAR_BYTES, stream) != hipSuccess) { fprintf(stderr, "kernel_launch: memset of the barrier words failed\n"); return; }
#if MK_PER_PHASE_LAUNCH
    for (int ph = 0; ph < N_PHASES; ++ph) { a.ph_lo = ph; a.ph_hi = ph + 1; hipLaunchKernelGGL(fwd_megakernel, dim3(grid), dim3(NWAVES * 64), LDS_BYTES, stream, a); }
#else
    a.ph_lo = 0; a.ph_hi = N_PHASES + ((DUP_PH >= 0) ? 1 : 0);
    void* kargs[] = {&a};
    const hipError_t e = hipLaunchCooperativeKernel((const void*)fwd_megakernel, dim3(grid), dim3(NWAVES * 64), kargs, LDS_BYTES, stream);
    if (e != hipSuccess) fprintf(stderr, "kernel_launch: cooperative launch failed: %s (grid %d)\n", hipGetErrorString(e), grid);
#endif
}
```

```cpp
#define DUP_PH -1
#define DUP_SYNC 0
#include <hip/hip_runtime.h>
#include <hip/hip_cooperative_groups.h>
#include <cstdio>
#include <cstdint>
namespace cg = cooperative_groups;
__device__ __forceinline__ int otid() { int t = (int)threadIdx.x; asm volatile("" : "+v"(t)); return t; }
__device__ __forceinline__ int osgpr(int v) { asm volatile("" : "+s"(v)); return v; }
namespace pg8 {
#define PG8_LAS __attribute__((address_space(3)))
typedef unsigned short bf16_t;
typedef short bf16x8 __attribute__((ext_vector_type(8)));
typedef float f32x4 __attribute__((ext_vector_type(4)));
typedef unsigned u32x4 __attribute__((ext_vector_type(4)));
constexpr int BM = 256, BK = 64, HALF = 128, HTB = HALF * BK * 2  , STAGE_BYTES = 8 * HTB, NXCD = 8, WGM = 8;

__host__ __device__ __forceinline__ int lds_byte(int r, int c) { const int st = (r >> 4) * 2 + (c >> 5), rr = r & 15, cc = c & 31, ob = rr * 64 + cc * 2; return st * 1024 + (ob ^ (((ob >> 9) & 1) << 5)); }
__host__ __device__ __forceinline__ void stage_rc(int b, int& R, int& C) { const int st = b / 1024, sb = b % 1024, swz = sb ^ (((sb >> 9) & 1) << 5); R = (st >> 1) * 16 + swz / 64; C = (st & 1) * 32 + (swz % 64) / 2; }
__host__ __device__ __forceinline__ int perm32(int rho) { const int n = rho >> 4, i = rho & 15; return 8 * (i >> 2) + 4 * n + (i & 3); }

struct Unit { int pm, pn; };
struct Gemm { const bf16_t* A; const bf16_t* Bt; int M, N, K; };

struct StaticOrder {
    int nM, nN, nwg, G, c;
    __host__ __device__ void init(int M, int N, int G_, int c_) { nM = M / BM; nN = N / BM; nwg = nM * nN; G = G_; c = c_; }
    __host__ __device__ bool next(int i, Unit& u) const {
        const long L = (long)i * G + c; if (L >= nwg) return false;
        int wgid = (int)L; { const int q = nwg / NXCD, r = nwg % NXCD, xcd = wgid % NXCD, off = wgid / NXCD; wgid = (xcd < r ? xcd * (q + 1) : r * (q + 1) + (xcd - r) * q) + off; }
        const int nig = WGM * nN, gid = wgid / nig, fm = gid * WGM, gsz = (nM - fm) < WGM ? (nM - fm) : WGM;
        u.pm = fm + ((wgid % nig) % gsz); u.pn = (wgid % nig) / gsz; return true;
    }
    __device__ __forceinline__ void a_ready(const Unit&) const {}
    __device__ __forceinline__ void done(const Unit&) const {}
};

__device__ __forceinline__ unsigned cvt_pk_bf16(float lo, float hi) { unsigned r; asm volatile("v_cvt_pk_bf16_f32 %0, %1, %2" : "=v"(r) : "v"(lo), "v"(hi)); return r; }
typedef float f32x2 __attribute__((ext_vector_type(2)));
__device__ __forceinline__ f32x2 gelu_pk(f32x2 v) {
    const f32x2 av = __builtin_elementwise_abs(v), d = av * 0.2316418882f + 1.0f;
    f32x2 t; t.x = __builtin_amdgcn_rcpf(d.x); t.y = __builtin_amdgcn_rcpf(d.y);
    f32x2 q = t * 0.5307027145f + (-0.7265760135f); q = q * t + 0.7107068705f; q = q * t + (-0.142248368f); q = q * t + 0.127414796f; q = q * t;
    const f32x2 s = (v * v) * (-0.72134752044f);
    f32x2 e; e.x = __builtin_amdgcn_exp2f(s.x); e.y = __builtin_amdgcn_exp2f(s.y);
    const f32x2 m = v * (q * e), r = v - m;
    f32x2 o; o.x = v.x < 0.f ? m.x : r.x; o.y = v.y < 0.f ? m.y : r.y; return o;
}

template <int ACT  > struct EpiBf16 {
    static constexpr bool PERM = true, AFTER_DRAIN = false; static_assert(ACT == 0 || ACT == 1, "EpiBf16: ACT is 0 (none) or 1 (gelu_pk)");
    bf16_t* O; int ldc; const float* bias; int split_cols; size_t split_stride; float scale0;
    __device__ __forceinline__ void operator()(const f32x4 (&acc)[2][2][4][2], const Unit& u, int wr, int wc, int fr, int fq) const {
        const int row0 = u.pm * BM + wr * 64 + fr; int colt = u.pn * BM; bf16_t* base = O;
        float sc = 1.f; if (split_cols) { const int t = colt / split_cols; base += (size_t)t * split_stride; colt -= t * split_cols; if (t == 0) sc = scale0; }
        const int col0 = colt + wc * 32 + 8 * fq, bcol0 = u.pn * BM + wc * 32 + 8 * fq;
        f32x4 bv[2][2];
#pragma unroll
        for (int bj = 0; bj < 2; ++bj)
#pragma unroll
            for (int n = 0; n < 2; ++n) bv[bj][n] = bias ? *(const f32x4*)(bias + bcol0 + bj * HALF + 4 * n) : (f32x4){0.f, 0.f, 0.f, 0.f};
#pragma unroll
        for (int ai = 0; ai < 2; ++ai)
#pragma unroll
            for (int m = 0; m < 4; ++m) { bf16_t* rowp = base + (size_t)(row0 + ai * HALF + m * 16) * ldc + col0;
#pragma unroll
                for (int bj = 0; bj < 2; ++bj) { f32x4 v0 = acc[ai][bj][m][0] + bv[bj][0], v1 = acc[ai][bj][m][1] + bv[bj][1];
                    if (ACT == 1) { f32x2 a = gelu_pk((f32x2){v0[0], v0[1]}), b = gelu_pk((f32x2){v0[2], v0[3]}), c = gelu_pk((f32x2){v1[0], v1[1]}), d = gelu_pk((f32x2){v1[2], v1[3]});
                        v0 = (f32x4){a.x, a.y, b.x, b.y}; v1 = (f32x4){c.x, c.y, d.x, d.y}; }
                    v0 = v0 * sc; v1 = v1 * sc; u32x4 w; w.x = cvt_pk_bf16(v0[0], v0[1]); w.y = cvt_pk_bf16(v0[2], v0[3]); w.z = cvt_pk_bf16(v1[0], v1[1]); w.w = cvt_pk_bf16(v1[2], v1[3]);
                    *(u32x4*)(rowp + bj * HALF) = w; } }
    }
};

typedef unsigned u32x2 __attribute__((ext_vector_type(2)));
__device__ __forceinline__ float rstd_row(const float* ss, int row) {
    const float s = __hip_atomic_load(ss + row, __ATOMIC_RELAXED, __HIP_MEMORY_SCOPE_AGENT);
    return 1.0f / sqrtf(s * (1.0f / 1024.0f) + 1e-6f);
}
__device__ __forceinline__ float fast_sigmoid(float v) { return __builtin_amdgcn_rcpf(1.0f + __builtin_amdgcn_exp2f(-1.4426950408889634f * v)); }
struct EpiSwiGLU {
    static constexpr bool PERM = true, AFTER_DRAIN = false;
    bf16_t* H; const float* ss;
    __device__ __forceinline__ void operator()(const f32x4 (&acc)[2][2][4][2], const Unit& u, int wr, int wc, int fr, int fq) const {
        const int hc0 = u.pn * 128 + wc * 32 + 8 * fq;
#pragma unroll
        for (int ai = 0; ai < 2; ++ai)
#pragma unroll
            for (int m = 0; m < 4; ++m) { const int row = u.pm * BM + ai * HALF + wr * 64 + m * 16 + fr; const float rs = rstd_row(ss, row);
                float hv[8];
#pragma unroll
                for (int n = 0; n < 2; ++n)
#pragma unroll
                    for (int e = 0; e < 4; ++e) { const float g = acc[ai][0][m][n][e] * rs, uu = acc[ai][1][m][n][e] * rs; hv[4 * n + e] = g * fast_sigmoid(g) * uu; }
                u32x4 w; w.x = cvt_pk_bf16(hv[0], hv[1]); w.y = cvt_pk_bf16(hv[2], hv[3]); w.z = cvt_pk_bf16(hv[4], hv[5]); w.w = cvt_pk_bf16(hv[6], hv[7]);
                *(u32x4*)(H + (size_t)row * 2816 + hc0) = w; }
    }
};
struct EpiResid {
    static constexpr bool PERM = true, AFTER_DRAIN = false;
    const float* xin; float* xout; bf16_t* xb; float* ss; float alpha;
    __device__ __forceinline__ void operator()(const f32x4 (&acc)[2][2][4][2], const Unit& u, int wr, int wc, int fr, int fq) const {
        const int col0 = u.pn * BM + wc * 32 + 8 * fq;
#pragma unroll
        for (int ai = 0; ai < 2; ++ai)
#pragma unroll
            for (int m = 0; m < 4; ++m) { const int row = u.pm * BM + ai * HALF + wr * 64 + m * 16 + fr; const size_t off = (size_t)row * 1024 + col0; float s = 0.f;
                f32x4 xi[2][2];
#pragma unroll
                for (int bj = 0; bj < 2; ++bj) { xi[bj][0] = *(const f32x4*)(xin + off + bj * HALF); xi[bj][1] = *(const f32x4*)(xin + off + bj * HALF + 4); }
#pragma unroll
                for (int bj = 0; bj < 2; ++bj) { const f32x4 o0 = xi[bj][0] + acc[ai][bj][m][0] * alpha, o1 = xi[bj][1] + acc[ai][bj][m][1] * alpha;
                    *(f32x4*)(xout + off + bj * HALF) = o0; *(f32x4*)(xout + off + bj * HALF + 4) = o1;
                    s += (o0[0] * o0[0] + o0[1] * o0[1]) + (o0[2] * o0[2] + o0[3] * o0[3]) + (o1[0] * o1[0] + o1[1] * o1[1]) + (o1[2] * o1[2] + o1[3] * o1[3]);
                    u32x4 w; w.x = cvt_pk_bf16(o0[0], o0[1]); w.y = cvt_pk_bf16(o0[2], o0[3]); w.z = cvt_pk_bf16(o1[0], o1[1]); w.w = cvt_pk_bf16(o1[2], o1[3]);
                    *(u32x4*)(xb + off + bj * HALF) = w; }
                s += __shfl_xor(s, 16); s += __shfl_xor(s, 32);
                if (fq == 0) __hip_atomic_fetch_add(ss + row, s, __ATOMIC_RELAXED, __HIP_MEMORY_SCOPE_AGENT); }
    }
};
struct EpiQKV {
    static constexpr bool PERM = true, AFTER_DRAIN = false;
    bf16_t* Q; size_t split_stride; const float* ss; float scale0; float* nrm;
    __device__ __forceinline__ void operator()(const f32x4 (&acc)[2][2][4][2], const Unit& u, int wr, int wc, int fr, int fq) const {
        int colt = u.pn * BM; const int t = colt >> 10; bf16_t* base = Q + (size_t)t * split_stride; colt -= t << 10; const float sc = (t == 0) ? scale0 : 1.f;
        const int col0 = colt + wc * 32 + 8 * fq; float mx[2][2] = {{0.f, 0.f}, {0.f, 0.f}};
#pragma unroll
        for (int ai = 0; ai < 2; ++ai)
#pragma unroll
            for (int m = 0; m < 4; ++m) { const int row = u.pm * BM + ai * HALF + wr * 64 + m * 16 + fr; const float rs = rstd_row(ss, row) * sc; bf16_t* rowp = base + (size_t)row * 1024 + col0;
#pragma unroll
                for (int bj = 0; bj < 2; ++bj) { const f32x4 v0 = acc[ai][bj][m][0] * rs, v1 = acc[ai][bj][m][1] * rs;
                    { float q = (v0[0] * v0[0] + v0[1] * v0[1]) + (v0[2] * v0[2] + v0[3] * v0[3]) + (v1[0] * v1[0] + v1[1] * v1[1]) + (v1[2] * v1[2] + v1[3] * v1[3]);
                      q += __shfl_xor(q, 16); q += __shfl_xor(q, 32); mx[ai][bj] = fmaxf(mx[ai][bj], q); }
                    u32x4 w; w.x = cvt_pk_bf16(v0[0], v0[1]); w.y = cvt_pk_bf16(v0[2], v0[3]); w.z = cvt_pk_bf16(v1[0], v1[1]); w.w = cvt_pk_bf16(v1[2], v1[3]);
                    *(u32x4*)(rowp + bj * HALF) = w; } }
        if (t < 2) {
#pragma unroll
            for (int ai = 0; ai < 2; ++ai)
#pragma unroll
                for (int bj = 0; bj < 2; ++bj) { float q = mx[ai][bj]; q = fmaxf(q, __shfl_xor(q, 1)); q = fmaxf(q, __shfl_xor(q, 2)); q = fmaxf(q, __shfl_xor(q, 4)); q = fmaxf(q, __shfl_xor(q, 8));
                    const int head = (colt + bj * HALF + wc * 32) >> 6, rt = (u.pm * BM + ai * HALF + wr * 64) >> 6;
                    if (fr == 0 && fq == 0) nrm[(((size_t)t * 16 + head) * 256 + rt) * 2 + (wc & 1)] = q; } }
    }
};
__device__ __forceinline__ float gelu_tanh(float v) { const float u2 = 1.5957691216057308f * (v + 0.044715f * v * v * v); return v * fast_sigmoid(u2); }
struct EpiLruIn {
    static constexpr bool PERM = true, AFTER_DRAIN = false;
    bf16_t* GATE; bf16_t* REC; const float* ss;
    __device__ __forceinline__ void operator()(const f32x4 (&acc)[2][2][4][2], const Unit& u, int wr, int wc, int fr, int fq) const {
        const bool isg = u.pn < 5; bf16_t* base = isg ? GATE : REC; const int col0 = (isg ? u.pn : u.pn - 5) * BM + wc * 32 + 8 * fq;
#pragma unroll
        for (int ai = 0; ai < 2; ++ai)
#pragma unroll
            for (int m = 0; m < 4; ++m) { const int row = u.pm * BM + ai * HALF + wr * 64 + m * 16 + fr; const float rs = rstd_row(ss, row); bf16_t* rowp = base + (size_t)row * 1280 + col0;
#pragma unroll
                for (int bj = 0; bj < 2; ++bj) { f32x4 v0 = acc[ai][bj][m][0] * rs, v1 = acc[ai][bj][m][1] * rs;
                    if (isg) {
#pragma unroll
                        for (int e = 0; e < 4; ++e) { v0[e] = gelu_tanh(v0[e]); v1[e] = gelu_tanh(v1[e]); } }
                    u32x4 w; w.x = cvt_pk_bf16(v0[0], v0[1]); w.y = cvt_pk_bf16(v0[2], v0[3]); w.z = cvt_pk_bf16(v1[0], v1[1]); w.w = cvt_pk_bf16(v1[2], v1[3]);
                    *(u32x4*)(rowp + bj * HALF) = w; } }
    }
};
template <class Epi, class Sched, bool ALIGN_EPI = false, bool SP2 = false>
__device__ __forceinline__ void gemm_phase(PG8_LAS unsigned char* lds, const Gemm g, const Sched& S, const Epi& E) {
    const int tid = otid(), wid = __builtin_amdgcn_readfirstlane(tid >> 6), lane = tid & 63, wr = wid >> 2, wc = wid & 3, fr = lane & 15, fq = lane >> 4;
    const int K = g.K, nt = K / BK;
    unsigned voffA[2], voffB[2];
#pragma unroll
    for (int i = 0; i < 2; ++i) { int R, C; stage_rc(tid * 16 + i * 8192, R, C); const int Rb = Epi::PERM ? ((R & ~31) + perm32(R & 31)) : R;
        voffA[i] = (unsigned)(R * K + C) * 2u; voffB[i] = (unsigned)(Rb * K + C) * 2u; }
    const size_t kstep = (size_t)(BK * 2);
    const size_t hstep = (size_t)HALF * K * 2;
    const size_t tstep = 2 * hstep;
    const unsigned ldsw = (unsigned)wid * 1024u;
    const int aoff = lds_byte(wr * 64 + fr, fq * 8), boff = lds_byte(wc * 32 + fr, fq * 8);
#define PG8_SA(b, h) (((b) * 2 + (h)) * HTB)
#define PG8_SB(b, h) ((4 + (b) * 2 + (h)) * HTB)
#define PG8_STAGE(bufoff, gbase, voff) do { _Pragma("unroll") for (int _i = 0; _i < 2; ++_i) \
        __builtin_amdgcn_global_load_lds((const unsigned*)((const char*)(gbase) + (voff)[_i]), (PG8_LAS unsigned*)(lds + (bufoff) + ldsw + _i * 8192), 16, 0, 0); } while (0)
#define PG8_LDA(dst, b, h) do { _Pragma("unroll") for (int m = 0; m < 4; ++m) _Pragma("unroll") for (int k = 0; k < 2; ++k) dst[m][k] = *(const PG8_LAS bf16x8*)(lds + PG8_SA(b, h) + aoff + m * 2048 + k * 1024); } while (0)
#define PG8_LDB(dst, b, h) do { _Pragma("unroll") for (int n = 0; n < 2; ++n) _Pragma("unroll") for (int k = 0; k < 2; ++k) dst[n][k] = *(const PG8_LAS bf16x8*)(lds + PG8_SB(b, h) + boff + n * 2048 + k * 1024); } while (0)
#define PG8_MMA(ai, bj, At, Bt) do { __builtin_amdgcn_s_setprio(1); _Pragma("unroll") for (int m = 0; m < 4; ++m) _Pragma("unroll") for (int n = 0; n < 2; ++n) _Pragma("unroll") for (int k = 0; k < 2; ++k) \
        acc[ai][bj][m][n] = __builtin_amdgcn_mfma_f32_16x16x32_bf16(Bt[n][k], At[m][k], acc[ai][bj][m][n], 0, 0, 0); __builtin_amdgcn_s_setprio(0); } while (0)
#define PG8_WAIT_V(n) asm volatile("s_waitcnt vmcnt(" #n ")" ::: "memory")
#define PG8_WAIT_L(n) asm volatile("s_waitcnt lgkmcnt(" #n ")" ::: "memory")
#define PG8_BAR __builtin_amdgcn_s_barrier()
#define PG8_SCHED __builtin_amdgcn_sched_barrier(0)
    Unit cur, nxt; int ui = 0;
    if (!S.next(0, cur)) return;
    f32x4 acc[2][2][4][2];
#pragma unroll
    for (int a = 0; a < 2; ++a)
#pragma unroll
        for (int b = 0; b < 2; ++b)
#pragma unroll
            for (int m = 0; m < 4; ++m)
#pragma unroll
                for (int n = 0; n < 2; ++n) acc[a][b][m][n] = (f32x4){0.f, 0.f, 0.f, 0.f};
    bf16x8 At[4][2], B0[2][2], B1[2][2];
    const char* cA = (const char*)g.A + (size_t)cur.pm * tstep; const char* cB = (const char*)g.Bt + (size_t)cur.pn * tstep;
    S.a_ready(cur);
    if constexpr (SP2) {
        PG8_STAGE(PG8_SB(0, 0), cB, voffB); PG8_STAGE(PG8_SB(0, 1), cB + hstep, voffB); PG8_STAGE(PG8_SA(0, 0), cA, voffA); PG8_STAGE(PG8_SA(0, 1), cA + hstep, voffA);
        if (wr == 1) PG8_BAR;
        PG8_WAIT_V(2); PG8_BAR;
        PG8_STAGE(PG8_SB(1, 0), cB + kstep, voffB); PG8_STAGE(PG8_SA(1, 0), cA + kstep, voffA); PG8_STAGE(PG8_SB(1, 1), cB + hstep + kstep, voffB);
        PG8_WAIT_V(6); PG8_BAR;
    } else {
        PG8_STAGE(PG8_SB(0, 0), cB, voffB); PG8_STAGE(PG8_SA(0, 0), cA, voffA); PG8_STAGE(PG8_SB(0, 1), cB + hstep, voffB); PG8_STAGE(PG8_SA(0, 1), cA + hstep, voffA);
        if (wr == 1) PG8_BAR;
        PG8_WAIT_V(4); PG8_BAR;
        PG8_STAGE(PG8_SB(1, 0), cB + kstep, voffB); PG8_STAGE(PG8_SA(1, 0), cA + kstep, voffA); PG8_STAGE(PG8_SB(1, 1), cB + hstep + kstep, voffB);
        PG8_WAIT_V(6); PG8_BAR;
    }
    for (;;) {
        const bool has_next = S.next(ui + 1, nxt);
        const char* nA = has_next ? (const char*)g.A + (size_t)nxt.pm * tstep : cA; const char* nB = has_next ? (const char*)g.Bt + (size_t)nxt.pn * tstep : cB;
        for (int t = 0; t < nt; t += 2) {
            const bool last = (t == nt - 2);
            const char* a1 = cA + (size_t)(t + 1) * kstep;
            const char* a2 = last ? nA : cA + (size_t)(t + 2) * kstep; const char* b2 = last ? nB : cB + (size_t)(t + 2) * kstep;
            const char* a3 = a2 + kstep; const char* b3 = b2 + kstep;
            if (last && has_next) S.a_ready(nxt);
            if constexpr (SP2) {
            PG8_LDB(B0, 0, 0); PG8_LDB(B1, 0, 1); PG8_SCHED; PG8_LDA(At, 0, 0); PG8_STAGE(PG8_SA(1, 1), a1 + hstep, voffA);
            PG8_WAIT_V(8); PG8_WAIT_L(0); PG8_BAR; PG8_MMA(0, 0, At, B0); PG8_MMA(0, 1, At, B1); PG8_BAR; PG8_SCHED;
            PG8_LDA(At, 0, 1); PG8_STAGE(PG8_SB(0, 0), b2, voffB); PG8_STAGE(PG8_SB(0, 1), b2 + hstep, voffB); PG8_STAGE(PG8_SA(0, 0), a2, voffA);
            PG8_WAIT_V(8); PG8_WAIT_L(0); PG8_BAR; PG8_MMA(1, 0, At, B0); PG8_MMA(1, 1, At, B1); PG8_BAR; PG8_SCHED;
            PG8_LDB(B0, 1, 0); PG8_LDB(B1, 1, 1); PG8_SCHED; PG8_LDA(At, 1, 0); PG8_STAGE(PG8_SA(0, 1), a2 + hstep, voffA);
            PG8_WAIT_V(8); PG8_WAIT_L(0); PG8_BAR; PG8_MMA(0, 0, At, B0); PG8_MMA(0, 1, At, B1); PG8_BAR; PG8_SCHED;
            PG8_LDA(At, 1, 1); PG8_STAGE(PG8_SB(1, 0), b3, voffB); PG8_STAGE(PG8_SB(1, 1), b3 + hstep, voffB); PG8_STAGE(PG8_SA(1, 0), a3, voffA);
            PG8_WAIT_V(8); PG8_WAIT_L(0); PG8_BAR; PG8_MMA(1, 0, At, B0); PG8_MMA(1, 1, At, B1); PG8_BAR; PG8_SCHED;
            } else {
            PG8_LDB(B0, 0, 0); PG8_SCHED; PG8_LDA(At, 0, 0); PG8_STAGE(PG8_SA(1, 1), a1 + hstep, voffA);
            PG8_WAIT_L(8); PG8_BAR; PG8_WAIT_L(0); PG8_MMA(0, 0, At, B0); PG8_BAR; PG8_SCHED;
            PG8_LDB(B1, 0, 1); PG8_STAGE(PG8_SB(0, 0), b2, voffB);
            PG8_BAR; PG8_WAIT_L(0); PG8_MMA(0, 1, At, B1); PG8_BAR;
            PG8_LDA(At, 0, 1); PG8_STAGE(PG8_SA(0, 0), a2, voffA);
            PG8_BAR; PG8_WAIT_L(0); PG8_MMA(1, 0, At, B0); PG8_BAR; PG8_SCHED;
            PG8_STAGE(PG8_SB(0, 1), b2 + hstep, voffB);
            PG8_WAIT_V(6); PG8_BAR; PG8_MMA(1, 1, At, B1); PG8_BAR;
            PG8_LDB(B0, 1, 0); PG8_SCHED; PG8_LDA(At, 1, 0); PG8_STAGE(PG8_SA(0, 1), a2 + hstep, voffA);
            PG8_WAIT_L(8); PG8_BAR; PG8_WAIT_L(0); PG8_MMA(0, 0, At, B0); PG8_BAR; PG8_SCHED;
            PG8_LDB(B1, 1, 1); PG8_STAGE(PG8_SB(1, 0), b3, voffB);
            PG8_BAR; PG8_WAIT_L(0); PG8_MMA(0, 1, At, B1); PG8_BAR;
            PG8_LDA(At, 1, 1); PG8_STAGE(PG8_SA(1, 0), a3, voffA);
            PG8_BAR; PG8_WAIT_L(0); PG8_MMA(1, 0, At, B0); PG8_BAR; PG8_SCHED;
            PG8_STAGE(PG8_SB(1, 1), b3 + hstep, voffB);
            PG8_WAIT_V(6); PG8_BAR; PG8_MMA(1, 1, At, B1); PG8_BAR;
            }
        }
        if constexpr (ALIGN_EPI) { if (wr == 0) PG8_BAR; }
        if constexpr (!Epi::AFTER_DRAIN) { E(acc, cur, wr, wc, fr, fq); S.done(cur); }
        if (!has_next) break;
#pragma unroll
        for (int a = 0; a < 2; ++a)
#pragma unroll
            for (int b = 0; b < 2; ++b)
#pragma unroll
                for (int m = 0; m < 4; ++m)
#pragma unroll
                    for (int n = 0; n < 2; ++n) acc[a][b][m][n] = (f32x4){0.f, 0.f, 0.f, 0.f};
        cur = nxt; cA = nA; cB = nB; ++ui;
        if constexpr (ALIGN_EPI) { if (wr == 1) PG8_BAR; }
    }
    PG8_WAIT_V(0);
    if constexpr (!ALIGN_EPI) { if (wr == 0) PG8_BAR; }
    PG8_BAR;
    if constexpr (Epi::AFTER_DRAIN) { E.fused(acc, cur, wr, wc, fr, fq, lds, wid, lane); S.done(cur); }
#undef PG8_SA
#undef PG8_SB
#undef PG8_STAGE
#undef PG8_LDA
#undef PG8_LDB
#undef PG8_MMA
#undef PG8_WAIT_V
#undef PG8_WAIT_L
#undef PG8_BAR
#undef PG8_SCHED
}
}

#ifndef PG8_SP2
#define PG8_SP2 true
#endif
#ifndef PG8_ALIGN
#define PG8_ALIGN true
#endif
#include <hip/hip_bf16.h>
#include <cmath>
namespace attn_body {
using bf16=__hip_bfloat16;
using bf16x8=__attribute__((ext_vector_type(8)))short;
using s16x4=__attribute__((ext_vector_type(4)))short;
using f32x16=__attribute__((ext_vector_type(16)))float;
using u32x4=__attribute__((ext_vector_type(4)))unsigned;
constexpr int BATCH=2,NHEAD=16,SEQ=8192,D=64,DM=NHEAD*D;
constexpr int NW=8,QBLK=32,QB=QBLK*NW,KVBLK=64,NQB=SEQ/QB;
constexpr int ATTN_PITCH=DM, ATTN_UNIT_ROWS=QB;
__device__ __forceinline__ int crow(int r,int hi){return (r&3)+8*(r>>2)+4*hi;}
#define SBAR() __builtin_amdgcn_sched_barrier(0)
__device__ __forceinline__ void cmask(f32x16&p0,f32x16&p1,int jb,int qrel,int hi){
  const float NEG=-INFINITY; int kb=64*jb+4*hi;
  #pragma unroll
  for(int r=0;r<16;++r){int kv=kb+(r&3)+8*(r>>2); if(kv>qrel)p0[r]=NEG; if(kv+32>qrel)p1[r]=NEG;}
}

constexpr int NSLOT=3, SLOTB=8192;
constexpr int LDS_K=0, LDS_V=NSLOT*SLOTB, LDS_WS=2*NSLOT*SLOTB, LDS_OST=LDS_WS+NW*64*4, LDS_BYTES=LDS_OST+NW*4096;
constexpr float C2=0.125f*1.4426950408889634f;
__device__ __forceinline__ void glds16(const void*gsrc,unsigned lds_dst){unsigned keep;
  asm volatile("s_mov_b32 %0, m0\n\ts_mov_b32 m0, %2\n\ts_nop 0\n\tglobal_load_lds_dwordx4 %1, off\n\ts_mov_b32 m0, %0":"=&s"(keep):"v"(gsrc),"s"(lds_dst):"memory");}
__device__ __forceinline__ float max3f(float a,float b,float c){float r;asm("v_max3_f32 %0, %1, %2, %3":"=v"(r):"v"(a),"v"(b),"v"(c));return r;}
__device__ __forceinline__ float max2f(float a,float b){float r;asm("v_max_f32_e32 %0, %1, %2":"=v"(r):"v"(a),"v"(b));return r;}
__device__ __forceinline__ float fadd_s(float a,float b){float r;asm("v_add_f32_e32 %0, %1, %2":"=v"(r):"v"(a),"v"(b));return r;}
__device__ __forceinline__ float fsub_s(float a,float b){float r;asm("v_sub_f32_e32 %0, %1, %2":"=v"(r):"v"(a),"v"(b));return r;}
typedef float f32x2_t __attribute__((ext_vector_type(2))); typedef __bf16 bf16x2_t __attribute__((ext_vector_type(2)));
__device__ __forceinline__ unsigned cvtpk_s(float lo,float hi){f32x2_t v={lo,hi};bf16x2_t b=__builtin_convertvector(v,bf16x2_t);return __builtin_bit_cast(unsigned,b);}
#define WAIT_BAR(N) asm volatile("s_waitcnt vmcnt(" #N ") lgkmcnt(0)\n\ts_barrier":::"memory")

typedef __attribute__((address_space(3))) const float* lds_fptr; typedef float f32x4_t __attribute__((ext_vector_type(4))); typedef __attribute__((address_space(3))) const f32x4_t* lds_f4ptr;
__device__ __forceinline__ void qkt(f32x16&p0,f32x16&p1,const char*Kslot,const bf16x8*qr,int r32,int hi){
  const char*kb=Kslot+hi*1024+r32*16;
  #pragma unroll
  for(int d0=0;d0<4;++d0){
    const bf16x8 b0=*reinterpret_cast<const bf16x8*>(kb+d0*2048);
    const bf16x8 b1=*reinterpret_cast<const bf16x8*>(kb+d0*2048+512);
    p0=__builtin_amdgcn_mfma_f32_32x32x16_bf16(b0,qr[d0],p0,0,0,0);p1=__builtin_amdgcn_mfma_f32_32x32x16_bf16(b1,qr[d0],p1,0,0,0);}
}
typedef __attribute__((address_space(3))) const char* lds_cptr;
typedef short v4i16_t __attribute__((ext_vector_type(4)));
__device__ __forceinline__ void kload8(bf16x8*kf,lds_cptr kp){
  kf[0]=*(const __attribute__((address_space(3))) bf16x8*)(kp);      kf[1]=*(const __attribute__((address_space(3))) bf16x8*)(kp+512);
  kf[2]=*(const __attribute__((address_space(3))) bf16x8*)(kp+2048); kf[3]=*(const __attribute__((address_space(3))) bf16x8*)(kp+2560);
  kf[4]=*(const __attribute__((address_space(3))) bf16x8*)(kp+4096); kf[5]=*(const __attribute__((address_space(3))) bf16x8*)(kp+4608);
  kf[6]=*(const __attribute__((address_space(3))) bf16x8*)(kp+6144); kf[7]=*(const __attribute__((address_space(3))) bf16x8*)(kp+6656);
}
__device__ __forceinline__ void kload2(bf16x8*kf,lds_cptr kp,int j){ kf[2*j]=*(const __attribute__((address_space(3))) bf16x8*)(kp+j*2048); kf[2*j+1]=*(const __attribute__((address_space(3))) bf16x8*)(kp+j*2048+512); }
__device__ __forceinline__ s16x4 vtr(lds_cptr p){ return __builtin_bit_cast(s16x4,__builtin_amdgcn_ds_read_tr16_b64_v4i16((__attribute__((address_space(3))) v4i16_t*)p)); }
__device__ __forceinline__ float rowmax(const f32x16&p0,const f32x16&p1){
  float a=max3f(p0[0],p0[1],p1[0]),b=max3f(p0[2],p0[3],p1[1]);a=max3f(a,p1[2],p1[3]);
  #pragma unroll
  for(int r=4;r<16;r+=4){a=max3f(a,p0[r],p0[r+1]);b=max3f(b,p0[r+2],p0[r+3]);a=max3f(a,p1[r],p1[r+1]);b=max3f(b,p1[r+2],p1[r+3]);}
  const float m=max2f(a,b);
  auto rr=__builtin_amdgcn_permlane32_swap(__float_as_uint(m),__float_as_uint(m),false,false);
  return max2f(__uint_as_float(rr[0]),__uint_as_float(rr[1]));
}
__device__ __forceinline__ void pv(f32x16*o,int vb,bf16x8 pa0,bf16x8 pa1,bf16x8 pa2,bf16x8 pa3){
  #pragma unroll
  for(int d0=0;d0<2;++d0){s16x4 lo[4],hi[4];
    #pragma unroll
    for(int ks=0;ks<4;++ks){
      asm volatile("ds_read_b64_tr_b16 %0,%1 offset:%c2":"=&v"(lo[ks]):"v"(vb),"i"(d0*4096+ks*1024):"memory");
      asm volatile("ds_read_b64_tr_b16 %0,%1 offset:%c2":"=&v"(hi[ks]):"v"(vb),"i"(d0*4096+ks*1024+512):"memory");}
    asm volatile("s_waitcnt lgkmcnt(0)":::"memory");SBAR();
    #define PK(k) (bf16x8){lo[k][0],lo[k][1],lo[k][2],lo[k][3],hi[k][0],hi[k][1],hi[k][2],hi[k][3]}
    o[d0]=__builtin_amdgcn_mfma_f32_32x32x16_bf16(pa0,PK(0),o[d0],0,0,0);
    o[d0]=__builtin_amdgcn_mfma_f32_32x32x16_bf16(pa1,PK(1),o[d0],0,0,0);
    o[d0]=__builtin_amdgcn_mfma_f32_32x32x16_bf16(pa2,PK(2),o[d0],0,0,0);
    o[d0]=__builtin_amdgcn_mfma_f32_32x32x16_bf16(pa3,PK(3),o[d0],0,0,0);
    #undef PK
  }
}

#ifndef ATTN_STORE16
#define ATTN_STORE16(p,v) (*(u32x4*)(p)=(v))
#endif
template<int THRL> __device__ __forceinline__ void attn_unit(int b,int h,int qb,const bf16*Q,const bf16*__restrict__ K,const bf16*__restrict__ V,bf16*O,char*shm,lds_fptr Gp,int tstart){
  const int tid=otid(),lane=tid&63,r32=lane&31,hi=lane>>5; const int wid=__builtin_amdgcn_readfirstlane(tid>>6);
  const long rowbase=(long)b*SEQ; const int q0=qb*QB;
  const bf16*Qw=Q+(rowbase+q0+wid*QBLK)*DM+h*D;
  const bf16*Kh=K+(rowbase+(long)tstart*KVBLK)*DM+h*D,*Vh=V+(rowbase+(long)tstart*KVBLK)*DM+h*D; const lds_fptr Gk=Gp+KVBLK*tstart;
  const unsigned lds0=(unsigned)(uintptr_t)shm;
  float*wsf=(float*)(shm+LDS_WS)+wid*64;
  const bf16*ksrc=Kh+(long)lane*DM+wid*8;
  const bf16*vsrc=Vh+(long)(16*(wid&3)+(lane>>2))*DM+(wid>>2)*32+(lane&3)*8;
  const unsigned kdst=lds0+LDS_K+wid*1024, vdst=lds0+LDS_V+wid*1024;
  #define DMA_K(t,slot) glds16(ksrc+(long)(t)*KVBLK*DM,(unsigned)__builtin_amdgcn_readfirstlane(kdst+(slot)))
  #define DMA_V(t,slot) glds16(vsrc+(long)(t)*KVBLK*DM,(unsigned)__builtin_amdgcn_readfirstlane(vdst+(slot)))
  const int vb0=(int)(lds0+LDS_V)+((lane>>4)&1)*32+(lane&3)*8+(4*hi+((lane&15)>>2))*64;
  const char*Kbase=shm+LDS_K; bf16x8 kf[8];
  const lds_cptr shm3=(lds_cptr)shm; const lds_cptr kp0=shm3+LDS_K+hi*1024+r32*16; const lds_cptr vp0=shm3+LDS_V+((lane>>4)&1)*32+(lane&3)*8+(4*hi+((lane&15)>>2))*64;
  const int NT=(q0+QB)/KVBLK-tstart;
  DMA_K(0,0);DMA_V(0,0);DMA_K(1,SLOTB);
  bf16x8 qr[4];
  #pragma unroll
  for(int d0=0;d0<4;++d0)qr[d0]=*reinterpret_cast<const bf16x8*>(&Qw[(long)r32*DM+d0*16+hi*8]);
  float mhat=0.f,l_reg=0.f;f32x16 o[2];o[0]=f32x16{};o[1]=f32x16{};
  const float Gq=Gp[q0+wid*QBLK+r32]; float negmq=Gq;
  #define BIAS_LD(X0,X1,t) do{ const lds_f4ptr gp_=(lds_f4ptr)(Gk+64*(t)+4*hi); _Pragma("unroll") for(int j_=0;j_<4;++j_){ const f32x4_t a_=gp_[2*j_], b_=gp_[8+2*j_]; \
      X0[4*j_]=a_[0];X0[4*j_+1]=a_[1];X0[4*j_+2]=a_[2];X0[4*j_+3]=a_[3]; X1[4*j_]=b_[0];X1[4*j_+1]=b_[1];X1[4*j_+2]=b_[2];X1[4*j_+3]=b_[3]; } }while(0)
  #define BSUB4(X,B) do{ X[B]=negmq-X[B]; X[(B)+1]=negmq-X[(B)+1]; X[(B)+2]=negmq-X[(B)+2]; X[(B)+3]=negmq-X[(B)+3]; }while(0)
  #define BSUBALL(X0,X1) do{ _Pragma("unroll") for(int r_=0;r_<16;++r_){ X0[r_]=negmq-X0[r_]; X1[r_]=negmq-X1[r_]; } }while(0)
  const int qrel=wid*QBLK+r32;
  #define CMASK(P0,P1,t) do{int jb_=(t)-(NT-4); if(jb_>=0)cmask(P0,P1,jb_,qrel,hi);}while(0)
  bool resc=false;
  #define START(P0,P1) do{ const float rm=rowmax(P0,P1); resc=false; \
    { const float dl=__builtin_fmaxf(rm,-40.f); mhat=fadd_s(mhat,dl); \
      _Pragma("unroll") for(int r=0;r<16;++r){P0[r]=fsub_s(P0[r],dl);P1[r]=fsub_s(P1[r],dl);} \
      negmq=Gq-mhat; } \
    _Pragma("unroll") for(int r=0;r<16;++r)P0[r]=__builtin_amdgcn_exp2f(P0[r]); }while(0)
  #define RESC() do{ if(resc){ asm volatile("s_waitcnt lgkmcnt(0)":::"memory"); \
      _Pragma("unroll") for(int d_=0;d_<2;++d_) _Pragma("unroll") for(int r=0;r<16;++r)o[d_][r]*=wsf[crow(r,hi)]; } }while(0)
  f32x16 pA0,pA1,pB0,pB1;
  int sl_prev=0,sl_cur=0,sl_next=SLOTB;
  #define ROT() do{sl_prev=sl_cur;sl_cur=sl_next;sl_next=(sl_next==(NSLOT-1)*SLOTB)?0:sl_next+SLOTB;}while(0)
  DMA_K(2,2*SLOTB);
  WAIT_BAR(3);
  BIAS_LD(pA0,pA1,0); BSUBALL(pA0,pA1);
  qkt(pA0,pA1,Kbase,qr,r32,hi);asm volatile("s_nop 15\n\ts_nop 7":"+v"(pA0),"+v"(pA1));CMASK(pA0,pA1,0);
  START(pA0,pA1);
  _Pragma("unroll") for(int r=0;r<16;++r)pA1[r]=__builtin_amdgcn_exp2f(pA1[r]);
  BIAS_LD(pB0,pB1,1); BSUBALL(pB0,pB1);
  WAIT_BAR(0);
  DMA_K(3,0);DMA_V(1,SLOTB);
  ROT();
  kload8(kf,kp0+sl_cur);
  WAIT_BAR(2);
  s16x4 vlo[8],vhi[8]; u32x4 pw0,pw1,pw2,pw3;
  #define PKW(P,B) cvtpk_s(P[B],P[B+1])
  #define PAF(k) __builtin_bit_cast(bf16x8,pw##k)
  #define VFR(i) (bf16x8){vlo[i][0],vlo[i][1],vlo[i][2],vlo[i][3],vhi[i][0],vhi[i][1],vhi[i][2],vhi[i][3]}
  #define PIN(x) asm volatile("":"+v"(x))
  #define MX3(a,b,c) __builtin_fmaxf(__builtin_fmaxf((a),(b)),(c))
  #define GAPA(MF,A0,A1,A2,A3,W0,W1,PW) do{ MF; sacc+=A0; sacc+=A1; sacc+=A2; sacc+=A3; PIN(sacc); W0; W1; PIN(PW); SBAR(); }while(0)
  #define EX(v) __builtin_amdgcn_exp2f(v)
  #define GAPB(MF,X,B,GL_,Y,YB) do{ MF; X[B]=EX(X[B]); X[B+1]=EX(X[B+1]); X[B+2]=EX(X[B+2]); X[B+3]=EX(X[B+3]); PIN(X); if(GL_){ BSUB4(Y,YB); PIN(Y); } SBAR(); }while(0)
  #define VRD(i) do{ vlo[i]=vtr(vp_+(((i)>>2)*4096+((i)&3)*1024)); vhi[i]=vtr(vp_+(((i)>>2)*4096+((i)&3)*1024+512)); }while(0)
  #define KRD(G,j) do{ if(G){ kload2(kf,kp0+sl_next,j); SBAR(); } }while(0)
  #define STEP(C0,C1,P0,P1,t,GK,GV,GL) do{ SBAR(); \
    const lds_cptr vp_=vp0+sl_prev; \
    VRD(0); SBAR(); float sacc=(P0[0]+P0[1]); \
    GAPA(C0=__builtin_amdgcn_mfma_f32_32x32x16_bf16(kf[0],qr[0],C0,0,0,0), P0[2],P0[3],P0[4],P0[5],     pw0[0]=PKW(P0,0), pw0[1]=PKW(P0,2), pw0); \
    VRD(4); SBAR(); GAPA(C1=__builtin_amdgcn_mfma_f32_32x32x16_bf16(kf[1],qr[0],C1,0,0,0), P0[6],P0[7],P0[8],P0[9],     pw0[2]=PKW(P0,4), pw0[3]=PKW(P0,6), pw0); \
    VRD(1); SBAR(); GAPA(C0=__builtin_amdgcn_mfma_f32_32x32x16_bf16(kf[2],qr[1],C0,0,0,0),   P0[10],P0[11],P0[12],P0[13], pw1[0]=PKW(P0,8), pw1[1]=PKW(P0,10), pw1); \
    VRD(5); SBAR(); GAPA(C1=__builtin_amdgcn_mfma_f32_32x32x16_bf16(kf[3],qr[1],C1,0,0,0),   P0[14],P0[15],P1[0],P1[1],   pw1[2]=PKW(P0,12),pw1[3]=PKW(P0,14), pw1); \
    VRD(2); SBAR(); GAPA(C0=__builtin_amdgcn_mfma_f32_32x32x16_bf16(kf[4],qr[2],C0,0,0,0),   P1[2],P1[3],P1[4],P1[5],     pw2[0]=PKW(P1,0), pw2[1]=PKW(P1,2), pw2); \
    VRD(6); SBAR(); GAPA(C1=__builtin_amdgcn_mfma_f32_32x32x16_bf16(kf[5],qr[2],C1,0,0,0),   P1[6],P1[7],P1[8],P1[9],     pw2[2]=PKW(P1,4), pw2[3]=PKW(P1,6), pw2); \
    VRD(3); SBAR(); GAPA(C0=__builtin_amdgcn_mfma_f32_32x32x16_bf16(kf[6],qr[3],C0,0,0,0),   P1[10],P1[11],P1[12],P1[13], pw3[0]=PKW(P1,8), pw3[1]=PKW(P1,10), pw3); \
    VRD(7); SBAR(); GAPA(C1=__builtin_amdgcn_mfma_f32_32x32x16_bf16(kf[7],qr[3],C1,0,0,0),   P1[14],P1[15],0.f,0.f,       pw3[2]=PKW(P1,12),pw3[3]=PKW(P1,14), pw3); \
    l_reg+=sacc; \
    if(GK){DMA_K((t)+3,sl_cur);} if(GV){DMA_V((t)+1,sl_next);} \
    CMASK(C0,C1,t); \
    { float a=MX3(C0[0],C0[1],C1[0]),b=MX3(C0[2],C0[3],C1[1]); a=MX3(a,C1[2],C1[3]); \
      _Pragma("unroll") for(int r=4;r<16;r+=4){a=MX3(a,C0[r],C0[r+1]);b=MX3(b,C0[r+2],C0[r+3]);a=MX3(a,C1[r],C1[r+1]);b=MX3(b,C1[r+2],C1[r+3]);} \
      float rm=__builtin_fmaxf(a,b); { auto rr=__builtin_amdgcn_permlane32_swap(__float_as_uint(rm),__float_as_uint(rm),false,false); rm=__builtin_fmaxf(__uint_as_float(rr[0]),__uint_as_float(rr[1])); } \
      resc=false; \
      if(__builtin_expect(__any(rm>(float)THRL),0)){ const float dl=__builtin_fmaxf(rm,0.f); mhat+=dl; \
        _Pragma("unroll") for(int r=0;r<16;++r){C0[r]-=dl;C1[r]-=dl;} \
        negmq=Gq-mhat; \
        const float f=__builtin_amdgcn_exp2f(-dl); l_reg*=f; if(hi==0)wsf[r32]=f; resc=true; } } \
    if(GL){ BIAS_LD(P0,P1,(t)+1); } \
    SBAR(); \
    GAPB(o[0]=__builtin_amdgcn_mfma_f32_32x32x16_bf16(PAF(0),VFR(0),o[0],0,0,0), C0,0, GL,P0,0); \
    GAPB(o[1]=__builtin_amdgcn_mfma_f32_32x32x16_bf16(PAF(0),VFR(4),o[1],0,0,0), C0,4, GL,P0,4); \
    KRD(GL,0); GAPB(o[0]=__builtin_amdgcn_mfma_f32_32x32x16_bf16(PAF(1),VFR(1),o[0],0,0,0), C0,8, GL,P0,8); \
    KRD(GL,1); GAPB(o[1]=__builtin_amdgcn_mfma_f32_32x32x16_bf16(PAF(1),VFR(5),o[1],0,0,0), C0,12, GL,P0,12); \
    KRD(GL,2); GAPB(o[0]=__builtin_amdgcn_mfma_f32_32x32x16_bf16(PAF(2),VFR(2),o[0],0,0,0), C1,0, GL,P1,0); \
    KRD(GL,3); GAPB(o[1]=__builtin_amdgcn_mfma_f32_32x32x16_bf16(PAF(2),VFR(6),o[1],0,0,0), C1,4, GL,P1,4); \
    GAPB(o[0]=__builtin_amdgcn_mfma_f32_32x32x16_bf16(PAF(3),VFR(3),o[0],0,0,0), C1,8, GL,P1,8); \
    GAPB(o[1]=__builtin_amdgcn_mfma_f32_32x32x16_bf16(PAF(3),VFR(7),o[1],0,0,0), C1,12, GL,P1,12); \
    }while(0)
  int t=1;
  #undef CMASK
  #define CMASK(P0,P1,t) do{}while(0)
  for(;t+5<NT;t+=2){
    STEP(pB0,pB1,pA0,pA1,t,true,true,true);     WAIT_BAR(2); RESC(); ROT();
    STEP(pA0,pA1,pB0,pB1,t+1,true,true,true);   WAIT_BAR(2); RESC(); ROT();
  }
  #undef CMASK
  #define CMASK(P0,P1,t) do{int jb_=(t)-(NT-4); if(jb_>=0)cmask(P0,P1,jb_,qrel,hi);}while(0)
  #define ENDW(tt) do{ if((tt)+3<NT){WAIT_BAR(2);} else if((tt)+2<NT){WAIT_BAR(1);} else {WAIT_BAR(0);} }while(0)
  for(;t+1<NT;t+=2){
    STEP(pB0,pB1,pA0,pA1,t,(t+3<NT),(t+1<NT),(t+1<NT));       ENDW(t);   RESC(); ROT();
    STEP(pA0,pA1,pB0,pB1,t+1,(t+4<NT),(t+2<NT),(t+2<NT));     ENDW(t+1); RESC(); ROT();
  }
  STEP(pB0,pB1,pA0,pA1,NT-1,false,false,false); RESC();
  { float sacc=pB0[0]+pB0[1]; _Pragma("unroll") for(int r=2;r<16;++r)sacc+=pB0[r]; _Pragma("unroll") for(int r=0;r<16;++r)sacc+=pB1[r]; l_reg+=sacc;
    pw0=(u32x4){PKW(pB0,0),PKW(pB0,2),PKW(pB0,4),PKW(pB0,6)};pw1=(u32x4){PKW(pB0,8),PKW(pB0,10),PKW(pB0,12),PKW(pB0,14)};pw2=(u32x4){PKW(pB1,0),PKW(pB1,2),PKW(pB1,4),PKW(pB1,6)};pw3=(u32x4){PKW(pB1,8),PKW(pB1,10),PKW(pB1,12),PKW(pB1,14)};
    SBAR(); pv(o,vb0+sl_cur,PAF(0),PAF(1),PAF(2),PAF(3)); }
  #undef PKW
  #undef PAF
  #undef VFR
  #undef PIN
  #undef MX3
  #undef GAPA
  #undef GAPB
  #undef EX
  #undef VRD
  #undef KRD
  #undef STEP
  #undef ENDW
  {auto rr=__builtin_amdgcn_permlane32_swap(__float_as_uint(l_reg),__float_as_uint(l_reg),false,false);l_reg=__uint_as_float(rr[0])+__uint_as_float(rr[1]);}
  if(hi==0)wsf[32+r32]=l_reg;asm volatile("s_waitcnt lgkmcnt(0)":::"memory");
  float rli[16];
  #pragma unroll
  for(int r=0;r<16;++r)rli[r]=__builtin_amdgcn_rcpf(wsf[32+crow(r,hi)]);
  bf16*Ow=O+(rowbase+q0+wid*QBLK)*DM+h*D;
  { bf16*stg=(bf16*)(shm+LDS_OST)+wid*2048;
    #pragma unroll
    for(int r=0;r<16;++r){const int orow=crow(r,hi);
      #pragma unroll
      for(int d0=0;d0<2;++d0)stg[orow*64+d0*32+r32]=__float2bfloat16(o[d0][r]*rli[r]);}
    asm volatile("s_waitcnt lgkmcnt(0)":::"memory");
    #pragma unroll
    for(int i=0;i<4;++i){const int row=i*8+(lane>>3),ch=lane&7; const u32x4 v=*(const u32x4*)(stg+row*64+ch*8); ATTN_STORE16(Ow+(long)row*DM+ch*8,v);} }
  asm volatile("s_waitcnt lgkmcnt(0)\n\ts_barrier":::"memory");
  #undef DMA_K
  #undef BIAS_LD
  #undef BSUB4
  #undef BSUBALL
  #undef DMA_V
  #undef CMASK
  #undef START
  #undef RESC
  #undef ROT
}
constexpr int ATTN_LDS_BYTES=LDS_BYTES;
#undef SBAR
#undef WAIT_BAR
}
#define GAS __attribute__((address_space(1)))
#define LAS __attribute__((address_space(3)))
typedef unsigned short bf16;
typedef unsigned v4u __attribute__((ext_vector_type(4)));
typedef float f32x4 __attribute__((ext_vector_type(4)));
typedef float f32x2 __attribute__((ext_vector_type(2)));
typedef short bf16x8 __attribute__((ext_vector_type(8)));
constexpr int NWAVES = 8;
constexpr int M = 16384, D = 1024, T = 8192, FF = 2816, NGU = 5632, R = 1280, NH = 16, NQKV = 3072, NFOX = 3088;
constexpr size_t MiB = 1u << 20;
constexpr size_t WS_SS = 0;
constexpr size_t WS_LOGF = 1 * MiB;
constexpr size_t WS_LSUM = 2 * MiB;
constexpr size_t WS_WF = 5 * MiB;
constexpr size_t WS_WLG = 5 * MiB + 512 * 1024;
constexpr size_t WS_NRM = 6 * MiB + 65536;
constexpr size_t WS_SP = 6 * MiB;
constexpr size_t WS_WGU = 8 * MiB, WGU_BYTES = 11 * MiB;
constexpr size_t WS_WD = 52 * MiB, WD_BYTES = 5 * MiB + 512 * 1024;
constexpr size_t WS_WQKV = 74 * MiB, WS_WO = 80 * MiB, WS_WLIN = 82 * MiB, WS_WLOUT = 87 * MiB;
constexpr size_t WS_XB = 90 * MiB;
constexpr size_t WS_BIG = 122 * MiB;
constexpr size_t WS_END = 218 * MiB;
constexpr int LDS_BYTES = 147456;
constexpr float LOG2E = 1.4426950408889634f;

__device__ __forceinline__ unsigned f2bf(float f) { unsigned u = __builtin_bit_cast(unsigned, f); return (u + 0x7fffu + ((u >> 16) & 1u)) >> 16; }
__device__ __forceinline__ unsigned pk2(float lo, float hi) { return f2bf(lo) | (f2bf(hi) << 16); }
__device__ __forceinline__ float bf2f(unsigned short b) { return __builtin_bit_cast(float, (unsigned)b << 16); }
__device__ __forceinline__ float wave_sum(float v) {
#pragma unroll
    for (int o = 1; o < 64; o <<= 1) v += __shfl_xor(v, o);
    return v;
}

#define XB_TMO      128
#define XB_XCNT(j)  (256  + 64 * (j))
#define XB_XSUB(j)  (1280 + 64 * (j))
#define XB_XGEN(j)  (2304 + 64 * (j))
#define XB_TOP      3328
#define XB_TOPGEN   3392
#define XCD_BAR_WORDS 3456
#define XB_SPIN_CAP (1u << 18)

__device__ __forceinline__ unsigned xb_ld(unsigned* p)              { return __hip_atomic_load(p, __ATOMIC_RELAXED, __HIP_MEMORY_SCOPE_AGENT); }
__device__ __forceinline__ unsigned xb_add(unsigned* p, unsigned v) { return __hip_atomic_fetch_add(p, v, __ATOMIC_RELAXED, __HIP_MEMORY_SCOPE_AGENT); }
__device__ __forceinline__ unsigned xb_xcc_id() { return (unsigned)__builtin_amdgcn_s_getreg((3 << 11) | 20) & 0xFu; }
#define XB_SPIN(cond, bar) do { unsigned _sp = 0; while (cond) { __builtin_amdgcn_s_sleep(1); \
    if ((++_sp & 255u) == 0u) { if (xb_ld(&(bar)[XB_TMO])) break; if (_sp > XB_SPIN_CAP) { atomicAdd(&(bar)[XB_TMO], 1u); break; } } } } while (0)

struct XcdBarrier {
    unsigned* bar; unsigned x;
    volatile LAS unsigned* st;
};

__device__ __forceinline__ XcdBarrier xcd_barrier_post(unsigned* bar, volatile LAS unsigned* st) {
    XcdBarrier b; b.bar = bar; b.x = xb_xcc_id(); b.st = st;
    if (threadIdx.x == 0) (void)xb_add(&bar[XB_XCNT(b.x)], 1u);
    return b;
}
__device__ __forceinline__ void xcd_barrier_complete(unsigned* bar, unsigned x, unsigned& nloc, unsigned& nx) {
    const unsigned G = gridDim.x * gridDim.y * gridDim.z;
    unsigned sum, cnt, mine, sp = 0u;
    for (;;) {
        sum = 0u; cnt = 0u; mine = 0u;
#pragma unroll
        for (unsigned j = 0; j < 16; ++j) { const unsigned c = xb_ld(&bar[XB_XCNT(j)]); sum += c; cnt += (c > 0u) ? 1u : 0u; mine = (j == x) ? c : mine; }
        if (sum == G) break;
        __builtin_amdgcn_s_sleep(1);
        if ((++sp & 255u) == 0u) { if (xb_ld(&bar[XB_TMO])) break; if (sp > XB_SPIN_CAP) { atomicAdd(&bar[XB_TMO], 1u); break; } }
    }
    nloc = mine > 0u ? mine : 1u; nx = cnt > 0u ? cnt : 1u;
}

__device__ __forceinline__ void xcd_barrier(const XcdBarrier& b) {
    asm volatile("s_waitcnt vmcnt(0)" ::: "memory");
    __syncthreads();
    if (threadIdx.x == 0) {
        unsigned* bar = b.bar;
        __builtin_amdgcn_s_waitcnt(0);
        unsigned nloc = b.st[0], nx = b.st[1];
        if (nloc == 0u) { xcd_barrier_complete(bar, b.x, nloc, nx); b.st[0] = nloc; b.st[1] = nx; }
        const unsigned old = xb_add(&bar[XB_XSUB(b.x)], 1u);
        const unsigned gen = old / nloc;
        if (old + 1u == (gen + 1u) * nloc) {
            __builtin_amdgcn_fence(__ATOMIC_RELEASE, "agent");
            asm volatile("s_waitcnt vmcnt(0)" ::: "memory");
            const unsigned og = xb_add(&bar[XB_TOP], 1u);
            const unsigned tg = og / nx;
            if (og + 1u == (tg + 1u) * nx) xb_add(&bar[XB_TOPGEN], 1u);
            else XB_SPIN(xb_ld(&bar[XB_TOPGEN]) == tg, bar);
            __builtin_amdgcn_fence(__ATOMIC_ACQUIRE, "agent");
            xb_add(&bar[XB_XGEN(b.x)], 1u);
            asm volatile("s_waitcnt vmcnt(0)" ::: "memory");
        } else {
            XB_SPIN(xb_ld(&bar[XB_XGEN(b.x)]) == gen, bar);
            __builtin_amdgcn_fence(__ATOMIC_ACQUIRE, "agent");
            asm volatile("s_waitcnt vmcnt(0)" ::: "memory");
        }
    }
    __syncthreads();
}

constexpr size_t WS_BAR = 7 * MiB, BAR_BYTES = 16384;
constexpr int MISC_OFF = 131072 + 320;
struct Args { const float* in[21]; float* out; unsigned char* ws; int ph_lo, ph_hi; };
enum { I_X = 0, I_F1N, I_F1GU, I_F1D, I_MIXN, I_F2N, I_F2GU, I_F2D, I_FOXIN, I_FOXBF, I_FOXOUT, I_LIN, I_LCW, I_LCB, I_LWA, I_LBA, I_LWI, I_LBI, I_LLAM, I_LOUT, I_FINN };

template <bool GU> __device__ __forceinline__ void tr_item(const float* W, int ldw, int K, int nblk, const float* gain, bf16* WT, LAS float* scr, int item, int lane) {
    const int kb = item / nblk, nb = item - kb * nblk, k0 = 64 * kb, n0 = 32 * nb;
#pragma unroll 8
    for (int i = 0; i < 32; ++i) { const int kk = 2 * i + (lane >> 5); float w = W[(size_t)(k0 + kk) * ldw + n0 + (lane & 31)]; if (gain) w *= gain[k0 + kk]; scr[kk * 33 + (lane & 31)] = w; }
    asm volatile("s_waitcnt lgkmcnt(0)" ::: "memory");
    int row0 = n0;
    if (GU) { const int c = (n0 < FF) ? n0 : n0 - FF; row0 = 256 * (c >> 7) + (c & 127) + ((n0 < FF) ? 0 : 128); }
    const int c8 = lane & 7;
#pragma unroll
    for (int j = 0; j < 4; ++j) { const int n = (lane >> 3) + 8 * j; const LAS float* s = scr + (8 * c8) * 33 + n;
        v4u o; o.x = pk2(s[0 * 33], s[1 * 33]); o.y = pk2(s[2 * 33], s[3 * 33]); o.z = pk2(s[4 * 33], s[5 * 33]); o.w = pk2(s[6 * 33], s[7 * 33]);
        *(v4u*)(WT + (size_t)(row0 + n) * K + k0 + 8 * c8) = o; }
    asm volatile("s_waitcnt lgkmcnt(0)" ::: "memory");
}

template <class Epi> __device__ __forceinline__ void run_gemm(LAS unsigned char* lds, const bf16* A, const bf16* Bt, int N, int K, const Epi& E) {
    pg8::Gemm g{A, Bt, M, N, K}; pg8::StaticOrder S; S.init(M, N, osgpr((int)gridDim.x), osgpr((int)blockIdx.x));
    pg8::gemm_phase<Epi, pg8::StaticOrder, PG8_ALIGN, PG8_SP2>(lds, g, S, E);
}

__device__ __forceinline__ float expm1_small(float x) {
    float p = 1.0f / 5040.0f; p = p * x + 1.0f / 720.0f; p = p * x + 1.0f / 120.0f; p = p * x + 1.0f / 24.0f; p = p * x + 1.0f / 6.0f; p = p * x + 0.5f; p = p * x + 1.0f; return p * x;
}
__device__ __forceinline__ void lru_passA(LAS unsigned char* L, const Args& args, int vcu, int G, int tid) {
    const int lane = tid & 63, wave = __builtin_amdgcn_readfirstlane(tid >> 6), fr = lane & 15, fq = lane >> 4;
    LAS bf16* Wt = (LAS bf16*)(L);
    LAS bf16* xcb = (LAS bf16*)(L + 33280);
    LAS float* xcf = (LAS float*)(L + 46592);
    LAS float* Aa = (LAS float*)(L + 67072);
    LAS float* Bb = (LAS float*)(L + 87552);
    LAS bf16* recs = (LAS bf16*)(L + 108032);
    LAS float* sub = (LAS float*)(L + 118752);
    LAS float* cst = (LAS float*)(L + 121632);
    unsigned char* ws = args.ws;
    const bf16* Wg = (const bf16*)(ws + WS_WLG); const float* sp = (const float*)(ws + WS_SP);
    bf16* GATE = (bf16*)(ws + WS_BIG); const bf16* REC = (const bf16*)(ws + WS_BIG + 40 * MiB); bf16* PG = (bf16*)(ws + WS_BIG + 80 * MiB);
    f32x2* SUM = (f32x2*)(ws + WS_LSUM);
    const int n = vcu & 15, ustep = G >> 4, u0 = vcu >> 4;
    unsigned zero = 0u; asm volatile("" : "+v"(zero));
    const int rr0 = tid / 10, pc0 = tid - rr0 * 10, rr1 = (tid + 512) / 10, pc1 = (tid + 512) - rr1 * 10;
#define LRU_REC_LOAD(uu, q0_, q1_) do { const int b_ = (uu) >> 7, t0_ = ((uu) & 127) * 64; q0_ = (v4u){zero, zero, zero, zero}; q1_ = q0_; \
        if (t0_ - 3 + rr0 >= 0) q0_ = *(const v4u*)(REC + ((size_t)b_ * T + t0_ - 3 + rr0) * R + n * 80 + pc0 * 8); \
        if (tid + 512 < 670) q1_ = *(const v4u*)(REC + ((size_t)b_ * T + t0_ - 3 + rr1) * R + n * 80 + pc1 * 8); } while (0)
    v4u rq0, rq1;
    LRU_REC_LOAD(u0, rq0, rq1);
    for (int p = tid; p < 1920; p += 512) { const int row = p / 12, pc = p - row * 12; *(LAS v4u*)(Wt + row * 104 + pc * 8) = *(const v4u*)(Wg + (size_t)(n * 160 + row) * 96 + pc * 8); }
    if (tid < 128) { const int row = tid >> 1, pc = tid & 1; *(LAS v4u*)(xcb + row * 104 + 80 + pc * 8) = (v4u){zero, zero, zero, zero}; }
    if (tid < 80) { const int c = n * 80 + tid;
        cst[0 * 80 + tid] = args.in[I_LCW][0 * R + c]; cst[1 * 80 + tid] = args.in[I_LCW][1 * R + c]; cst[2 * 80 + tid] = args.in[I_LCW][2 * R + c]; cst[3 * 80 + tid] = args.in[I_LCW][3 * R + c];
        cst[4 * 80 + tid] = args.in[I_LCB][c]; cst[5 * 80 + tid] = args.in[I_LBA][c]; cst[6 * 80 + tid] = args.in[I_LBI][c]; cst[7 * 80 + tid] = sp[c]; }
    for (int u = u0; u < 256; u += ustep) {
        const int b = u >> 7, j = u & 127, t0 = j * 64; const size_t rowg0 = (size_t)b * T + t0;
        *(LAS v4u*)(recs + rr0 * 80 + pc0 * 8) = rq0; if (tid + 512 < 670) *(LAS v4u*)(recs + rr1 * 80 + pc1 * 8) = rq1;
        v4u gq0, gq1 = (v4u){zero, zero, zero, zero};
        gq0 = *(const v4u*)(GATE + (rowg0 + rr0) * R + n * 80 + pc0 * 8); if (tid + 512 < 640) gq1 = *(const v4u*)(GATE + (rowg0 + rr1) * R + n * 80 + pc1 * 8);
        if (u + ustep < 256) LRU_REC_LOAD(u + ustep, rq0, rq1);
        __syncthreads();
#pragma unroll
        for (int i = 0; i < 10; ++i) { const int idx = tid + 512 * i, t = idx / 80, c = idx - t * 80;
            float x = cst[4 * 80 + c];
#pragma unroll
            for (int jj = 0; jj < 4; ++jj) x += cst[jj * 80 + c] * bf2f(recs[(t + jj) * 80 + c]);
            xcf[t * 80 + c] = x; xcb[t * 104 + c] = (bf16)f2bf(x); }
        __syncthreads();
        { const int mt = wave & 3, ct0 = (wave >> 2) ? 3 : 0, ct1 = (wave >> 2) ? 5 : 3, tok = 16 * mt + fr;
            for (int ct = ct0; ct < ct1; ++ct) { f32x4 ga = (f32x4){0.f, 0.f, 0.f, 0.f}, gi = ga;
#pragma unroll
                for (int kk = 0; kk < 3; ++kk) { const bf16x8 xf = *(const LAS bf16x8*)(xcb + tok * 104 + 32 * kk + 8 * fq);
                    const bf16x8 wa = *(const LAS bf16x8*)(Wt + (16 * ct + fr) * 104 + 32 * kk + 8 * fq), wi = *(const LAS bf16x8*)(Wt + (80 + 16 * ct + fr) * 104 + 32 * kk + 8 * fq);
                    ga = __builtin_amdgcn_mfma_f32_16x16x32_bf16(wa, xf, ga, 0, 0, 0); gi = __builtin_amdgcn_mfma_f32_16x16x32_bf16(wi, xf, gi, 0, 0, 0); }
                const int ch0 = 16 * ct + 4 * fq; const f32x4 xv = *(const LAS f32x4*)(xcf + tok * 80 + ch0);
                const f32x4 bav = *(const LAS f32x4*)(cst + 5 * 80 + ch0), biv = *(const LAS f32x4*)(cst + 6 * 80 + ch0), spv = *(const LAS f32x4*)(cst + 7 * 80 + ch0); f32x4 av, bv;
#pragma unroll
                for (int e = 0; e < 4; ++e) {
                    const float r = pg8::fast_sigmoid(ga[e] + bav[e]), ig = pg8::fast_sigmoid(gi[e] + biv[e]);
                    const float la = -8.0f * r * spv[e]; float a, om;
                    if (la > -0.125f) { a = 1.0f + expm1_small(la); om = -expm1_small(2.0f * la); } else { a = expf(la); om = -expm1f(2.0f * la); }
                    av[e] = a; bv[e] = __builtin_amdgcn_sqrtf(om) * (ig * xv[e]); }
                *(LAS f32x4*)(Aa + tok * 80 + ch0) = av; *(LAS f32x4*)(Bb + tok * 80 + ch0) = bv; } }
        __syncthreads();
        const int ch = tid % 80, s = tid / 80;
        if (tid < 320) { float Ap = 1.f, Bp = 0.f;
#pragma unroll
            for (int tt = 0; tt < 16; ++tt) { const int t = 16 * s + tt; const float a = Aa[t * 80 + ch], bb = Bb[t * 80 + ch]; Ap *= a; Bp = a * Bp + bb; }
            sub[(s * 80 + ch) * 2] = Ap; sub[(s * 80 + ch) * 2 + 1] = Bp; }
        __syncthreads();
        if (tid < 320) { float h = 0.f, Pp = 1.f;
            for (int s2 = 0; s2 < s; ++s2) { const float a = sub[(s2 * 80 + ch) * 2]; h = a * h + sub[(s2 * 80 + ch) * 2 + 1]; Pp *= a; }
#pragma unroll
            for (int tt = 0; tt < 16; ++tt) { const int t = 16 * s + tt; const float a = Aa[t * 80 + ch]; h = a * h + Bb[t * 80 + ch]; Pp *= a; Bb[t * 80 + ch] = h; Aa[t * 80 + ch] = Pp; }
            if (s == 3) SUM[((size_t)b * 128 + j) * R + n * 80 + ch] = (f32x2){Pp, h}; }
        __syncthreads();
#define LRU_OUT(rr_, pc_, gv) do { const f32x4 h0 = *(const LAS f32x4*)(Bb + (rr_) * 80 + (pc_) * 8), h1 = *(const LAS f32x4*)(Bb + (rr_) * 80 + (pc_) * 8 + 4); \
            const f32x4 p0 = *(const LAS f32x4*)(Aa + (rr_) * 80 + (pc_) * 8), p1 = *(const LAS f32x4*)(Aa + (rr_) * 80 + (pc_) * 8 + 4); \
            const float g0 = bf2f((unsigned short)(gv.x & 0xffffu)), g1 = bf2f((unsigned short)(gv.x >> 16)), g2 = bf2f((unsigned short)(gv.y & 0xffffu)), g3 = bf2f((unsigned short)(gv.y >> 16)); \
            const float g4 = bf2f((unsigned short)(gv.z & 0xffffu)), g5 = bf2f((unsigned short)(gv.z >> 16)), g6 = bf2f((unsigned short)(gv.w & 0xffffu)), g7 = bf2f((unsigned short)(gv.w >> 16)); \
            v4u o, q; o.x = pg8::cvt_pk_bf16(h0[0] * g0, h0[1] * g1); o.y = pg8::cvt_pk_bf16(h0[2] * g2, h0[3] * g3); o.z = pg8::cvt_pk_bf16(h1[0] * g4, h1[1] * g5); o.w = pg8::cvt_pk_bf16(h1[2] * g6, h1[3] * g7); \
            q.x = pg8::cvt_pk_bf16(p0[0] * g0, p0[1] * g1); q.y = pg8::cvt_pk_bf16(p0[2] * g2, p0[3] * g3); q.z = pg8::cvt_pk_bf16(p1[0] * g4, p1[1] * g5); q.w = pg8::cvt_pk_bf16(p1[2] * g6, p1[3] * g7); \
            const size_t off_ = (rowg0 + (rr_)) * R + n * 80 + (pc_) * 8; *(v4u*)(GATE + off_) = o; *(v4u*)(PG + off_) = q; } while (0)
        LRU_OUT(rr0, pc0, gq0); if (tid + 512 < 640) LRU_OUT(rr1, pc1, gq1);
#undef LRU_OUT
        __syncthreads();
    }
#undef LRU_REC_LOAD
}
__device__ __forceinline__ void lru_passB(LAS unsigned char* L, const Args& args, int vcu, int G, int tid, bf16* YOUT) {
    LAS float* carry = (LAS float*)(L);
    unsigned char* ws = args.ws;
    const bf16* YL = (const bf16*)(ws + WS_BIG); const bf16* PG = (const bf16*)(ws + WS_BIG + 80 * MiB); const f32x2* SUM = (const f32x2*)(ws + WS_LSUM);
    const int n = vcu & 15, ustep = G >> 4, u0 = vcu >> 4;
    unsigned zero = 0u; asm volatile("" : "+v"(zero));
    const int rr0 = tid / 10, pc0 = tid - rr0 * 10, rr1 = (tid + 512) / 10, pc1 = (tid + 512) - rr1 * 10;
#define LRU_B_LOAD(uu, y0_, y1_, p0_, p1_, sq_) do { const int b_ = (uu) >> 7, j_ = (uu) & 127, lo_ = (j_ < ustep) ? 0 : j_ - ustep; const size_t r0_ = (size_t)b_ * T + j_ * 64; \
        y0_ = *(const v4u*)(YL + (r0_ + rr0) * R + n * 80 + pc0 * 8); p0_ = *(const v4u*)(PG + (r0_ + rr0) * R + n * 80 + pc0 * 8); y1_ = (v4u){zero, zero, zero, zero}; p1_ = y1_; \
        if (tid + 512 < 640) { y1_ = *(const v4u*)(YL + (r0_ + rr1) * R + n * 80 + pc1 * 8); p1_ = *(const v4u*)(PG + (r0_ + rr1) * R + n * 80 + pc1 * 8); } \
        const f32x2* S_ = SUM + ((size_t)b_ * 128) * R + n * 80 + tid; \
        _Pragma("unroll") for (int i_ = 0; i_ < 16; ++i_) { sq_[i_] = (f32x2){1.f, 0.f}; if (tid < 80 && lo_ + i_ < j_) sq_[i_] = S_[(size_t)(lo_ + i_) * R]; } } while (0)
#define LRU_B_OUT(rr_, pc_, yv, pv) do { const f32x4 c0 = *(const LAS f32x4*)(carry + (pc_) * 8), c1 = *(const LAS f32x4*)(carry + (pc_) * 8 + 4); v4u o; \
        o.x = pg8::cvt_pk_bf16(bf2f((unsigned short)(yv.x & 0xffffu)) + bf2f((unsigned short)(pv.x & 0xffffu)) * c0[0], bf2f((unsigned short)(yv.x >> 16)) + bf2f((unsigned short)(pv.x >> 16)) * c0[1]); \
        o.y = pg8::cvt_pk_bf16(bf2f((unsigned short)(yv.y & 0xffffu)) + bf2f((unsigned short)(pv.y & 0xffffu)) * c0[2], bf2f((unsigned short)(yv.y >> 16)) + bf2f((unsigned short)(pv.y >> 16)) * c0[3]); \
        o.z = pg8::cvt_pk_bf16(bf2f((unsigned short)(yv.z & 0xffffu)) + bf2f((unsigned short)(pv.z & 0xffffu)) * c1[0], bf2f((unsigned short)(yv.z >> 16)) + bf2f((unsigned short)(pv.z >> 16)) * c1[1]); \
        o.w = pg8::cvt_pk_bf16(bf2f((unsigned short)(yv.w & 0xffffu)) + bf2f((unsigned short)(pv.w & 0xffffu)) * c1[2], bf2f((unsigned short)(yv.w >> 16)) + bf2f((unsigned short)(pv.w >> 16)) * c1[3]); \
        *(v4u*)(YOUT + (rowg0 + (rr_)) * R + n * 80 + (pc_) * 8) = o; } while (0)
    v4u y0, y1, p0, p1; f32x2 sq[16];
    LRU_B_LOAD(u0, y0, y1, p0, p1, sq);
    float hc = 0.f;
    for (int u = u0; u < 256; u += ustep) {
        const int b = u >> 7, j = u & 127; const size_t rowg0 = (size_t)b * T + j * 64;
        if (tid < 80) { if (j < ustep) hc = 0.f;
#pragma unroll
            for (int i = 0; i < 16; ++i) hc = sq[i].x * hc + sq[i].y;
            carry[tid] = hc; }
        const v4u cy0 = y0, cy1 = y1, cp0 = p0, cp1 = p1;
        if (u + ustep < 256) LRU_B_LOAD(u + ustep, y0, y1, p0, p1, sq);
        __syncthreads();
        LRU_B_OUT(rr0, pc0, cy0, cp0); if (tid + 512 < 640) LRU_B_OUT(rr1, pc1, cy1, cp1);
        __syncthreads();
    }
#undef LRU_B_LOAD
#undef LRU_B_OUT
}

__device__ __forceinline__ void p0_prologue(LAS unsigned char* lds, const Args& args, int vcu, int G, int tid) {
    const int lane = tid & 63, wave = __builtin_amdgcn_readfirstlane(tid >> 6);
    unsigned char* ws = args.ws;
    LAS float* scr = (LAS float*)(lds + wave * 16384);
    const int gw = vcu * NWAVES + wave, NGW = G * NWAVES;
    constexpr int I_GU = (D / 64) * (NGU / 32), I_DN = (FF / 64) * (D / 32), I_QKV = (D / 64) * (NQKV / 32), I_WO = (D / 64) * (D / 32), I_LI = (D / 64) * (2 * R / 32), I_LO = (R / 64) * (D / 32);
    constexpr int NITEMS = 4 * I_GU + 4 * I_DN + I_QKV + I_WO + I_LI + I_LO;
#define TR_DECODE(it_, W_, gn_, WT_, ldw_, K_, nblk_, gu_, r_) do { int q_ = (it_); gu_ = 0; gn_ = nullptr; \
        if (q_ < 4 * I_GU) { const int f = q_ / I_GU; q_ -= f * I_GU; const int layer = f >> 1; \
            W_ = ((f & 1) ? args.in[I_F2GU] : args.in[I_F1GU]) + (size_t)layer * D * NGU; gn_ = ((f & 1) ? args.in[I_F2N] : args.in[I_F1N]) + layer * D; \
            WT_ = (bf16*)(ws + WS_WGU + f * WGU_BYTES); ldw_ = NGU; K_ = D; nblk_ = NGU / 32; gu_ = 1; } \
        else if ((q_ -= 4 * I_GU) < 4 * I_DN) { const int f = q_ / I_DN; q_ -= f * I_DN; const int layer = f >> 1; \
            W_ = ((f & 1) ? args.in[I_F2D] : args.in[I_F1D]) + (size_t)layer * FF * D; WT_ = (bf16*)(ws + WS_WD + f * WD_BYTES); ldw_ = D; K_ = FF; nblk_ = D / 32; } \
        else if ((q_ -= 4 * I_DN) < I_QKV) { W_ = args.in[I_FOXIN]; gn_ = args.in[I_MIXN]; WT_ = (bf16*)(ws + WS_WQKV); ldw_ = NFOX; K_ = D; nblk_ = NQKV / 32; } \
        else if ((q_ -= I_QKV) < I_WO) { W_ = args.in[I_FOXOUT]; WT_ = (bf16*)(ws + WS_WO); ldw_ = D; K_ = D; nblk_ = D / 32; } \
        else if ((q_ -= I_WO) < I_LI) { W_ = args.in[I_LIN]; gn_ = args.in[I_MIXN] + D; WT_ = (bf16*)(ws + WS_WLIN); ldw_ = 2 * R; K_ = D; nblk_ = 2 * R / 32; } \
        else { q_ -= I_LI; W_ = args.in[I_LOUT]; WT_ = (bf16*)(ws + WS_WLOUT); ldw_ = D; K_ = R; nblk_ = D / 32; } \
        r_ = q_; } while (0)
#define TR_LOAD(v_, W_, ldw_, nblk_, r_) do { const int kb_ = (r_) / (nblk_), nb_ = (r_) - kb_ * (nblk_); const float* p_ = (W_) + (size_t)(64 * kb_ + (lane >> 3)) * (ldw_) + 32 * nb_ + 4 * (lane & 7); \
        _Pragma("unroll") for (int i_ = 0; i_ < 8; ++i_) v_[i_] = *(const f32x4*)(p_ + (size_t)(8 * i_) * (ldw_)); } while (0)
    {
        const float* W = nullptr; const float* gn = nullptr; bf16* WT = nullptr; int ldw = 0, K = 0, nblk = 1, gu = 0, r = 0; f32x4 cur[8];
        int it = gw;
        if (it < NITEMS) { TR_DECODE(it, W, gn, WT, ldw, K, nblk, gu, r); TR_LOAD(cur, W, ldw, nblk, r); }
        while (it < NITEMS) {
            const int itn = it + NGW; const float* Wn = nullptr; const float* gnn = nullptr; bf16* WTn = nullptr; int ldwn = 0, Kn = 0, nblkn = 1, gun = 0, rn = 0; f32x4 nxt[8];
            if (itn < NITEMS) { TR_DECODE(itn, Wn, gnn, WTn, ldwn, Kn, nblkn, gun, rn); TR_LOAD(nxt, Wn, ldwn, nblkn, rn); }
            const int kb = r / nblk, nb = r - kb * nblk, k0 = 64 * kb, n0 = 32 * nb;
#pragma unroll
            for (int i = 0; i < 8; ++i) { const int kk = 8 * i + (lane >> 3); const float g = gn ? gn[k0 + kk] : 1.0f; LAS float* sp_ = scr + kk * 33 + 4 * (lane & 7);
                sp_[0] = cur[i][0] * g; sp_[1] = cur[i][1] * g; sp_[2] = cur[i][2] * g; sp_[3] = cur[i][3] * g; }
            asm volatile("s_waitcnt lgkmcnt(0)" ::: "memory");
            int row0 = n0;
            if (gu) { const int c = (n0 < FF) ? n0 : n0 - FF; row0 = 256 * (c >> 7) + (c & 127) + ((n0 < FF) ? 0 : 128); }
            const int c8 = lane & 7;
#pragma unroll
            for (int j = 0; j < 4; ++j) { const int n = (lane >> 3) + 8 * j; const LAS float* s_ = scr + (8 * c8) * 33 + n;
                v4u o; o.x = pg8::cvt_pk_bf16(s_[0 * 33], s_[1 * 33]); o.y = pg8::cvt_pk_bf16(s_[2 * 33], s_[3 * 33]); o.z = pg8::cvt_pk_bf16(s_[4 * 33], s_[5 * 33]); o.w = pg8::cvt_pk_bf16(s_[6 * 33], s_[7 * 33]);
                *(v4u*)(WT + (size_t)(row0 + n) * K + k0 + 8 * c8) = o; }
            asm volatile("s_waitcnt lgkmcnt(0)" ::: "memory");
            it = itn; W = Wn; gn = gnn; WT = WTn; ldw = ldwn; K = Kn; nblk = nblkn; gu = gun; r = rn;
#pragma unroll
            for (int i = 0; i < 8; ++i) cur[i] = nxt[i];
        }
    }
#undef TR_DECODE
#undef TR_LOAD
    const int gt = vcu * 512 + tid, NGT = G * 512;
    { bf16* wf = (bf16*)(ws + WS_WF);
        for (int i = gt; i < NH * D; i += NGT) { const int h = i >> 10, k = i & 1023; wf[i] = (bf16)f2bf(args.in[I_MIXN][k] * args.in[I_FOXIN][(size_t)k * NFOX + NQKV + h]); } }
    { bf16* wg = (bf16*)(ws + WS_WLG);
        for (int i = gt; i < 16 * 160 * 96; i += NGT) { const int k = i % 96, dd = (i / 96) % 160, n = i / (96 * 160); float v = 0.f;
            if (k < 80) v = (dd < 80) ? args.in[I_LWA][((size_t)n * 80 + k) * 80 + dd] : args.in[I_LWI][((size_t)n * 80 + k) * 80 + (dd - 80)];
            wg[i] = (bf16)f2bf(v); } }
    { float* sp = (float*)(ws + WS_SP); for (int i = gt; i < R; i += NGT) sp[i] = log1pf(expf(-args.in[I_LLAM][i])); }
    { float* ss = (float*)(ws + WS_SS); for (int i = gt; i < 7 * M; i += NGT) ss[M + i] = 0.f; }
    { float* ss0 = (float*)(ws + WS_SS); bf16* xb = (bf16*)(ws + WS_XB); const float* x = args.in[I_X];
        for (int m = gw; m < M; m += NGW) { const f32x4* xr = (const f32x4*)(x + (size_t)m * D) + lane; f32x4 v[4]; float s = 0.f;
#pragma unroll
            for (int j = 0; j < 4; ++j) { v[j] = xr[64 * j]; s += (v[j].x * v[j].x + v[j].y * v[j].y) + (v[j].z * v[j].z + v[j].w * v[j].w); }
            s = wave_sum(s); if (lane == 0) ss0[m] = s;
            unsigned long long* o8 = (unsigned long long*)(xb + (size_t)m * D) + lane;
#pragma unroll
            for (int j = 0; j < 4; ++j) o8[64 * j] = (unsigned long long)pk2(v[j].x, v[j].y) | ((unsigned long long)pk2(v[j].z, v[j].w) << 32); } }
}

__device__ __forceinline__ void flogit_phase(const Args& args, int vcu, int G, int tid) {
    const int lane = tid & 63, wave = __builtin_amdgcn_readfirstlane(tid >> 6), fr = lane & 15, fq = lane >> 4;
    unsigned char* ws = args.ws; const bf16* xb = (const bf16*)(ws + WS_XB); const bf16* wf = (const bf16*)(ws + WS_WF); const float* ss = (const float*)(ws + WS_SS) + 1 * M; float* logf_ = (float*)(ws + WS_LOGF);
    const int gw = vcu * NWAVES + wave, NGW = G * NWAVES;
    for (int grp = gw; grp < M / 16; grp += NGW) { const int row0 = grp * 16;
        const bf16* xa = xb + (size_t)(row0 + fr) * D + 8 * fq; const bf16* wb = wf + (size_t)fr * D + 8 * fq; f32x4 acc = (f32x4){0.f, 0.f, 0.f, 0.f};
#pragma unroll 8
        for (int kk = 0; kk < 32; ++kk) { const bf16x8 xf = *(const bf16x8*)(xa + 32 * kk), wv = *(const bf16x8*)(wb + 32 * kk); acc = __builtin_amdgcn_mfma_f32_16x16x32_bf16(wv, xf, acc, 0, 0, 0); }
        const int row = row0 + fr, b = row >> 13, t = row & (T - 1); const float rs = pg8::rstd_row(ss, row);
#pragma unroll
        for (int e = 0; e < 4; ++e) { const int h = 4 * fq + e; const float z = acc[e] * rs + args.in[I_FOXBF][h];
            const float lf = fminf(z, 0.f) - log1pf(expf(-fabsf(z))); logf_[(size_t)(b * NH + h) * T + t] = lf * LOG2E; } }
}

__device__ __forceinline__ void attn_cumsum(const float* lf, LAS float* Gl, LAS float* wsum, int tid) {
    const int lane = tid & 63, wave = tid >> 6; f32x4 v[4];
#pragma unroll
    for (int j = 0; j < 4; ++j) v[j] = *(const f32x4*)(lf + tid * 16 + 4 * j);
    float run = 0.f;
#pragma unroll
    for (int j = 0; j < 4; ++j) { run += v[j].x; v[j].x = run; run += v[j].y; v[j].y = run; run += v[j].z; v[j].z = run; run += v[j].w; v[j].w = run; }
    float incl = run;
#pragma unroll
    for (int o = 1; o < 64; o <<= 1) { const float nb = __shfl_up(incl, o); if (lane >= o) incl += nb; }
    if (lane == 63) wsum[wave] = incl;
    __syncthreads();
    float base = incl - run;
    for (int w = 0; w < wave; ++w) base += wsum[w];
#pragma unroll
    for (int j = 0; j < 4; ++j) *(LAS f32x4*)(Gl + tid * 16 + 4 * j) = v[j] + base;
    __syncthreads();
}

constexpr int N_PHASES = 17;
#ifndef ONLY_KIND
#define ONLY_KIND -1
#endif
#define KON(k) (ONLY_KIND < 0 || ONLY_KIND == (k))
#ifndef DUP_PH
#define DUP_PH -1
#endif
#ifndef DUP_SYNC
#define DUP_SYNC 0
#endif
__global__ void __launch_bounds__(NWAVES * 64, 2) fwd_megakernel(Args args) {
    extern __shared__ __attribute__((aligned(16))) unsigned char lds_raw[];
    LAS unsigned char* lds = (LAS unsigned char*)lds_raw;
    cg::grid_group grid = cg::this_grid();
    if (threadIdx.x < 16) ((LAS unsigned*)(lds + MISC_OFF))[threadIdx.x] = 0u;
    __syncthreads();
    XcdBarrier xbar = xcd_barrier_post((unsigned*)(args.ws + WS_BAR), (volatile LAS unsigned*)(lds + MISC_OFF));
    unsigned char* ws = args.ws;
    float* ssb = (float*)(ws + WS_SS); bf16* XB = (bf16*)(ws + WS_XB);
    bf16* HB = (bf16*)(ws + WS_BIG); bf16* QB_ = (bf16*)(ws + WS_BIG); bf16* KB = (bf16*)(ws + WS_BIG + 32 * MiB); bf16* VB = (bf16*)(ws + WS_BIG + 64 * MiB);
    bf16* GATE = (bf16*)(ws + WS_BIG); bf16* REC = (bf16*)(ws + WS_BIG + 40 * MiB);
    for (int pp = args.ph_lo; pp < args.ph_hi; ++pp) {
        int ph = pp; bool dummy = false;
        if (DUP_PH >= 0) { dummy = (pp == DUP_PH); ph = (pp <= DUP_PH) ? pp : pp - 1; }
        const int tid = otid(), G = osgpr((int)gridDim.x), bx = osgpr((int)blockIdx.x);
        const int vcu = (G % 8 == 0) ? (bx % 8) * (G / 8) + bx / 8 : bx;
        int kind = 0, f = 0, ssi = 0; const bf16* A = XB; const bf16* Bt = nullptr; int K = D; const float* xin = args.out; float alpha = 1.f;
        switch (ph) {
            case 0: kind = 0; break;
            case 1: kind = 1; f = 0; ssi = 0; break;
            case 2: kind = 2; A = HB; Bt = (const bf16*)(ws + WS_WD + 0 * WD_BYTES); K = FF; xin = args.in[I_X]; alpha = 0.5f; ssi = 1; break;
            case 3: kind = 3; break;
            case 4: kind = 4; break;
            case 5: kind = 2; A = QB_; Bt = (const bf16*)(ws + WS_WO); K = D; alpha = 1.f; ssi = 2; break;
            case 6: kind = 1; f = 1; ssi = 2; break;
            case 7: kind = 2; A = HB; Bt = (const bf16*)(ws + WS_WD + 1 * WD_BYTES); K = FF; alpha = 0.5f; ssi = 3; break;
            case 8: kind = 1; f = 2; ssi = 3; break;
            case 9: kind = 2; A = HB; Bt = (const bf16*)(ws + WS_WD + 2 * WD_BYTES); K = FF; alpha = 0.5f; ssi = 4; break;
            case 10: kind = 5; break;
            case 11: kind = 6; break;
            case 12: kind = 7; break;
            case 13: kind = 2; A = GATE; Bt = (const bf16*)(ws + WS_WLOUT); K = R; alpha = 1.f; ssi = 5; break;
            case 14: kind = 1; f = 3; ssi = 5; break;
            case 15: kind = 2; A = HB; Bt = (const bf16*)(ws + WS_WD + 3 * WD_BYTES); K = FF; alpha = 0.5f; ssi = 6; break;
            default: kind = 8; break;
        }
        if (dummy) { alpha = 0.f; if (kind == 2) ssi = 7; }
        bf16* const OB = dummy ? (bf16*)(ws + 218 * MiB) : QB_; bf16* const YB = dummy ? REC : GATE;
        if (KON(0) && kind == 0) { p0_prologue(lds, args, vcu, G, tid); }
        else if (KON(1) && kind == 1) { pg8::EpiSwiGLU E{HB, ssb + (size_t)ssi * M}; run_gemm(lds, XB, (const bf16*)(ws + WS_WGU + f * WGU_BYTES), NGU, D, E); }
        else if (KON(2) && kind == 2) { pg8::EpiResid E{xin, args.out, XB, ssb + (size_t)ssi * M, alpha}; run_gemm(lds, A, Bt, D, K, E); }
        else if (KON(3) && kind == 3) { pg8::EpiQKV E{QB_, (size_t)M * D, ssb + 1 * M, attn_body::C2, (float*)(ws + WS_NRM)}; run_gemm(lds, XB, (const bf16*)(ws + WS_WQKV), NQKV, D, E); flogit_phase(args, vcu, G, tid); }
        else if (KON(4) && kind == 4) {
            LAS float* Gl = (LAS float*)(lds + 86016); LAS float* wsum = (LAS float*)(lds + 86016 + 32768); LAS unsigned* tsw = (LAS unsigned*)(lds + 86016 + 32768 + 64);
            for (int item = vcu; item < 256; item += G) { const int bh = item >> 3, s = item & 7;
                attn_cumsum((const float*)(ws + WS_LOGF) + (size_t)bh * T, Gl, wsum, tid);
                for (int i = 0; i < 4; ++i) { const int qb = (i == 0) ? s : (i == 1) ? 15 - s : (i == 2) ? 16 + s : 31 - s;
                    const int hd = bh & 15, bb = bh >> 4, NTu = 4 * qb + 4, q0 = 256 * qb; const float* nq = (const float*)(ws + WS_NRM) + ((size_t)hd * 256 + bb * 128) * 2; const float* nk = nq + (size_t)16 * 256 * 2;
                    if (tid == 0) tsw[0] = (unsigned)(NTu - 4);
                    __syncthreads();
                    if (tid < 128 && tid < NTu - 4) { float qn2 = 0.f;
#pragma unroll
                        for (int r4 = 0; r4 < 4; ++r4) qn2 = fmaxf(qn2, nq[(4 * qb + r4) * 2] + nq[(4 * qb + r4) * 2 + 1]);
                        const float kn2 = nk[tid * 2] + nk[tid * 2 + 1]; const float bound = 1.01f * sqrtf(qn2 * kn2) + Gl[q0] - Gl[64 * tid + 63];
                        if (!(bound < -190.f)) atomicMin((unsigned*)tsw, (unsigned)tid); }
                    __syncthreads();
                    const int tstart = __builtin_amdgcn_readfirstlane((int)tsw[0]) & ~1;
                    attn_body::attn_unit<8>(bh >> 4, bh & 15, qb, (const attn_body::bf16*)QB_, (const attn_body::bf16*)KB, (const attn_body::bf16*)VB, (attn_body::bf16*)OB, (char*)lds_raw, (attn_body::lds_fptr)Gl, tstart); }
                __syncthreads(); }
        }
        else if (KON(5) && kind == 5) { pg8::EpiLruIn E{GATE, REC, ssb + 4 * M}; run_gemm(lds, XB, (const bf16*)(ws + WS_WLIN), 2 * R, D, E); }
        else if (KON(6) && kind == 6) { lru_passA(lds, args, vcu, G, tid); }
        else if (KON(7) && kind == 7) { lru_passB(lds, args, vcu, G, tid, YB); }
        else if (KON(8)) { const int lane = tid & 63, wave = tid >> 6, gw = vcu * NWAVES + wave, NGW = G * NWAVES; const float* ss = ssb + 6 * M; const f32x4* gn = (const f32x4*)args.in[I_FINN] + lane;
            for (int m = gw; m < M; m += NGW) { const float rs = pg8::rstd_row(ss, m); f32x4* xr = (f32x4*)(args.out + (size_t)m * D) + lane;
#pragma unroll
                for (int j = 0; j < 4; ++j) { const f32x4 v = xr[64 * j]; xr[64 * j] = v * rs * gn[64 * j]; } } }
        if (pp + 1 < args.ph_hi) { if (pp == args.ph_lo) grid.sync(); else xcd_barrier(xbar); if (DUP_SYNC) xcd_barrier(xbar); }
    }
}

#ifndef MK_PER_PHASE_LAUNCH
#define MK_PER_PHASE_LAUNCH 0
#endif
extern "C" void kernel_launch(void* const* d_in, const int* in_sizes, int n_in, void* d_out, int out_size, void* d_ws, size_t ws_size, hipStream_t stream) {
    static int grid = 0;
    if (grid == 0) {
        if (n_in != 21 || in_sizes[0] != M * D || out_size != M * D || ws_size < WS_END) { fprintf(stderr, "kernel_launch: unexpected shapes (n_in %d, in0 %d, out %d, ws %zu); nothing launched\n", n_in, n_in > 0 ? in_sizes[0] : -1, out_size, ws_size); grid = -1; return; }
        int dev = 0, cus = 0, per_cu = 0;
        if (hipGetDevice(&dev) != hipSuccess || hipDeviceGetAttribute(&cus, hipDeviceAttributeMultiprocessorCount, dev) != hipSuccess) { grid = -1; return; }
        if (hipFuncSetAttribute((const void*)fwd_megakernel, hipFuncAttributeMaxDynamicSharedMemorySize, LDS_BYTES) != hipSuccess) { fprintf(stderr, "kernel_launch: hipFuncSetAttribute failed\n"); grid = -1; return; }
        if (hipOccupancyMaxActiveBlocksPerMultiprocessor(&per_cu, (const void*)fwd_megakernel, NWAVES * 64, LDS_BYTES) != hipSuccess || per_cu < 1) { fprintf(stderr, "kernel_launch: occupancy query says %d blocks per CU\n", per_cu); per_cu = 1; }
        (void)hipGetLastError();
        grid = cus * per_cu;
        if (grid != 256) fprintf(stderr, "kernel_launch: grid %d (this kernel's static unit orders assume 256 workgroups)\n", grid);
    }
    if (grid < 0) return;
    Args a{};
    for (int i = 0; i < 21; ++i) a.in[i] = (const float*)d_in[i];
    a.out = (float*)d_out; a.ws = (unsigned char*)d_ws;
    if (hipMemsetAsync((unsigned char*)d_ws + WS_BAR, 0, BAR_BYTES, stream) != hipSuccess) { fprintf(stderr, "kernel_launch: memset of the barrier words failed\n"); return; }
#if MK_PER_PHASE_LAUNCH
    for (int ph = 0; ph < N_PHASES; ++ph) { a.ph_lo = ph; a.ph_hi = ph + 1; hipLaunchKernelGGL(fwd_megakernel, dim3(grid), dim3(NWAVES * 64), LDS_BYTES, stream, a); }
#else
    a.ph_lo = 0; a.ph_hi = N_PHASES + ((DUP_PH >= 0) ? 1 : 0);
    void* kargs[] = {&a};
    const hipError_t e = hipLaunchCooperativeKernel((const void*)fwd_megakernel, dim3(grid), dim3(NWAVES * 64), kargs, LDS_BYTES, stream);
    if (e != hipSuccess) fprintf(stderr, "kernel_launch: cooperative launch failed: %s (grid %d)\n", hipGetErrorString(e), grid);
#endif
}
```

```cpp
#define DUP_PH -1
#define DUP_SYNC 0
#include <hip/hip_runtime.h>
#include <hip/hip_cooperative_groups.h>
#include <cstdio>
#include <cstdint>
namespace cg = cooperative_groups;
__device__ __forceinline__ int otid() { int t = (int)threadIdx.x; asm volatile("" : "+v"(t)); return t; }
__device__ __forceinline__ float shx(float v, int o, int lane) { return __builtin_bit_cast(float, __builtin_amdgcn_ds_bpermute((lane ^ o) << 2, __builtin_bit_cast(int, v))); }
__device__ __forceinline__ int shxi(int v, int o, int lane) { return __builtin_amdgcn_ds_bpermute((lane ^ o) << 2, v); }
__device__ __forceinline__ float shup(float v, int o, int lane) { return __builtin_bit_cast(float, __builtin_amdgcn_ds_bpermute((lane - o) << 2, __builtin_bit_cast(int, v))); }
__device__ __forceinline__ int shupi(int v, int o, int lane) { return __builtin_amdgcn_ds_bpermute((lane - o) << 2, v); }
__device__ __forceinline__ int osgpr(int v) { asm volatile("" : "+s"(v)); return v; }
namespace pg8 {
#define PG8_LAS __attribute__((address_space(3)))
typedef unsigned short bf16_t;
typedef short bf16x8 __attribute__((ext_vector_type(8)));
typedef float f32x4 __attribute__((ext_vector_type(4)));
typedef unsigned u32x4 __attribute__((ext_vector_type(4)));
constexpr int BM = 256, BK = 64, HALF = 128, HTB = HALF * BK * 2  , STAGE_BYTES = 8 * HTB, NXCD = 8, WGM = 8;

__host__ __device__ __forceinline__ int lds_byte(int r, int c) { const int st = (r >> 4) * 2 + (c >> 5), rr = r & 15, cc = c & 31, ob = rr * 64 + cc * 2; return st * 1024 + (ob ^ (((ob >> 9) & 1) << 5)); }
__host__ __device__ __forceinline__ void stage_rc(int b, int& R, int& C) { const int st = b / 1024, sb = b % 1024, swz = sb ^ (((sb >> 9) & 1) << 5); R = (st >> 1) * 16 + swz / 64; C = (st & 1) * 32 + (swz % 64) / 2; }
__host__ __device__ __forceinline__ int perm32(int rho) { const int n = rho >> 4, i = rho & 15; return 8 * (i >> 2) + 4 * n + (i & 3); }

struct Unit { int pm, pn; };
struct Gemm { const bf16_t* A; const bf16_t* Bt; int M, N, K; };

struct StaticOrder {
    int nM, nN, nwg, G, c;
    __host__ __device__ void init(int M, int N, int G_, int c_) { nM = M / BM; nN = N / BM; nwg = nM * nN; G = G_; c = c_; }
    __host__ __device__ bool next(int i, Unit& u) const {
        const long L = (long)i * G + c; if (L >= nwg) return false;
        int wgid = (int)L; { const int q = nwg / NXCD, r = nwg % NXCD, xcd = wgid % NXCD, off = wgid / NXCD; wgid = (xcd < r ? xcd * (q + 1) : r * (q + 1) + (xcd - r) * q) + off; }
        const int nig = WGM * nN, gid = wgid / nig, fm = gid * WGM, gsz = (nM - fm) < WGM ? (nM - fm) : WGM;
        u.pm = fm + ((wgid % nig) % gsz); u.pn = (wgid % nig) / gsz; return true;
    }
    __device__ __forceinline__ void a_ready(const Unit&) const {}
    __device__ __forceinline__ void done(const Unit&) const {}
};

__device__ __forceinline__ unsigned cvt_pk_bf16(float lo, float hi) { unsigned r; asm volatile("v_cvt_pk_bf16_f32 %0, %1, %2" : "=v"(r) : "v"(lo), "v"(hi)); return r; }
typedef float f32x2 __attribute__((ext_vector_type(2)));
__device__ __forceinline__ f32x2 gelu_pk(f32x2 v) {
    const f32x2 av = __builtin_elementwise_abs(v), d = av * 0.2316418882f + 1.0f;
    f32x2 t; t.x = __builtin_amdgcn_rcpf(d.x); t.y = __builtin_amdgcn_rcpf(d.y);
    f32x2 q = t * 0.5307027145f + (-0.7265760135f); q = q * t + 0.7107068705f; q = q * t + (-0.142248368f); q = q * t + 0.127414796f; q = q * t;
    const f32x2 s = (v * v) * (-0.72134752044f);
    f32x2 e; e.x = __builtin_amdgcn_exp2f(s.x); e.y = __builtin_amdgcn_exp2f(s.y);
    const f32x2 m = v * (q * e), r = v - m;
    f32x2 o; o.x = v.x < 0.f ? m.x : r.x; o.y = v.y < 0.f ? m.y : r.y; return o;
}

template <int ACT  > struct EpiBf16 {
    static constexpr bool PERM = true, AFTER_DRAIN = false; static_assert(ACT == 0 || ACT == 1, "EpiBf16: ACT is 0 (none) or 1 (gelu_pk)");
    bf16_t* O; int ldc; const float* bias; int split_cols; size_t split_stride; float scale0;
    __device__ __forceinline__ void operator()(const f32x4 (&acc)[2][2][4][2], const Unit& u, int wr, int wc, int fr, int fq) const {
        const int row0 = u.pm * BM + wr * 64 + fr; int colt = u.pn * BM; bf16_t* base = O;
        float sc = 1.f; if (split_cols) { const int t = colt / split_cols; base += (size_t)t * split_stride; colt -= t * split_cols; if (t == 0) sc = scale0; }
        const int col0 = colt + wc * 32 + 8 * fq, bcol0 = u.pn * BM + wc * 32 + 8 * fq;
        f32x4 bv[2][2];
#pragma unroll
        for (int bj = 0; bj < 2; ++bj)
#pragma unroll
            for (int n = 0; n < 2; ++n) bv[bj][n] = bias ? *(const f32x4*)(bias + bcol0 + bj * HALF + 4 * n) : (f32x4){0.f, 0.f, 0.f, 0.f};
#pragma unroll
        for (int ai = 0; ai < 2; ++ai)
#pragma unroll
            for (int m = 0; m < 4; ++m) { bf16_t* rowp = base + (size_t)(row0 + ai * HALF + m * 16) * ldc + col0;
#pragma unroll
                for (int bj = 0; bj < 2; ++bj) { f32x4 v0 = acc[ai][bj][m][0] + bv[bj][0], v1 = acc[ai][bj][m][1] + bv[bj][1];
                    if (ACT == 1) { f32x2 a = gelu_pk((f32x2){v0[0], v0[1]}), b = gelu_pk((f32x2){v0[2], v0[3]}), c = gelu_pk((f32x2){v1[0], v1[1]}), d = gelu_pk((f32x2){v1[2], v1[3]});
                        v0 = (f32x4){a.x, a.y, b.x, b.y}; v1 = (f32x4){c.x, c.y, d.x, d.y}; }
                    v0 = v0 * sc; v1 = v1 * sc; u32x4 w; w.x = cvt_pk_bf16(v0[0], v0[1]); w.y = cvt_pk_bf16(v0[2], v0[3]); w.z = cvt_pk_bf16(v1[0], v1[1]); w.w = cvt_pk_bf16(v1[2], v1[3]);
                    *(u32x4*)(rowp + bj * HALF) = w; } }
    }
};

typedef unsigned u32x2 __attribute__((ext_vector_type(2)));
__device__ __forceinline__ float rstd_row(const float* ss, int row) {
    const float s = __hip_atomic_load(ss + row, __ATOMIC_RELAXED, __HIP_MEMORY_SCOPE_AGENT);
    return 1.0f / sqrtf(s * (1.0f / 1024.0f) + 1e-6f);
}
__device__ __forceinline__ float fast_sigmoid(float v) { return __builtin_amdgcn_rcpf(1.0f + __builtin_amdgcn_exp2f(-1.4426950408889634f * v)); }
struct EpiSwiGLU {
    static constexpr bool PERM = true, AFTER_DRAIN = false;
    bf16_t* H; const float* ss;
    __device__ __forceinline__ void operator()(const f32x4 (&acc)[2][2][4][2], const Unit& u, int wr, int wc, int fr, int fq) const {
        const int hc0 = u.pn * 128 + wc * 32 + 8 * fq;
#pragma unroll
        for (int ai = 0; ai < 2; ++ai)
#pragma unroll
            for (int m = 0; m < 4; ++m) { const int row = u.pm * BM + ai * HALF + wr * 64 + m * 16 + fr; const float rs = rstd_row(ss, row);
                float hv[8];
#pragma unroll
                for (int n = 0; n < 2; ++n)
#pragma unroll
                    for (int e = 0; e < 4; ++e) { const float g = acc[ai][0][m][n][e] * rs, uu = acc[ai][1][m][n][e] * rs; hv[4 * n + e] = g * fast_sigmoid(g) * uu; }
                u32x4 w; w.x = cvt_pk_bf16(hv[0], hv[1]); w.y = cvt_pk_bf16(hv[2], hv[3]); w.z = cvt_pk_bf16(hv[4], hv[5]); w.w = cvt_pk_bf16(hv[6], hv[7]);
                *(u32x4*)(H + (size_t)row * 2816 + hc0) = w; }
    }
};
struct EpiResid {
    static constexpr bool PERM = true, AFTER_DRAIN = false;
    const float* xin; float* xout; bf16_t* xb; float* ss; float alpha;
    __device__ __forceinline__ void operator()(const f32x4 (&acc)[2][2][4][2], const Unit& u, int wr, int wc, int fr, int fq) const {
        const int col0 = u.pn * BM + wc * 32 + 8 * fq;
#pragma unroll
        for (int ai = 0; ai < 2; ++ai) {
            f32x4 xi[4][2][2];
#pragma unroll
            for (int m = 0; m < 4; ++m) { const size_t off = (size_t)(u.pm * BM + ai * HALF + wr * 64 + m * 16 + fr) * 1024 + col0;
#pragma unroll
                for (int bj = 0; bj < 2; ++bj) { xi[m][bj][0] = *(const f32x4*)(xin + off + bj * HALF); xi[m][bj][1] = *(const f32x4*)(xin + off + bj * HALF + 4); } }
            asm volatile("" ::: "memory");
#pragma unroll
            for (int m = 0; m < 4; ++m) { const int row = u.pm * BM + ai * HALF + wr * 64 + m * 16 + fr; const size_t off = (size_t)row * 1024 + col0; float s = 0.f;
#pragma unroll
                for (int bj = 0; bj < 2; ++bj) { const f32x4 o0 = xi[m][bj][0] + acc[ai][bj][m][0] * alpha, o1 = xi[m][bj][1] + acc[ai][bj][m][1] * alpha;
                    *(f32x4*)(xout + off + bj * HALF) = o0; *(f32x4*)(xout + off + bj * HALF + 4) = o1;
                    s += (o0[0] * o0[0] + o0[1] * o0[1]) + (o0[2] * o0[2] + o0[3] * o0[3]) + (o1[0] * o1[0] + o1[1] * o1[1]) + (o1[2] * o1[2] + o1[3] * o1[3]);
                    u32x4 w; w.x = cvt_pk_bf16(o0[0], o0[1]); w.y = cvt_pk_bf16(o0[2], o0[3]); w.z = cvt_pk_bf16(o1[0], o1[1]); w.w = cvt_pk_bf16(o1[2], o1[3]);
                    *(u32x4*)(xb + off + bj * HALF) = w; }
                s += shx(s, 16, (fr | (fq << 4))); s += shx(s, 32, (fr | (fq << 4)));
                if (fq == 0) __hip_atomic_fetch_add(ss + row, s, __ATOMIC_RELAXED, __HIP_MEMORY_SCOPE_AGENT); }
            asm volatile("" ::: "memory"); }
    }
};
struct EpiQKV {
    static constexpr bool PERM = true, AFTER_DRAIN = false;
    bf16_t* Q; size_t split_stride; const float* ss; float scale0; float* nrm;
    __device__ __forceinline__ void operator()(const f32x4 (&acc)[2][2][4][2], const Unit& u, int wr, int wc, int fr, int fq) const {
        int colt = u.pn * BM; const int t = colt >> 10; bf16_t* base = Q + (size_t)t * split_stride; colt -= t << 10; const float sc = (t == 0) ? scale0 : 1.f;
        const int col0 = colt + wc * 32 + 8 * fq; float mx[2][2] = {{0.f, 0.f}, {0.f, 0.f}};
#pragma unroll
        for (int ai = 0; ai < 2; ++ai)
#pragma unroll
            for (int m = 0; m < 4; ++m) { const int row = u.pm * BM + ai * HALF + wr * 64 + m * 16 + fr; const float rs = rstd_row(ss, row) * sc; bf16_t* rowp = base + (size_t)row * 1024 + col0;
#pragma unroll
                for (int bj = 0; bj < 2; ++bj) { const f32x4 v0 = acc[ai][bj][m][0] * rs, v1 = acc[ai][bj][m][1] * rs;
                    { float q = (v0[0] * v0[0] + v0[1] * v0[1]) + (v0[2] * v0[2] + v0[3] * v0[3]) + (v1[0] * v1[0] + v1[1] * v1[1]) + (v1[2] * v1[2] + v1[3] * v1[3]);
                      q += shx(q, 16, (fr | (fq << 4))); q += shx(q, 32, (fr | (fq << 4))); mx[ai][bj] = fmaxf(mx[ai][bj], q); }
                    u32x4 w; w.x = cvt_pk_bf16(v0[0], v0[1]); w.y = cvt_pk_bf16(v0[2], v0[3]); w.z = cvt_pk_bf16(v1[0], v1[1]); w.w = cvt_pk_bf16(v1[2], v1[3]);
                    *(u32x4*)(rowp + bj * HALF) = w; } }
        if (t < 2) {
#pragma unroll
            for (int ai = 0; ai < 2; ++ai)
#pragma unroll
                for (int bj = 0; bj < 2; ++bj) { float q = mx[ai][bj]; q = fmaxf(q, shx(q, 1, (fr | (fq << 4)))); q = fmaxf(q, shx(q, 2, (fr | (fq << 4)))); q = fmaxf(q, shx(q, 4, (fr | (fq << 4)))); q = fmaxf(q, shx(q, 8, (fr | (fq << 4))));
                    const int head = (colt + bj * HALF + wc * 32) >> 6, rt = (u.pm * BM + ai * HALF + wr * 64) >> 6;
                    if (fr == 0 && fq == 0) nrm[(((size_t)t * 16 + head) * 256 + rt) * 2 + (wc & 1)] = q; } }
    }
};
__device__ __forceinline__ float gelu_tanh(float v) { const float u2 = 1.5957691216057308f * (v + 0.044715f * v * v * v); return v * fast_sigmoid(u2); }
struct EpiLruIn {
    static constexpr bool PERM = true, AFTER_DRAIN = false;
    bf16_t* GATE; bf16_t* REC; const float* ss;
    __device__ __forceinline__ void operator()(const f32x4 (&acc)[2][2][4][2], const Unit& u, int wr, int wc, int fr, int fq) const {
        const bool isg = u.pn < 5; bf16_t* base = isg ? GATE : REC; const int col0 = (isg ? u.pn : u.pn - 5) * BM + wc * 32 + 8 * fq;
#pragma unroll
        for (int ai = 0; ai < 2; ++ai)
#pragma unroll
            for (int m = 0; m < 4; ++m) { const int row = u.pm * BM + ai * HALF + wr * 64 + m * 16 + fr; const float rs = rstd_row(ss, row); bf16_t* rowp = base + (size_t)row * 1280 + col0;
#pragma unroll
                for (int bj = 0; bj < 2; ++bj) { f32x4 v0 = acc[ai][bj][m][0] * rs, v1 = acc[ai][bj][m][1] * rs;
                    if (isg) {
#pragma unroll
                        for (int e = 0; e < 4; ++e) { v0[e] = gelu_tanh(v0[e]); v1[e] = gelu_tanh(v1[e]); } }
                    u32x4 w; w.x = cvt_pk_bf16(v0[0], v0[1]); w.y = cvt_pk_bf16(v0[2], v0[3]); w.z = cvt_pk_bf16(v1[0], v1[1]); w.w = cvt_pk_bf16(v1[2], v1[3]);
                    *(u32x4*)(rowp + bj * HALF) = w; } }
    }
};
template <class Epi, class Sched, bool ALIGN_EPI = false, bool SP2 = false>
__device__ __forceinline__ void gemm_phase(PG8_LAS unsigned char* lds, const Gemm g, const Sched& S, const Epi& E) {
    const int tid = otid(), wid = __builtin_amdgcn_readfirstlane(tid >> 6), lane = tid & 63, wr = wid >> 2, wc = wid & 3, fr = lane & 15, fq = lane >> 4;
    const int K = g.K, nt = K / BK;
    unsigned voffA[2], voffB[2];
#pragma unroll
    for (int i = 0; i < 2; ++i) { int R, C; stage_rc(tid * 16 + i * 8192, R, C); const int Rb = Epi::PERM ? ((R & ~31) + perm32(R & 31)) : R;
        voffA[i] = (unsigned)(R * K + C) * 2u; voffB[i] = (unsigned)(Rb * K + C) * 2u; }
    const size_t kstep = (size_t)(BK * 2);
    const size_t hstep = (size_t)HALF * K * 2;
    const size_t tstep = 2 * hstep;
    const unsigned ldsw = (unsigned)wid * 1024u;
    const int aoff = lds_byte(wr * 64 + fr, fq * 8), boff = lds_byte(wc * 32 + fr, fq * 8);
#define PG8_SA(b, h) (((b) * 2 + (h)) * HTB)
#define PG8_SB(b, h) ((4 + (b) * 2 + (h)) * HTB)
#define PG8_STAGE(bufoff, gbase, voff) do { _Pragma("unroll") for (int _i = 0; _i < 2; ++_i) \
        __builtin_amdgcn_global_load_lds((const unsigned*)((const char*)(gbase) + (voff)[_i]), (PG8_LAS unsigned*)(lds + (bufoff) + ldsw + _i * 8192), 16, 0, 0); } while (0)
#define PG8_LDA(dst, b, h) do { _Pragma("unroll") for (int m = 0; m < 4; ++m) _Pragma("unroll") for (int k = 0; k < 2; ++k) dst[m][k] = *(const PG8_LAS bf16x8*)(lds + PG8_SA(b, h) + aoff + m * 2048 + k * 1024); } while (0)
#define PG8_LDB(dst, b, h) do { _Pragma("unroll") for (int n = 0; n < 2; ++n) _Pragma("unroll") for (int k = 0; k < 2; ++k) dst[n][k] = *(const PG8_LAS bf16x8*)(lds + PG8_SB(b, h) + boff + n * 2048 + k * 1024); } while (0)
#define PG8_MMA(ai, bj, At, Bt) do { __builtin_amdgcn_s_setprio(1); _Pragma("unroll") for (int m = 0; m < 4; ++m) _Pragma("unroll") for (int n = 0; n < 2; ++n) _Pragma("unroll") for (int k = 0; k < 2; ++k) \
        acc[ai][bj][m][n] = __builtin_amdgcn_mfma_f32_16x16x32_bf16(Bt[n][k], At[m][k], acc[ai][bj][m][n], 0, 0, 0); __builtin_amdgcn_s_setprio(0); } while (0)
#define PG8_WAIT_V(n) asm volatile("s_waitcnt vmcnt(" #n ")" ::: "memory")
#define PG8_WAIT_L(n) asm volatile("s_waitcnt lgkmcnt(" #n ")" ::: "memory")
#define PG8_BAR __builtin_amdgcn_s_barrier()
#define PG8_SCHED __builtin_amdgcn_sched_barrier(0)
    Unit cur, nxt; int ui = 0;
    if (!S.next(0, cur)) return;
    f32x4 acc[2][2][4][2];
#pragma unroll
    for (int a = 0; a < 2; ++a)
#pragma unroll
        for (int b = 0; b < 2; ++b)
#pragma unroll
            for (int m = 0; m < 4; ++m)
#pragma unroll
                for (int n = 0; n < 2; ++n) acc[a][b][m][n] = (f32x4){0.f, 0.f, 0.f, 0.f};
    bf16x8 At[4][2], B0[2][2], B1[2][2];
    const char* cA = (const char*)g.A + (size_t)cur.pm * tstep; const char* cB = (const char*)g.Bt + (size_t)cur.pn * tstep;
    S.a_ready(cur);
    if constexpr (SP2) {
        PG8_STAGE(PG8_SB(0, 0), cB, voffB); PG8_STAGE(PG8_SB(0, 1), cB + hstep, voffB); PG8_STAGE(PG8_SA(0, 0), cA, voffA); PG8_STAGE(PG8_SA(0, 1), cA + hstep, voffA);
        if (wr == 1) PG8_BAR;
        PG8_WAIT_V(2); PG8_BAR;
        PG8_STAGE(PG8_SB(1, 0), cB + kstep, voffB); PG8_STAGE(PG8_SA(1, 0), cA + kstep, voffA); PG8_STAGE(PG8_SB(1, 1), cB + hstep + kstep, voffB);
        PG8_WAIT_V(6); PG8_BAR;
    } else {
        PG8_STAGE(PG8_SB(0, 0), cB, voffB); PG8_STAGE(PG8_SA(0, 0), cA, voffA); PG8_STAGE(PG8_SB(0, 1), cB + hstep, voffB); PG8_STAGE(PG8_SA(0, 1), cA + hstep, voffA);
        if (wr == 1) PG8_BAR;
        PG8_WAIT_V(4); PG8_BAR;
        PG8_STAGE(PG8_SB(1, 0), cB + kstep, voffB); PG8_STAGE(PG8_SA(1, 0), cA + kstep, voffA); PG8_STAGE(PG8_SB(1, 1), cB + hstep + kstep, voffB);
        PG8_WAIT_V(6); PG8_BAR;
    }
    for (;;) {
        const bool has_next = S.next(ui + 1, nxt);
        const char* nA = has_next ? (const char*)g.A + (size_t)nxt.pm * tstep : cA; const char* nB = has_next ? (const char*)g.Bt + (size_t)nxt.pn * tstep : cB;
        for (int t = 0; t < nt; t += 2) {
            const bool last = (t == nt - 2);
            const char* a1 = cA + (size_t)(t + 1) * kstep;
            const char* a2 = last ? nA : cA + (size_t)(t + 2) * kstep; const char* b2 = last ? nB : cB + (size_t)(t + 2) * kstep;
            const char* a3 = a2 + kstep; const char* b3 = b2 + kstep;
            if (last && has_next) S.a_ready(nxt);
            if constexpr (SP2) {
            PG8_LDB(B0, 0, 0); PG8_LDB(B1, 0, 1); PG8_SCHED; PG8_LDA(At, 0, 0); PG8_STAGE(PG8_SA(1, 1), a1 + hstep, voffA);
            PG8_WAIT_V(8); PG8_WAIT_L(0); PG8_BAR; PG8_MMA(0, 0, At, B0); PG8_MMA(0, 1, At, B1); PG8_BAR; PG8_SCHED;
            PG8_LDA(At, 0, 1); PG8_STAGE(PG8_SB(0, 0), b2, voffB); PG8_STAGE(PG8_SB(0, 1), b2 + hstep, voffB); PG8_STAGE(PG8_SA(0, 0), a2, voffA);
            PG8_WAIT_V(8); PG8_WAIT_L(0); PG8_BAR; PG8_MMA(1, 0, At, B0); PG8_MMA(1, 1, At, B1); PG8_BAR; PG8_SCHED;
            PG8_LDB(B0, 1, 0); PG8_LDB(B1, 1, 1); PG8_SCHED; PG8_LDA(At, 1, 0); PG8_STAGE(PG8_SA(0, 1), a2 + hstep, voffA);
            PG8_WAIT_V(8); PG8_WAIT_L(0); PG8_BAR; PG8_MMA(0, 0, At, B0); PG8_MMA(0, 1, At, B1); PG8_BAR; PG8_SCHED;
            PG8_LDA(At, 1, 1); PG8_STAGE(PG8_SB(1, 0), b3, voffB); PG8_STAGE(PG8_SB(1, 1), b3 + hstep, voffB); PG8_STAGE(PG8_SA(1, 0), a3, voffA);
            PG8_WAIT_V(8); PG8_WAIT_L(0); PG8_BAR; PG8_MMA(1, 0, At, B0); PG8_MMA(1, 1, At, B1); PG8_BAR; PG8_SCHED;
            } else {
            PG8_LDB(B0, 0, 0); PG8_SCHED; PG8_LDA(At, 0, 0); PG8_STAGE(PG8_SA(1, 1), a1 + hstep, voffA);
            PG8_WAIT_L(8); PG8_BAR; PG8_WAIT_L(0); PG8_MMA(0, 0, At, B0); PG8_BAR; PG8_SCHED;
            PG8_LDB(B1, 0, 1); PG8_STAGE(PG8_SB(0, 0), b2, voffB);
            PG8_BAR; PG8_WAIT_L(0); PG8_MMA(0, 1, At, B1); PG8_BAR;
            PG8_LDA(At, 0, 1); PG8_STAGE(PG8_SA(0, 0), a2, voffA);
            PG8_BAR; PG8_WAIT_L(0); PG8_MMA(1, 0, At, B0); PG8_BAR; PG8_SCHED;
            PG8_STAGE(PG8_SB(0, 1), b2 + hstep, voffB);
            PG8_WAIT_V(6); PG8_BAR; PG8_MMA(1, 1, At, B1); PG8_BAR;
            PG8_LDB(B0, 1, 0); PG8_SCHED; PG8_LDA(At, 1, 0); PG8_STAGE(PG8_SA(0, 1), a2 + hstep, voffA);
            PG8_WAIT_L(8); PG8_BAR; PG8_WAIT_L(0); PG8_MMA(0, 0, At, B0); PG8_BAR; PG8_SCHED;
            PG8_LDB(B1, 1, 1); PG8_STAGE(PG8_SB(1, 0), b3, voffB);
            PG8_BAR; PG8_WAIT_L(0); PG8_MMA(0, 1, At, B1); PG8_BAR;
            PG8_LDA(At, 1, 1); PG8_STAGE(PG8_SA(1, 0), a3, voffA);
            PG8_BAR; PG8_WAIT_L(0); PG8_MMA(1, 0, At, B0); PG8_BAR; PG8_SCHED;
            PG8_STAGE(PG8_SB(1, 1), b3 + hstep, voffB);
            PG8_WAIT_V(6); PG8_BAR; PG8_MMA(1, 1, At, B1); PG8_BAR;
            }
        }
        if constexpr (ALIGN_EPI) { if (wr == 0) PG8_BAR; }
        if constexpr (!Epi::AFTER_DRAIN) { E(acc, cur, wr, wc, fr, fq); S.done(cur); }
        if (!has_next) break;
#pragma unroll
        for (int a = 0; a < 2; ++a)
#pragma unroll
            for (int b = 0; b < 2; ++b)
#pragma unroll
                for (int m = 0; m < 4; ++m)
#pragma unroll
                    for (int n = 0; n < 2; ++n) acc[a][b][m][n] = (f32x4){0.f, 0.f, 0.f, 0.f};
        cur = nxt; cA = nA; cB = nB; ++ui;
        if constexpr (ALIGN_EPI) { if (wr == 1) PG8_BAR; }
    }
    PG8_WAIT_V(0);
    if constexpr (!ALIGN_EPI) { if (wr == 0) PG8_BAR; }
    PG8_BAR;
    if constexpr (Epi::AFTER_DRAIN) { E.fused(acc, cur, wr, wc, fr, fq, lds, wid, lane); S.done(cur); }
#undef PG8_SA
#undef PG8_SB
#undef PG8_STAGE
#undef PG8_LDA
#undef PG8_LDB
#undef PG8_MMA
#undef PG8_WAIT_V
#undef PG8_WAIT_L
#undef PG8_BAR
#undef PG8_SCHED
}
}

#ifndef PG8_SP2
#define PG8_SP2 true
#endif
#ifndef PG8_ALIGN
#define PG8_ALIGN true
#endif
#include <hip/hip_bf16.h>
#include <cmath>
namespace attn_body {
using bf16=__hip_bfloat16;
using bf16x8=__attribute__((ext_vector_type(8)))short;
using s16x4=__attribute__((ext_vector_type(4)))short;
using f32x16=__attribute__((ext_vector_type(16)))float;
using u32x4=__attribute__((ext_vector_type(4)))unsigned;
constexpr int BATCH=2,NHEAD=16,SEQ=8192,D=64,DM=NHEAD*D;
constexpr int NW=8,QBLK=32,QB=QBLK*NW,KVBLK=64,NQB=SEQ/QB;
constexpr int ATTN_PITCH=DM, ATTN_UNIT_ROWS=QB;
__device__ __forceinline__ int crow(int r,int hi){return (r&3)+8*(r>>2)+4*hi;}
#define SBAR() __builtin_amdgcn_sched_barrier(0)
__device__ __forceinline__ void cmask(f32x16&p0,f32x16&p1,int jb,int qrel,int hi){
  const float NEG=-INFINITY; int kb=64*jb+4*hi;
  #pragma unroll
  for(int r=0;r<16;++r){int kv=kb+(r&3)+8*(r>>2); if(kv>qrel)p0[r]=NEG; if(kv+32>qrel)p1[r]=NEG;}
}

constexpr int NSLOT=3, SLOTB=8192;
constexpr int LDS_K=0, LDS_V=NSLOT*SLOTB, LDS_WS=2*NSLOT*SLOTB, LDS_OST=LDS_WS+NW*64*4, LDS_BYTES=LDS_OST+NW*4096;
constexpr float C2=0.125f*1.4426950408889634f;
__device__ __forceinline__ void glds16(const void*gsrc,unsigned lds_dst){unsigned keep;
  asm volatile("s_mov_b32 %0, m0\n\ts_mov_b32 m0, %2\n\ts_nop 0\n\tglobal_load_lds_dwordx4 %1, off\n\ts_mov_b32 m0, %0":"=&s"(keep):"v"(gsrc),"s"(lds_dst):"memory");}
__device__ __forceinline__ float max3f(float a,float b,float c){float r;asm("v_max3_f32 %0, %1, %2, %3":"=v"(r):"v"(a),"v"(b),"v"(c));return r;}
__device__ __forceinline__ float max2f(float a,float b){float r;asm("v_max_f32_e32 %0, %1, %2":"=v"(r):"v"(a),"v"(b));return r;}
__device__ __forceinline__ float fadd_s(float a,float b){float r;asm("v_add_f32_e32 %0, %1, %2":"=v"(r):"v"(a),"v"(b));return r;}
__device__ __forceinline__ float fsub_s(float a,float b){float r;asm("v_sub_f32_e32 %0, %1, %2":"=v"(r):"v"(a),"v"(b));return r;}
typedef float f32x2_t __attribute__((ext_vector_type(2))); typedef __bf16 bf16x2_t __attribute__((ext_vector_type(2)));
__device__ __forceinline__ unsigned cvtpk_s(float lo,float hi){f32x2_t v={lo,hi};bf16x2_t b=__builtin_convertvector(v,bf16x2_t);return __builtin_bit_cast(unsigned,b);}
#define WAIT_BAR(N) asm volatile("s_waitcnt vmcnt(" #N ") lgkmcnt(0)\n\ts_barrier":::"memory")

typedef __attribute__((address_space(3))) const float* lds_fptr; typedef float f32x4_t __attribute__((ext_vector_type(4))); typedef __attribute__((address_space(3))) const f32x4_t* lds_f4ptr;
__device__ __forceinline__ void qkt(f32x16&p0,f32x16&p1,const char*Kslot,const bf16x8*qr,int r32,int hi){
  const char*kb=Kslot+hi*1024+r32*16;
  #pragma unroll
  for(int d0=0;d0<4;++d0){
    const bf16x8 b0=*reinterpret_cast<const bf16x8*>(kb+d0*2048);
    const bf16x8 b1=*reinterpret_cast<const bf16x8*>(kb+d0*2048+512);
    p0=__builtin_amdgcn_mfma_f32_32x32x16_bf16(b0,qr[d0],p0,0,0,0);p1=__builtin_amdgcn_mfma_f32_32x32x16_bf16(b1,qr[d0],p1,0,0,0);}
}
typedef __attribute__((address_space(3))) const char* lds_cptr;
typedef short v4i16_t __attribute__((ext_vector_type(4)));
__device__ __forceinline__ void kload8(bf16x8*kf,lds_cptr kp){
  kf[0]=*(const __attribute__((address_space(3))) bf16x8*)(kp);      kf[1]=*(const __attribute__((address_space(3))) bf16x8*)(kp+512);
  kf[2]=*(const __attribute__((address_space(3))) bf16x8*)(kp+2048); kf[3]=*(const __attribute__((address_space(3))) bf16x8*)(kp+2560);
  kf[4]=*(const __attribute__((address_space(3))) bf16x8*)(kp+4096); kf[5]=*(const __attribute__((address_space(3))) bf16x8*)(kp+4608);
  kf[6]=*(const __attribute__((address_space(3))) bf16x8*)(kp+6144); kf[7]=*(const __attribute__((address_space(3))) bf16x8*)(kp+6656);
}
__device__ __forceinline__ void kload2(bf16x8*kf,lds_cptr kp,int j){ kf[2*j]=*(const __attribute__((address_space(3))) bf16x8*)(kp+j*2048); kf[2*j+1]=*(const __attribute__((address_space(3))) bf16x8*)(kp+j*2048+512); }
__device__ __forceinline__ s16x4 vtr(lds_cptr p){ return __builtin_bit_cast(s16x4,__builtin_amdgcn_ds_read_tr16_b64_v4i16((__attribute__((address_space(3))) v4i16_t*)p)); }
__device__ __forceinline__ float rowmax(const f32x16&p0,const f32x16&p1){
  float a=max3f(p0[0],p0[1],p1[0]),b=max3f(p0[2],p0[3],p1[1]);a=max3f(a,p1[2],p1[3]);
  #pragma unroll
  for(int r=4;r<16;r+=4){a=max3f(a,p0[r],p0[r+1]);b=max3f(b,p0[r+2],p0[r+3]);a=max3f(a,p1[r],p1[r+1]);b=max3f(b,p1[r+2],p1[r+3]);}
  const float m=max2f(a,b);
  auto rr=__builtin_amdgcn_permlane32_swap(__float_as_uint(m),__float_as_uint(m),false,false);
  return max2f(__uint_as_float(rr[0]),__uint_as_float(rr[1]));
}
__device__ __forceinline__ void pv(f32x16*o,int vb,bf16x8 pa0,bf16x8 pa1,bf16x8 pa2,bf16x8 pa3){
  #pragma unroll
  for(int d0=0;d0<2;++d0){s16x4 lo[4],hi[4];
    #pragma unroll
    for(int ks=0;ks<4;++ks){
      asm volatile("ds_read_b64_tr_b16 %0,%1 offset:%c2":"=&v"(lo[ks]):"v"(vb),"i"(d0*4096+ks*1024):"memory");
      asm volatile("ds_read_b64_tr_b16 %0,%1 offset:%c2":"=&v"(hi[ks]):"v"(vb),"i"(d0*4096+ks*1024+512):"memory");}
    asm volatile("s_waitcnt lgkmcnt(0)":::"memory");SBAR();
    #define PK(k) (bf16x8){lo[k][0],lo[k][1],lo[k][2],lo[k][3],hi[k][0],hi[k][1],hi[k][2],hi[k][3]}
    o[d0]=__builtin_amdgcn_mfma_f32_32x32x16_bf16(pa0,PK(0),o[d0],0,0,0);
    o[d0]=__builtin_amdgcn_mfma_f32_32x32x16_bf16(pa1,PK(1),o[d0],0,0,0);
    o[d0]=__builtin_amdgcn_mfma_f32_32x32x16_bf16(pa2,PK(2),o[d0],0,0,0);
    o[d0]=__builtin_amdgcn_mfma_f32_32x32x16_bf16(pa3,PK(3),o[d0],0,0,0);
    #undef PK
  }
}

#ifndef ATTN_STORE16
#define ATTN_STORE16(p,v) (*(u32x4*)(p)=(v))
#endif
template<int THRL> __device__ __forceinline__ void attn_unit(int b,int h,int qb,const bf16*Q,const bf16*__restrict__ K,const bf16*__restrict__ V,bf16*O,char*shm,lds_fptr Gp,int tstart){
  const int tid=otid(),lane=tid&63,r32=lane&31,hi=lane>>5; const int wid=__builtin_amdgcn_readfirstlane(tid>>6);
  const long rowbase=(long)b*SEQ; const int q0=qb*QB;
  const bf16*Qw=Q+(rowbase+q0+wid*QBLK)*DM+h*D;
  const bf16*Kh=K+(rowbase+(long)tstart*KVBLK)*DM+h*D,*Vh=V+(rowbase+(long)tstart*KVBLK)*DM+h*D; const lds_fptr Gk=Gp+KVBLK*tstart;
  const unsigned lds0=(unsigned)(uintptr_t)shm;
  float*wsf=(float*)(shm+LDS_WS)+wid*64;
  const bf16*ksrc=Kh+(long)lane*DM+wid*8;
  const bf16*vsrc=Vh+(long)(16*(wid&3)+(lane>>2))*DM+(wid>>2)*32+(lane&3)*8;
  const unsigned kdst=lds0+LDS_K+wid*1024, vdst=lds0+LDS_V+wid*1024;
  #define DMA_K(t,slot) glds16(ksrc+(long)(t)*KVBLK*DM,(unsigned)__builtin_amdgcn_readfirstlane(kdst+(slot)))
  #define DMA_V(t,slot) glds16(vsrc+(long)(t)*KVBLK*DM,(unsigned)__builtin_amdgcn_readfirstlane(vdst+(slot)))
  const int vb0=(int)(lds0+LDS_V)+((lane>>4)&1)*32+(lane&3)*8+(4*hi+((lane&15)>>2))*64;
  const char*Kbase=shm+LDS_K; bf16x8 kf[8];
  const lds_cptr shm3=(lds_cptr)shm; const lds_cptr kp0=shm3+LDS_K+hi*1024+r32*16; const lds_cptr vp0=shm3+LDS_V+((lane>>4)&1)*32+(lane&3)*8+(4*hi+((lane&15)>>2))*64;
  const int NT=(q0+QB)/KVBLK-tstart;
  DMA_K(0,0);DMA_V(0,0);DMA_K(1,SLOTB);
  bf16x8 qr[4];
  #pragma unroll
  for(int d0=0;d0<4;++d0)qr[d0]=*reinterpret_cast<const bf16x8*>(&Qw[(long)r32*DM+d0*16+hi*8]);
  float mhat=0.f,l_reg=0.f;f32x16 o[2];o[0]=f32x16{};o[1]=f32x16{};
  const float Gq=Gp[q0+wid*QBLK+r32]; float negmq=Gq;
  #define BIAS_LD(X0,X1,t) do{ const lds_f4ptr gp_=(lds_f4ptr)(Gk+64*(t)+4*hi); _Pragma("unroll") for(int j_=0;j_<4;++j_){ const f32x4_t a_=gp_[2*j_], b_=gp_[8+2*j_]; \
      X0[4*j_]=a_[0];X0[4*j_+1]=a_[1];X0[4*j_+2]=a_[2];X0[4*j_+3]=a_[3]; X1[4*j_]=b_[0];X1[4*j_+1]=b_[1];X1[4*j_+2]=b_[2];X1[4*j_+3]=b_[3]; } }while(0)
  #define BSUB4(X,B) do{ X[B]=negmq-X[B]; X[(B)+1]=negmq-X[(B)+1]; X[(B)+2]=negmq-X[(B)+2]; X[(B)+3]=negmq-X[(B)+3]; }while(0)
  #define BSUBALL(X0,X1) do{ _Pragma("unroll") for(int r_=0;r_<16;++r_){ X0[r_]=negmq-X0[r_]; X1[r_]=negmq-X1[r_]; } }while(0)
  const int qrel=wid*QBLK+r32;
  #define CMASK(P0,P1,t) do{int jb_=(t)-(NT-4); if(jb_>=0)cmask(P0,P1,jb_,qrel,hi);}while(0)
  bool resc=false;
  #define START(P0,P1) do{ const float rm=rowmax(P0,P1); resc=false; \
    { const float dl=__builtin_fmaxf(rm,-40.f); mhat=fadd_s(mhat,dl); \
      _Pragma("unroll") for(int r=0;r<16;++r){P0[r]=fsub_s(P0[r],dl);P1[r]=fsub_s(P1[r],dl);} \
      negmq=Gq-mhat; } \
    _Pragma("unroll") for(int r=0;r<16;++r)P0[r]=__builtin_amdgcn_exp2f(P0[r]); }while(0)
  #define RESC() do{ if(resc){ asm volatile("s_waitcnt lgkmcnt(0)":::"memory"); \
      _Pragma("unroll") for(int d_=0;d_<2;++d_) _Pragma("unroll") for(int r=0;r<16;++r)o[d_][r]*=wsf[crow(r,hi)]; } }while(0)
  f32x16 pA0,pA1,pB0,pB1;
  int sl_prev=0,sl_cur=0,sl_next=SLOTB;
  #define ROT() do{sl_prev=sl_cur;sl_cur=sl_next;sl_next=(sl_next==(NSLOT-1)*SLOTB)?0:sl_next+SLOTB;}while(0)
  DMA_K(2,2*SLOTB);
  WAIT_BAR(3);
  BIAS_LD(pA0,pA1,0); BSUBALL(pA0,pA1);
  qkt(pA0,pA1,Kbase,qr,r32,hi);asm volatile("s_nop 15\n\ts_nop 7":"+v"(pA0),"+v"(pA1));CMASK(pA0,pA1,0);
  START(pA0,pA1);
  _Pragma("unroll") for(int r=0;r<16;++r)pA1[r]=__builtin_amdgcn_exp2f(pA1[r]);
  BIAS_LD(pB0,pB1,1); BSUBALL(pB0,pB1);
  WAIT_BAR(0);
  DMA_K(3,0);DMA_V(1,SLOTB);
  ROT();
  kload8(kf,kp0+sl_cur);
  WAIT_BAR(2);
  s16x4 vlo[8],vhi[8]; u32x4 pw0,pw1,pw2,pw3;
  #define PKW(P,B) cvtpk_s(P[B],P[B+1])
  #define PAF(k) __builtin_bit_cast(bf16x8,pw##k)
  #define VFR(i) (bf16x8){vlo[i][0],vlo[i][1],vlo[i][2],vlo[i][3],vhi[i][0],vhi[i][1],vhi[i][2],vhi[i][3]}
  #define PIN(x) asm volatile("":"+v"(x))
  #define MX3(a,b,c) __builtin_fmaxf(__builtin_fmaxf((a),(b)),(c))
  #define GAPA(MF,A0,A1,A2,A3,W0,W1,PW) do{ MF; sacc+=A0; sacc+=A1; sacc+=A2; sacc+=A3; PIN(sacc); W0; W1; PIN(PW); SBAR(); }while(0)
  #define EX(v) __builtin_amdgcn_exp2f(v)
  #define GAPB(MF,X,B,GL_,Y,YB) do{ MF; X[B]=EX(X[B]); X[B+1]=EX(X[B+1]); X[B+2]=EX(X[B+2]); X[B+3]=EX(X[B+3]); PIN(X); if(GL_){ BSUB4(Y,YB); PIN(Y); } SBAR(); }while(0)
  #define VRD(i) do{ vlo[i]=vtr(vp_+(((i)>>2)*4096+((i)&3)*1024)); vhi[i]=vtr(vp_+(((i)>>2)*4096+((i)&3)*1024+512)); }while(0)
  #define KRD(G,j) do{ if(G){ kload2(kf,kp0+sl_next,j); SBAR(); } }while(0)
  #define STEP(C0,C1,P0,P1,t,GK,GV,GL) do{ SBAR(); \
    const lds_cptr vp_=vp0+sl_prev; \
    VRD(0); SBAR(); float sacc=(P0[0]+P0[1]); \
    GAPA(C0=__builtin_amdgcn_mfma_f32_32x32x16_bf16(kf[0],qr[0],C0,0,0,0), P0[2],P0[3],P0[4],P0[5],     pw0[0]=PKW(P0,0), pw0[1]=PKW(P0,2), pw0); \
    VRD(4); SBAR(); GAPA(C1=__builtin_amdgcn_mfma_f32_32x32x16_bf16(kf[1],qr[0],C1,0,0,0), P0[6],P0[7],P0[8],P0[9],     pw0[2]=PKW(P0,4), pw0[3]=PKW(P0,6), pw0); \
    VRD(1); SBAR(); GAPA(C0=__builtin_amdgcn_mfma_f32_32x32x16_bf16(kf[2],qr[1],C0,0,0,0),   P0[10],P0[11],P0[12],P0[13], pw1[0]=PKW(P0,8), pw1[1]=PKW(P0,10), pw1); \
    VRD(5); SBAR(); GAPA(C1=__builtin_amdgcn_mfma_f32_32x32x16_bf16(kf[3],qr[1],C1,0,0,0),   P0[14],P0[15],P1[0],P1[1],   pw1[2]=PKW(P0,12),pw1[3]=PKW(P0,14), pw1); \
    VRD(2); SBAR(); GAPA(C0=__builtin_amdgcn_mfma_f32_32x32x16_bf16(kf[4],qr[2],C0,0,0,0),   P1[2],P1[3],P1[4],P1[5],     pw2[0]=PKW(P1,0), pw2[1]=PKW(P1,2), pw2); \
    VRD(6); SBAR(); GAPA(C1=__builtin_amdgcn_mfma_f32_32x32x16_bf16(kf[5],qr[2],C1,0,0,0),   P1[6],P1[7],P1[8],P1[9],     pw2[2]=PKW(P1,4), pw2[3]=PKW(P1,6), pw2); \
    VRD(3); SBAR(); GAPA(C0=__builtin_amdgcn_mfma_f32_32x32x16_bf16(kf[6],qr[3],C0,0,0,0),   P1[10],P1[11],P1[12],P1[13], pw3[0]=PKW(P1,8), pw3[1]=PKW(P1,10), pw3); \
    VRD(7); SBAR(); GAPA(C1=__builtin_amdgcn_mfma_f32_32x32x16_bf16(kf[7],qr[3],C1,0,0,0),   P1[14],P1[15],0.f,0.f,       pw3[2]=PKW(P1,12),pw3[3]=PKW(P1,14), pw3); \
    l_reg+=sacc; \
    if(GK){DMA_K((t)+3,sl_cur);} if(GV){DMA_V((t)+1,sl_next);} \
    CMASK(C0,C1,t); \
    { float a=MX3(C0[0],C0[1],C1[0]),b=MX3(C0[2],C0[3],C1[1]); a=MX3(a,C1[2],C1[3]); \
      _Pragma("unroll") for(int r=4;r<16;r+=4){a=MX3(a,C0[r],C0[r+1]);b=MX3(b,C0[r+2],C0[r+3]);a=MX3(a,C1[r],C1[r+1]);b=MX3(b,C1[r+2],C1[r+3]);} \
      float rm=__builtin_fmaxf(a,b); { auto rr=__builtin_amdgcn_permlane32_swap(__float_as_uint(rm),__float_as_uint(rm),false,false); rm=__builtin_fmaxf(__uint_as_float(rr[0]),__uint_as_float(rr[1])); } \
      resc=false; \
      if(__builtin_expect(__any(rm>(float)THRL),0)){ const float dl=__builtin_fmaxf(rm,0.f); mhat+=dl; \
        _Pragma("unroll") for(int r=0;r<16;++r){C0[r]-=dl;C1[r]-=dl;} \
        negmq=Gq-mhat; \
        const float f=__builtin_amdgcn_exp2f(-dl); l_reg*=f; if(hi==0)wsf[r32]=f; resc=true; } } \
    if(GL){ BIAS_LD(P0,P1,(t)+1); } \
    SBAR(); \
    GAPB(o[0]=__builtin_amdgcn_mfma_f32_32x32x16_bf16(PAF(0),VFR(0),o[0],0,0,0), C0,0, GL,P0,0); \
    GAPB(o[1]=__builtin_amdgcn_mfma_f32_32x32x16_bf16(PAF(0),VFR(4),o[1],0,0,0), C0,4, GL,P0,4); \
    KRD(GL,0); GAPB(o[0]=__builtin_amdgcn_mfma_f32_32x32x16_bf16(PAF(1),VFR(1),o[0],0,0,0), C0,8, GL,P0,8); \
    KRD(GL,1); GAPB(o[1]=__builtin_amdgcn_mfma_f32_32x32x16_bf16(PAF(1),VFR(5),o[1],0,0,0), C0,12, GL,P0,12); \
    KRD(GL,2); GAPB(o[0]=__builtin_amdgcn_mfma_f32_32x32x16_bf16(PAF(2),VFR(2),o[0],0,0,0), C1,0, GL,P1,0); \
    KRD(GL,3); GAPB(o[1]=__builtin_amdgcn_mfma_f32_32x32x16_bf16(PAF(2),VFR(6),o[1],0,0,0), C1,4, GL,P1,4); \
    GAPB(o[0]=__builtin_amdgcn_mfma_f32_32x32x16_bf16(PAF(3),VFR(3),o[0],0,0,0), C1,8, GL,P1,8); \
    GAPB(o[1]=__builtin_amdgcn_mfma_f32_32x32x16_bf16(PAF(3),VFR(7),o[1],0,0,0), C1,12, GL,P1,12); \
    }while(0)
  int t=1;
  #undef CMASK
  #define CMASK(P0,P1,t) do{}while(0)
  for(;t+5<NT;t+=2){
    STEP(pB0,pB1,pA0,pA1,t,true,true,true);     WAIT_BAR(2); RESC(); ROT();
    STEP(pA0,pA1,pB0,pB1,t+1,true,true,true);   WAIT_BAR(2); RESC(); ROT();
  }
  #undef CMASK
  #define CMASK(P0,P1,t) do{int jb_=(t)-(NT-4); if(jb_>=0)cmask(P0,P1,jb_,qrel,hi);}while(0)
  #define ENDW(tt) do{ if((tt)+3<NT){WAIT_BAR(2);} else if((tt)+2<NT){WAIT_BAR(1);} else {WAIT_BAR(0);} }while(0)
  for(;t+1<NT;t+=2){
    STEP(pB0,pB1,pA0,pA1,t,(t+3<NT),(t+1<NT),(t+1<NT));       ENDW(t);   RESC(); ROT();
    STEP(pA0,pA1,pB0,pB1,t+1,(t+4<NT),(t+2<NT),(t+2<NT));     ENDW(t+1); RESC(); ROT();
  }
  STEP(pB0,pB1,pA0,pA1,NT-1,false,false,false); RESC();
  { float sacc=pB0[0]+pB0[1]; _Pragma("unroll") for(int r=2;r<16;++r)sacc+=pB0[r]; _Pragma("unroll") for(int r=0;r<16;++r)sacc+=pB1[r]; l_reg+=sacc;
    pw0=(u32x4){PKW(pB0,0),PKW(pB0,2),PKW(pB0,4),PKW(pB0,6)};pw1=(u32x4){PKW(pB0,8),PKW(pB0,10),PKW(pB0,12),PKW(pB0,14)};pw2=(u32x4){PKW(pB1,0),PKW(pB1,2),PKW(pB1,4),PKW(pB1,6)};pw3=(u32x4){PKW(pB1,8),PKW(pB1,10),PKW(pB1,12),PKW(pB1,14)};
    SBAR(); pv(o,vb0+sl_cur,PAF(0),PAF(1),PAF(2),PAF(3)); }
  #undef PKW
  #undef PAF
  #undef VFR
  #undef PIN
  #undef MX3
  #undef GAPA
  #undef GAPB
  #undef EX
  #undef VRD
  #undef KRD
  #undef STEP
  #undef ENDW
  {auto rr=__builtin_amdgcn_permlane32_swap(__float_as_uint(l_reg),__float_as_uint(l_reg),false,false);l_reg=__uint_as_float(rr[0])+__uint_as_float(rr[1]);}
  if(hi==0)wsf[32+r32]=l_reg;asm volatile("s_waitcnt lgkmcnt(0)":::"memory");
  float rli[16];
  #pragma unroll
  for(int r=0;r<16;++r)rli[r]=__builtin_amdgcn_rcpf(wsf[32+crow(r,hi)]);
  bf16*Ow=O+(rowbase+q0+wid*QBLK)*DM+h*D;
  { bf16*stg=(bf16*)(shm+LDS_OST)+wid*2048;
    #pragma unroll
    for(int r=0;r<16;++r){const int orow=crow(r,hi);
      #pragma unroll
      for(int d0=0;d0<2;++d0)stg[orow*64+d0*32+r32]=__float2bfloat16(o[d0][r]*rli[r]);}
    asm volatile("s_waitcnt lgkmcnt(0)":::"memory");
    #pragma unroll
    for(int i=0;i<4;++i){const int row=i*8+(lane>>3),ch=lane&7; const u32x4 v=*(const u32x4*)(stg+row*64+ch*8); ATTN_STORE16(Ow+(long)row*DM+ch*8,v);} }
  asm volatile("s_waitcnt lgkmcnt(0)\n\ts_barrier":::"memory");
  #undef DMA_K
  #undef BIAS_LD
  #undef BSUB4
  #undef BSUBALL
  #undef DMA_V
  #undef CMASK
  #undef START
  #undef RESC
  #undef ROT
}
constexpr int ATTN_LDS_BYTES=LDS_BYTES;
#undef SBAR
#undef WAIT_BAR
}
#define GAS __attribute__((address_space(1)))
#define LAS __attribute__((address_space(3)))
typedef unsigned short bf16;
typedef unsigned v4u __attribute__((ext_vector_type(4)));
typedef float f32x4 __attribute__((ext_vector_type(4)));
typedef float f32x2 __attribute__((ext_vector_type(2)));
typedef short bf16x8 __attribute__((ext_vector_type(8)));
constexpr int NWAVES = 8;
constexpr int M = 16384, D = 1024, T = 8192, FF = 2816, NGU = 5632, R = 1280, NH = 16, NQKV = 3072, NFOX = 3088;
constexpr size_t MiB = 1u << 20;
constexpr size_t WS_SS = 0;
constexpr size_t WS_LOGF = 1 * MiB;
constexpr size_t WS_LSUM = 2 * MiB;
constexpr size_t WS_WF = 5 * MiB;
constexpr size_t WS_WLG = 5 * MiB + 512 * 1024;
constexpr size_t WS_NRM = 6 * MiB + 65536;
constexpr size_t WS_FS = 6 * MiB + 131072;
constexpr size_t WS_SP = 6 * MiB;
constexpr size_t WS_WGU = 8 * MiB, WGU_BYTES = 11 * MiB;
constexpr size_t WS_WD = 52 * MiB, WD_BYTES = 5 * MiB + 512 * 1024;
constexpr size_t WS_WQKV = 74 * MiB, WS_WO = 80 * MiB, WS_WLIN = 82 * MiB, WS_WLOUT = 87 * MiB;
constexpr size_t WS_XB = 90 * MiB;
constexpr size_t WS_BIG = 122 * MiB;
constexpr size_t WS_END = 250 * MiB;
constexpr int LDS_BYTES = 147456;
constexpr float LOG2E = 1.4426950408889634f;

__device__ __forceinline__ unsigned f2bf(float f) { unsigned u = __builtin_bit_cast(unsigned, f); return (u + 0x7fffu + ((u >> 16) & 1u)) >> 16; }
__device__ __forceinline__ unsigned pk2(float lo, float hi) { return f2bf(lo) | (f2bf(hi) << 16); }
__device__ __forceinline__ float bf2f(unsigned short b) { return __builtin_bit_cast(float, (unsigned)b << 16); }
__device__ __forceinline__ float wave_sum(float v, int lane) {
#pragma unroll
    for (int o = 1; o < 64; o <<= 1) v += shx(v, o, lane);
    return v;
}

#define XB_TMO      128
#define XB_XCNT(j)  (256  + 64 * (j))
#define XB_XSUB(j)  (1280 + 64 * (j))
#define XB_XGEN(j)  (2304 + 64 * (j))
#define XB_TOP      3328
#define XB_TOPGEN   3392
#define XCD_BAR_WORDS 3456
#define XB_SPIN_CAP (1u << 18)

__device__ __forceinline__ unsigned xb_ld(unsigned* p)              { return __hip_atomic_load(p, __ATOMIC_RELAXED, __HIP_MEMORY_SCOPE_AGENT); }
__device__ __forceinline__ unsigned xb_add(unsigned* p, unsigned v) { return __hip_atomic_fetch_add(p, v, __ATOMIC_RELAXED, __HIP_MEMORY_SCOPE_AGENT); }
__device__ __forceinline__ unsigned xb_xcc_id() { return (unsigned)__builtin_amdgcn_s_getreg((3 << 11) | 20) & 0xFu; }
#define XB_SPIN(cond, bar) do { unsigned _sp = 0; while (cond) { __builtin_amdgcn_s_sleep(1); \
    if ((++_sp & 255u) == 0u) { if (xb_ld(&(bar)[XB_TMO])) break; if (_sp > XB_SPIN_CAP) { atomicAdd(&(bar)[XB_TMO], 1u); break; } } } } while (0)

struct XcdBarrier {
    unsigned* bar; unsigned x;
    volatile LAS unsigned* st;
};

__device__ __forceinline__ XcdBarrier xcd_barrier_post(unsigned* bar, volatile LAS unsigned* st) {
    XcdBarrier b; b.bar = bar; b.x = xb_xcc_id(); b.st = st;
    if (threadIdx.x == 0) (void)xb_add(&bar[XB_XCNT(b.x)], 1u);
    return b;
}
__device__ __forceinline__ void xcd_barrier_complete(unsigned* bar, unsigned x, unsigned& nloc, unsigned& nx) {
    const unsigned G = gridDim.x * gridDim.y * gridDim.z;
    unsigned sum, cnt, mine, sp = 0u;
    for (;;) {
        sum = 0u; cnt = 0u; mine = 0u;
#pragma unroll
        for (unsigned j = 0; j < 16; ++j) { const unsigned c = xb_ld(&bar[XB_XCNT(j)]); sum += c; cnt += (c > 0u) ? 1u : 0u; mine = (j == x) ? c : mine; }
        if (sum == G) break;
        __builtin_amdgcn_s_sleep(1);
        if ((++sp & 255u) == 0u) { if (xb_ld(&bar[XB_TMO])) break; if (sp > XB_SPIN_CAP) { atomicAdd(&bar[XB_TMO], 1u); break; } }
    }
    nloc = mine > 0u ? mine : 1u; nx = cnt > 0u ? cnt : 1u;
}

__device__ __forceinline__ void xcd_barrier(const XcdBarrier& b) {
    asm volatile("s_waitcnt vmcnt(0)" ::: "memory");
    __syncthreads();
    if (threadIdx.x == 0) {
        unsigned* bar = b.bar;
        __builtin_amdgcn_s_waitcnt(0);
        unsigned nloc = b.st[0], nx = b.st[1];
        if (nloc == 0u) { xcd_barrier_complete(bar, b.x, nloc, nx); b.st[0] = nloc; b.st[1] = nx; }
        const unsigned old = xb_add(&bar[XB_XSUB(b.x)], 1u);
        const unsigned gen = old / nloc;
        if (old + 1u == (gen + 1u) * nloc) {
            __builtin_amdgcn_fence(__ATOMIC_RELEASE, "agent");
            asm volatile("s_waitcnt vmcnt(0)" ::: "memory");
            const unsigned og = xb_add(&bar[XB_TOP], 1u);
            const unsigned tg = og / nx;
            if (og + 1u == (tg + 1u) * nx) xb_add(&bar[XB_TOPGEN], 1u);
            else XB_SPIN(xb_ld(&bar[XB_TOPGEN]) == tg, bar);
            __builtin_amdgcn_fence(__ATOMIC_ACQUIRE, "agent");
            xb_add(&bar[XB_XGEN(b.x)], 1u);
            asm volatile("s_waitcnt vmcnt(0)" ::: "memory");
        } else {
            XB_SPIN(xb_ld(&bar[XB_XGEN(b.x)]) == gen, bar);
            __builtin_amdgcn_fence(__ATOMIC_ACQUIRE, "agent");
            asm volatile("s_waitcnt vmcnt(0)" ::: "memory");
        }
    }
    __syncthreads();
}

constexpr size_t WS_BAR = 7 * MiB, BAR_BYTES = 16384;
constexpr int MISC_OFF = 131072 + 320;
struct Args { const float* in[21]; float* out; unsigned char* ws; int ph_lo, ph_hi; };
enum { I_X = 0, I_F1N, I_F1GU, I_F1D, I_MIXN, I_F2N, I_F2GU, I_F2D, I_FOXIN, I_FOXBF, I_FOXOUT, I_LIN, I_LCW, I_LCB, I_LWA, I_LBA, I_LWI, I_LBI, I_LLAM, I_LOUT, I_FINN };

template <bool GU> __device__ __forceinline__ void tr_item(const float* W, int ldw, int K, int nblk, const float* gain, bf16* WT, LAS float* scr, int item, int lane) {
    const int kb = item / nblk, nb = item - kb * nblk, k0 = 64 * kb, n0 = 32 * nb;
#pragma unroll 8
    for (int i = 0; i < 32; ++i) { const int kk = 2 * i + (lane >> 5); float w = W[(size_t)(k0 + kk) * ldw + n0 + (lane & 31)]; if (gain) w *= gain[k0 + kk]; scr[kk * 33 + (lane & 31)] = w; }
    asm volatile("s_waitcnt lgkmcnt(0)" ::: "memory");
    int row0 = n0;
    if (GU) { const int c = (n0 < FF) ? n0 : n0 - FF; row0 = 256 * (c >> 7) + (c & 127) + ((n0 < FF) ? 0 : 128); }
    const int c8 = lane & 7;
#pragma unroll
    for (int j = 0; j < 4; ++j) { const int n = (lane >> 3) + 8 * j; const LAS float* s = scr + (8 * c8) * 33 + n;
        v4u o; o.x = pk2(s[0 * 33], s[1 * 33]); o.y = pk2(s[2 * 33], s[3 * 33]); o.z = pk2(s[4 * 33], s[5 * 33]); o.w = pk2(s[6 * 33], s[7 * 33]);
        *(v4u*)(WT + (size_t)(row0 + n) * K + k0 + 8 * c8) = o; }
    asm volatile("s_waitcnt lgkmcnt(0)" ::: "memory");
}

template <class Epi> __device__ __forceinline__ void run_gemm(LAS unsigned char* lds, const bf16* A, const bf16* Bt, int N, int K, const Epi& E) {
    pg8::Gemm g{A, Bt, M, N, K}; pg8::StaticOrder S; S.init(M, N, osgpr((int)gridDim.x), osgpr((int)blockIdx.x));
    pg8::gemm_phase<Epi, pg8::StaticOrder, PG8_ALIGN, PG8_SP2>(lds, g, S, E);
}

__device__ __forceinline__ float expm1_small(float x) {
    float p = 1.0f / 5040.0f; p = p * x + 1.0f / 720.0f; p = p * x + 1.0f / 120.0f; p = p * x + 1.0f / 24.0f; p = p * x + 1.0f / 6.0f; p = p * x + 0.5f; p = p * x + 1.0f; return p * x;
}
__device__ __forceinline__ void lru_passA(LAS unsigned char* L, const Args& args, int vcu, int G, int tid) {
    const int lane = tid & 63, wave = __builtin_amdgcn_readfirstlane(tid >> 6), fr = lane & 15, fq = lane >> 4;
    LAS bf16* Wt = (LAS bf16*)(L);
    LAS bf16* xcb = (LAS bf16*)(L + 33280);
    LAS float* xcf = (LAS float*)(L + 46592);
    LAS float* Aa = (LAS float*)(L + 67072);
    LAS float* Bb = (LAS float*)(L + 87552);
    LAS bf16* recs = (LAS bf16*)(L + 108032);
    LAS float* sub = (LAS float*)(L + 118752);
    LAS float* cst = (LAS float*)(L + 121632);
    unsigned char* ws = args.ws;
    const bf16* Wg = (const bf16*)(ws + WS_WLG); const float* sp = (const float*)(ws + WS_SP);
    bf16* GATE = (bf16*)(ws + WS_BIG); const bf16* REC = (const bf16*)(ws + WS_BIG + 40 * MiB); bf16* PG = (bf16*)(ws + WS_BIG + 80 * MiB);
    f32x2* SUM = (f32x2*)(ws + WS_LSUM);
    const int n = vcu & 15, ustep = G >> 4, u0 = vcu >> 4;
    unsigned zero = 0u; asm volatile("" : "+v"(zero));
    const int rr0 = tid / 10, pc0 = tid - rr0 * 10, rr1 = (tid + 512) / 10, pc1 = (tid + 512) - rr1 * 10;
#define LRU_REC_LOAD(uu, q0_, q1_) do { const int b_ = (uu) >> 7, t0_ = ((uu) & 127) * 64; q0_ = (v4u){zero, zero, zero, zero}; q1_ = q0_; \
        if (t0_ - 3 + rr0 >= 0) q0_ = *(const v4u*)(REC + ((size_t)b_ * T + t0_ - 3 + rr0) * R + n * 80 + pc0 * 8); \
        if (tid + 512 < 670) q1_ = *(const v4u*)(REC + ((size_t)b_ * T + t0_ - 3 + rr1) * R + n * 80 + pc1 * 8); } while (0)
    v4u rq0, rq1;
    LRU_REC_LOAD(u0, rq0, rq1);
    for (int p = tid; p < 1920; p += 512) { const int row = p / 12, pc = p - row * 12; *(LAS v4u*)(Wt + row * 104 + pc * 8) = *(const v4u*)(Wg + (size_t)(n * 160 + row) * 96 + pc * 8); }
    if (tid < 128) { const int row = tid >> 1, pc = tid & 1; *(LAS v4u*)(xcb + row * 104 + 80 + pc * 8) = (v4u){zero, zero, zero, zero}; }
    if (tid < 80) { const int c = n * 80 + tid;
        cst[0 * 80 + tid] = args.in[I_LCW][0 * R + c]; cst[1 * 80 + tid] = args.in[I_LCW][1 * R + c]; cst[2 * 80 + tid] = args.in[I_LCW][2 * R + c]; cst[3 * 80 + tid] = args.in[I_LCW][3 * R + c];
        cst[4 * 80 + tid] = args.in[I_LCB][c]; cst[5 * 80 + tid] = args.in[I_LBA][c]; cst[6 * 80 + tid] = args.in[I_LBI][c]; cst[7 * 80 + tid] = sp[c]; }
    for (int u = u0; u < 256; u += ustep) {
        const int b = u >> 7, j = u & 127, t0 = j * 64; const size_t rowg0 = (size_t)b * T + t0;
        *(LAS v4u*)(recs + rr0 * 80 + pc0 * 8) = rq0; if (tid + 512 < 670) *(LAS v4u*)(recs + rr1 * 80 + pc1 * 8) = rq1;
        v4u gq0, gq1 = (v4u){zero, zero, zero, zero};
        gq0 = *(const v4u*)(GATE + (rowg0 + rr0) * R + n * 80 + pc0 * 8); if (tid + 512 < 640) gq1 = *(const v4u*)(GATE + (rowg0 + rr1) * R + n * 80 + pc1 * 8);
        if (u + ustep < 256) LRU_REC_LOAD(u + ustep, rq0, rq1);
        __syncthreads();
#pragma unroll
        for (int i = 0; i < 10; ++i) { const int idx = tid + 512 * i, t = idx / 80, c = idx - t * 80;
            float x = cst[4 * 80 + c];
#pragma unroll
            for (int jj = 0; jj < 4; ++jj) x += cst[jj * 80 + c] * bf2f(recs[(t + jj) * 80 + c]);
            xcf[t * 80 + c] = x; xcb[t * 104 + c] = (bf16)f2bf(x); }
        __syncthreads();
        { const int mt = wave & 3, ct0 = (wave >> 2) ? 3 : 0, ct1 = (wave >> 2) ? 5 : 3, tok = 16 * mt + fr;
            for (int ct = ct0; ct < ct1; ++ct) { f32x4 ga = (f32x4){0.f, 0.f, 0.f, 0.f}, gi = ga;
#pragma unroll
                for (int kk = 0; kk < 3; ++kk) { const bf16x8 xf = *(const LAS bf16x8*)(xcb + tok * 104 + 32 * kk + 8 * fq);
                    const bf16x8 wa = *(const LAS bf16x8*)(Wt + (16 * ct + fr) * 104 + 32 * kk + 8 * fq), wi = *(const LAS bf16x8*)(Wt + (80 + 16 * ct + fr) * 104 + 32 * kk + 8 * fq);
                    ga = __builtin_amdgcn_mfma_f32_16x16x32_bf16(wa, xf, ga, 0, 0, 0); gi = __builtin_amdgcn_mfma_f32_16x16x32_bf16(wi, xf, gi, 0, 0, 0); }
                const int ch0 = 16 * ct + 4 * fq; const f32x4 xv = *(const LAS f32x4*)(xcf + tok * 80 + ch0);
                const f32x4 bav = *(const LAS f32x4*)(cst + 5 * 80 + ch0), biv = *(const LAS f32x4*)(cst + 6 * 80 + ch0), spv = *(const LAS f32x4*)(cst + 7 * 80 + ch0); f32x4 av, bv;
#pragma unroll
                for (int e = 0; e < 4; ++e) {
                    const float r = pg8::fast_sigmoid(ga[e] + bav[e]), ig = pg8::fast_sigmoid(gi[e] + biv[e]);
                    const float la = -8.0f * r * spv[e]; float a, om;
                    if (la > -0.125f) { a = 1.0f + expm1_small(la); om = -expm1_small(2.0f * la); } else { a = expf(la); om = -expm1f(2.0f * la); }
                    av[e] = a; bv[e] = __builtin_amdgcn_sqrtf(om) * (ig * xv[e]); }
                *(LAS f32x4*)(Aa + tok * 80 + ch0) = av; *(LAS f32x4*)(Bb + tok * 80 + ch0) = bv; } }
        __syncthreads();
        const int ch = tid % 80, s = tid / 80;
        if (tid < 320) { float Ap = 1.f, Bp = 0.f;
#pragma unroll
            for (int tt = 0; tt < 16; ++tt) { const int t = 16 * s + tt; const float a = Aa[t * 80 + ch], bb = Bb[t * 80 + ch]; Ap *= a; Bp = a * Bp + bb; }
            sub[(s * 80 + ch) * 2] = Ap; sub[(s * 80 + ch) * 2 + 1] = Bp; }
        __syncthreads();
        if (tid < 320) { float h = 0.f, Pp = 1.f;
            for (int s2 = 0; s2 < s; ++s2) { const float a = sub[(s2 * 80 + ch) * 2]; h = a * h + sub[(s2 * 80 + ch) * 2 + 1]; Pp *= a; }
#pragma unroll
            for (int tt = 0; tt < 16; ++tt) { const int t = 16 * s + tt; const float a = Aa[t * 80 + ch]; h = a * h + Bb[t * 80 + ch]; Pp *= a; Bb[t * 80 + ch] = h; Aa[t * 80 + ch] = Pp; }
            if (s == 3) SUM[((size_t)b * 128 + j) * R + n * 80 + ch] = (f32x2){Pp, h}; }
        __syncthreads();
#define LRU_OUT(rr_, pc_, gv) do { const f32x4 h0 = *(const LAS f32x4*)(Bb + (rr_) * 80 + (pc_) * 8), h1 = *(const LAS f32x4*)(Bb + (rr_) * 80 + (pc_) * 8 + 4); \
            const f32x4 p0 = *(const LAS f32x4*)(Aa + (rr_) * 80 + (pc_) * 8), p1 = *(const LAS f32x4*)(Aa + (rr_) * 80 + (pc_) * 8 + 4); \
            const float g0 = bf2f((unsigned short)(gv.x & 0xffffu)), g1 = bf2f((unsigned short)(gv.x >> 16)), g2 = bf2f((unsigned short)(gv.y & 0xffffu)), g3 = bf2f((unsigned short)(gv.y >> 16)); \
            const float g4 = bf2f((unsigned short)(gv.z & 0xffffu)), g5 = bf2f((unsigned short)(gv.z >> 16)), g6 = bf2f((unsigned short)(gv.w & 0xffffu)), g7 = bf2f((unsigned short)(gv.w >> 16)); \
            v4u o, q; o.x = pg8::cvt_pk_bf16(h0[0] * g0, h0[1] * g1); o.y = pg8::cvt_pk_bf16(h0[2] * g2, h0[3] * g3); o.z = pg8::cvt_pk_bf16(h1[0] * g4, h1[1] * g5); o.w = pg8::cvt_pk_bf16(h1[2] * g6, h1[3] * g7); \
            q.x = pg8::cvt_pk_bf16(p0[0] * g0, p0[1] * g1); q.y = pg8::cvt_pk_bf16(p0[2] * g2, p0[3] * g3); q.z = pg8::cvt_pk_bf16(p1[0] * g4, p1[1] * g5); q.w = pg8::cvt_pk_bf16(p1[2] * g6, p1[3] * g7); \
            const size_t off_ = (rowg0 + (rr_)) * R + n * 80 + (pc_) * 8; *(v4u*)(GATE + off_) = o; *(v4u*)(PG + off_) = q; } while (0)
        LRU_OUT(rr0, pc0, gq0); if (tid + 512 < 640) LRU_OUT(rr1, pc1, gq1);
#undef LRU_OUT
        __syncthreads();
    }
#undef LRU_REC_LOAD
}
__device__ __forceinline__ void lru_passB(LAS unsigned char* L, const Args& args, int vcu, int G, int tid, bf16* YOUT) {
    LAS float* carry = (LAS float*)(L);
    unsigned char* ws = args.ws;
    const bf16* YL = (const bf16*)(ws + WS_BIG); const bf16* PG = (const bf16*)(ws + WS_BIG + 80 * MiB); const f32x2* SUM = (const f32x2*)(ws + WS_LSUM);
    const int n = vcu & 15, ustep = G >> 4, u0 = vcu >> 4;
    unsigned zero = 0u; asm volatile("" : "+v"(zero));
    const int rr0 = tid / 10, pc0 = tid - rr0 * 10, rr1 = (tid + 512) / 10, pc1 = (tid + 512) - rr1 * 10;
#define LRU_B_LOAD(uu, y0_, y1_, p0_, p1_, sq_) do { const int b_ = (uu) >> 7, j_ = (uu) & 127, lo_ = (j_ < ustep) ? 0 : j_ - ustep; const size_t r0_ = (size_t)b_ * T + j_ * 64; \
        y0_ = *(const v4u*)(YL + (r0_ + rr0) * R + n * 80 + pc0 * 8); p0_ = *(const v4u*)(PG + (r0_ + rr0) * R + n * 80 + pc0 * 8); y1_ = (v4u){zero, zero, zero, zero}; p1_ = y1_; \
        if (tid + 512 < 640) { y1_ = *(const v4u*)(YL + (r0_ + rr1) * R + n * 80 + pc1 * 8); p1_ = *(const v4u*)(PG + (r0_ + rr1) * R + n * 80 + pc1 * 8); } \
        const f32x2* S_ = SUM + ((size_t)b_ * 128) * R + n * 80 + tid; \
        _Pragma("unroll") for (int i_ = 0; i_ < 16; ++i_) { sq_[i_] = (f32x2){1.f, 0.f}; if (tid < 80 && lo_ + i_ < j_) sq_[i_] = S_[(size_t)(lo_ + i_) * R]; } } while (0)
#define LRU_B_OUT(rr_, pc_, yv, pv) do { const f32x4 c0 = *(const LAS f32x4*)(carry + (pc_) * 8), c1 = *(const LAS f32x4*)(carry + (pc_) * 8 + 4); v4u o; \
        o.x = pg8::cvt_pk_bf16(bf2f((unsigned short)(yv.x & 0xffffu)) + bf2f((unsigned short)(pv.x & 0xffffu)) * c0[0], bf2f((unsigned short)(yv.x >> 16)) + bf2f((unsigned short)(pv.x >> 16)) * c0[1]); \
        o.y = pg8::cvt_pk_bf16(bf2f((unsigned short)(yv.y & 0xffffu)) + bf2f((unsigned short)(pv.y & 0xffffu)) * c0[2], bf2f((unsigned short)(yv.y >> 16)) + bf2f((unsigned short)(pv.y >> 16)) * c0[3]); \
        o.z = pg8::cvt_pk_bf16(bf2f((unsigned short)(yv.z & 0xffffu)) + bf2f((unsigned short)(pv.z & 0xffffu)) * c1[0], bf2f((unsigned short)(yv.z >> 16)) + bf2f((unsigned short)(pv.z >> 16)) * c1[1]); \
        o.w = pg8::cvt_pk_bf16(bf2f((unsigned short)(yv.w & 0xffffu)) + bf2f((unsigned short)(pv.w & 0xffffu)) * c1[2], bf2f((unsigned short)(yv.w >> 16)) + bf2f((unsigned short)(pv.w >> 16)) * c1[3]); \
        *(v4u*)(YOUT + (rowg0 + (rr_)) * R + n * 80 + (pc_) * 8) = o; } while (0)
    v4u y0, y1, p0, p1; f32x2 sq[16];
    LRU_B_LOAD(u0, y0, y1, p0, p1, sq);
    float hc = 0.f;
    for (int u = u0; u < 256; u += ustep) {
        const int b = u >> 7, j = u & 127; const size_t rowg0 = (size_t)b * T + j * 64;
        if (tid < 80) { if (j < ustep) hc = 0.f;
#pragma unroll
            for (int i = 0; i < 16; ++i) hc = sq[i].x * hc + sq[i].y;
            carry[tid] = hc; }
        const v4u cy0 = y0, cy1 = y1, cp0 = p0, cp1 = p1;
        if (u + ustep < 256) LRU_B_LOAD(u + ustep, y0, y1, p0, p1, sq);
        __syncthreads();
        LRU_B_OUT(rr0, pc0, cy0, cp0); if (tid + 512 < 640) LRU_B_OUT(rr1, pc1, cy1, cp1);
        __syncthreads();
    }
#undef LRU_B_LOAD
#undef LRU_B_OUT
}

__device__ __forceinline__ void p0_prologue(LAS unsigned char* lds, const Args& args, int vcu, int G, int tid) {
    const int lane = tid & 63, wave = __builtin_amdgcn_readfirstlane(tid >> 6);
    unsigned char* ws = args.ws;
    LAS float* scr = (LAS float*)(lds + wave * 16384);
    const int gw = vcu * NWAVES + wave, NGW = G * NWAVES;
    constexpr int I_GU = (D / 64) * (NGU / 32), I_DN = (FF / 64) * (D / 32), I_QKV = (D / 64) * (NQKV / 32), I_WO = (D / 64) * (D / 32), I_LI = (D / 64) * (2 * R / 32), I_LO = (R / 64) * (D / 32);
    constexpr int NITEMS = 4 * I_GU + 4 * I_DN + I_QKV + I_WO + I_LI + I_LO;
#define TR_DECODE(it_, W_, gn_, WT_, ldw_, K_, nblk_, gu_, r_) do { int q_ = (it_); gu_ = 0; gn_ = nullptr; \
        if (q_ < 4 * I_GU) { const int f = q_ / I_GU; q_ -= f * I_GU; const int layer = f >> 1; \
            W_ = ((f & 1) ? args.in[I_F2GU] : args.in[I_F1GU]) + (size_t)layer * D * NGU; gn_ = ((f & 1) ? args.in[I_F2N] : args.in[I_F1N]) + layer * D; \
            WT_ = (bf16*)(ws + WS_WGU + f * WGU_BYTES); ldw_ = NGU; K_ = D; nblk_ = NGU / 32; gu_ = 1; } \
        else if ((q_ -= 4 * I_GU) < 4 * I_DN) { const int f = q_ / I_DN; q_ -= f * I_DN; const int layer = f >> 1; \
            W_ = ((f & 1) ? args.in[I_F2D] : args.in[I_F1D]) + (size_t)layer * FF * D; WT_ = (bf16*)(ws + WS_WD + f * WD_BYTES); ldw_ = D; K_ = FF; nblk_ = D / 32; } \
        else if ((q_ -= 4 * I_DN) < I_QKV) { W_ = args.in[I_FOXIN]; gn_ = args.in[I_MIXN]; WT_ = (bf16*)(ws + WS_WQKV); ldw_ = NFOX; K_ = D; nblk_ = NQKV / 32; } \
        else if ((q_ -= I_QKV) < I_WO) { W_ = args.in[I_FOXOUT]; WT_ = (bf16*)(ws + WS_WO); ldw_ = D; K_ = D; nblk_ = D / 32; } \
        else if ((q_ -= I_WO) < I_LI) { W_ = args.in[I_LIN]; gn_ = args.in[I_MIXN] + D; WT_ = (bf16*)(ws + WS_WLIN); ldw_ = 2 * R; K_ = D; nblk_ = 2 * R / 32; } \
        else { q_ -= I_LI; W_ = args.in[I_LOUT]; WT_ = (bf16*)(ws + WS_WLOUT); ldw_ = D; K_ = R; nblk_ = D / 32; } \
        r_ = q_; } while (0)
#define TR_LOAD(v_, W_, ldw_, nblk_, r_) do { const int kb_ = (r_) / (nblk_), nb_ = (r_) - kb_ * (nblk_); const float* p_ = (W_) + (size_t)(64 * kb_ + (lane >> 3)) * (ldw_) + 32 * nb_ + 4 * (lane & 7); \
        _Pragma("unroll") for (int i_ = 0; i_ < 8; ++i_) v_[i_] = *(const f32x4*)(p_ + (size_t)(8 * i_) * (ldw_)); } while (0)
    {
        const float* W = nullptr; const float* gn = nullptr; bf16* WT = nullptr; int ldw = 0, K = 0, nblk = 1, gu = 0, r = 0; f32x4 cur[8];
        int it = gw;
        if (it < NITEMS) { TR_DECODE(it, W, gn, WT, ldw, K, nblk, gu, r); TR_LOAD(cur, W, ldw, nblk, r); }
        while (it < NITEMS) {
            const int itn = it + NGW; const float* Wn = nullptr; const float* gnn = nullptr; bf16* WTn = nullptr; int ldwn = 0, Kn = 0, nblkn = 1, gun = 0, rn = 0; f32x4 nxt[8];
            if (itn < NITEMS) { TR_DECODE(itn, Wn, gnn, WTn, ldwn, Kn, nblkn, gun, rn); TR_LOAD(nxt, Wn, ldwn, nblkn, rn); }
            const int kb = r / nblk, nb = r - kb * nblk, k0 = 64 * kb, n0 = 32 * nb;
#pragma unroll
            for (int i = 0; i < 8; ++i) { const int kk = 8 * i + (lane >> 3); const float g = gn ? gn[k0 + kk] : 1.0f; LAS float* sp_ = scr + kk * 33 + 4 * (lane & 7);
                sp_[0] = cur[i][0] * g; sp_[1] = cur[i][1] * g; sp_[2] = cur[i][2] * g; sp_[3] = cur[i][3] * g; }
            asm volatile("s_waitcnt lgkmcnt(0)" ::: "memory");
            int row0 = n0;
            if (gu) { const int c = (n0 < FF) ? n0 : n0 - FF; row0 = 256 * (c >> 7) + (c & 127) + ((n0 < FF) ? 0 : 128); }
            const int c8 = lane & 7;
#pragma unroll
            for (int j = 0; j < 4; ++j) { const int n = (lane >> 3) + 8 * j; const LAS float* s_ = scr + (8 * c8) * 33 + n;
                v4u o; o.x = pg8::cvt_pk_bf16(s_[0 * 33], s_[1 * 33]); o.y = pg8::cvt_pk_bf16(s_[2 * 33], s_[3 * 33]); o.z = pg8::cvt_pk_bf16(s_[4 * 33], s_[5 * 33]); o.w = pg8::cvt_pk_bf16(s_[6 * 33], s_[7 * 33]);
                *(v4u*)(WT + (size_t)(row0 + n) * K + k0 + 8 * c8) = o; }
            asm volatile("s_waitcnt lgkmcnt(0)" ::: "memory");
            it = itn; W = Wn; gn = gnn; WT = WTn; ldw = ldwn; K = Kn; nblk = nblkn; gu = gun; r = rn;
#pragma unroll
            for (int i = 0; i < 8; ++i) cur[i] = nxt[i];
        }
    }
#undef TR_DECODE
#undef TR_LOAD
    const int gt = vcu * 512 + tid, NGT = G * 512;
    { bf16* wf = (bf16*)(ws + WS_WF);
        for (int i = gt; i < NH * D; i += NGT) { const int h = i >> 10, k = i & 1023; wf[i] = (bf16)f2bf(args.in[I_MIXN][k] * args.in[I_FOXIN][(size_t)k * NFOX + NQKV + h]); } }
    { bf16* wg = (bf16*)(ws + WS_WLG);
        for (int i = gt; i < 16 * 160 * 96; i += NGT) { const int k = i % 96, dd = (i / 96) % 160, n = i / (96 * 160); float v = 0.f;
            if (k < 80) v = (dd < 80) ? args.in[I_LWA][((size_t)n * 80 + k) * 80 + dd] : args.in[I_LWI][((size_t)n * 80 + k) * 80 + (dd - 80)];
            wg[i] = (bf16)f2bf(v); } }
    { float* sp = (float*)(ws + WS_SP); for (int i = gt; i < R; i += NGT) sp[i] = log1pf(expf(-args.in[I_LLAM][i])); }
    { float* ss = (float*)(ws + WS_SS); for (int i = gt; i < 7 * M; i += NGT) ss[M + i] = 0.f; if (gt < 32) ((float*)(ws + WS_FS))[gt] = 0.f; }
    { float* ss0 = (float*)(ws + WS_SS); bf16* xb = (bf16*)(ws + WS_XB); const float* x = args.in[I_X];
        for (int m = gw; m < M; m += NGW) { const f32x4* xr = (const f32x4*)(x + (size_t)m * D) + lane; f32x4 v[4]; float s = 0.f;
#pragma unroll
            for (int j = 0; j < 4; ++j) { v[j] = xr[64 * j]; s += (v[j].x * v[j].x + v[j].y * v[j].y) + (v[j].z * v[j].z + v[j].w * v[j].w); }
            s = wave_sum(s, lane); if (lane == 0) ss0[m] = s;
            unsigned long long* o8 = (unsigned long long*)(xb + (size_t)m * D) + lane;
#pragma unroll
            for (int j = 0; j < 4; ++j) o8[64 * j] = (unsigned long long)pk2(v[j].x, v[j].y) | ((unsigned long long)pk2(v[j].z, v[j].w) << 32); } }
}

__device__ __forceinline__ void flogit_phase(const Args& args, int vcu, int G, int tid) {
    const int lane = tid & 63, wave = __builtin_amdgcn_readfirstlane(tid >> 6), fr = lane & 15, fq = lane >> 4;
    unsigned char* ws = args.ws; const bf16* xb = (const bf16*)(ws + WS_XB); const bf16* wf = (const bf16*)(ws + WS_WF); const float* ss = (const float*)(ws + WS_SS) + 1 * M; float* logf_ = (float*)(ws + WS_LOGF);
    const int gw = vcu * NWAVES + wave, NGW = G * NWAVES;
    for (int grp = gw; grp < M / 16; grp += NGW) { const int row0 = grp * 16;
        const bf16* xa = xb + (size_t)(row0 + fr) * D + 8 * fq; const bf16* wb = wf + (size_t)fr * D + 8 * fq; f32x4 acc = (f32x4){0.f, 0.f, 0.f, 0.f};
#pragma unroll 8
        for (int kk = 0; kk < 32; ++kk) { const bf16x8 xf = *(const bf16x8*)(xa + 32 * kk), wv = *(const bf16x8*)(wb + 32 * kk); acc = __builtin_amdgcn_mfma_f32_16x16x32_bf16(wv, xf, acc, 0, 0, 0); }
        const int row = row0 + fr, b = row >> 13, t = row & (T - 1); const float rs = pg8::rstd_row(ss, row);
#pragma unroll
        for (int e = 0; e < 4; ++e) { const int h = 4 * fq + e; const float z = acc[e] * rs + args.in[I_FOXBF][h];
            const float lf = (fminf(z, 0.f) - log1pf(expf(-fabsf(z)))) * LOG2E; logf_[(size_t)(b * NH + h) * T + t] = lf;
            float sr = lf; sr += shx(sr, 1, lane); sr += shx(sr, 2, lane); sr += shx(sr, 4, lane); sr += shx(sr, 8, lane);
            if (fr == 0) __hip_atomic_fetch_add((float*)(ws + WS_FS) + b * NH + h, sr, __ATOMIC_RELAXED, __HIP_MEMORY_SCOPE_AGENT); } }
}

__device__ __forceinline__ void attn_cumsum(const float* lf, LAS float* Gl, LAS float* wsum, int tid) {
    const int lane = tid & 63, wave = tid >> 6; f32x4 v[4];
#pragma unroll
    for (int j = 0; j < 4; ++j) v[j] = *(const f32x4*)(lf + tid * 16 + 4 * j);
    float run = 0.f;
#pragma unroll
    for (int j = 0; j < 4; ++j) { run += v[j].x; v[j].x = run; run += v[j].y; v[j].y = run; run += v[j].z; v[j].z = run; run += v[j].w; v[j].w = run; }
    float incl = run;
#pragma unroll
    for (int o = 1; o < 64; o <<= 1) { const float nb = shup(incl, o, lane); if (lane >= o) incl += nb; }
    if (lane == 63) wsum[wave] = incl;
    __syncthreads();
    float base = incl - run;
    for (int w = 0; w < wave; ++w) base += wsum[w];
#pragma unroll
    for (int j = 0; j < 4; ++j) *(LAS f32x4*)(Gl + tid * 16 + 4 * j) = v[j] + base;
    __syncthreads();
}

constexpr int N_PHASES = 17;
#ifndef ONLY_KIND
#define ONLY_KIND -1
#endif
#define KON(k) (ONLY_KIND < 0 || ONLY_KIND == (k))
#ifndef DUP_PH
#define DUP_PH -1
#endif
#ifndef DUP_SYNC
#define DUP_SYNC 0
#endif
__global__ void __launch_bounds__(NWAVES * 64, 2) fwd_megakernel(Args args) {
    extern __shared__ __attribute__((aligned(16))) unsigned char lds_raw[];
    LAS unsigned char* lds = (LAS unsigned char*)lds_raw;
    cg::grid_group grid = cg::this_grid();
    if (threadIdx.x < 16) ((LAS unsigned*)(lds + MISC_OFF))[threadIdx.x] = 0u;
    __syncthreads();
    XcdBarrier xbar = xcd_barrier_post((unsigned*)(args.ws + WS_BAR), (volatile LAS unsigned*)(lds + MISC_OFF));
    unsigned char* ws = args.ws;
    float* ssb = (float*)(ws + WS_SS); bf16* XB = (bf16*)(ws + WS_XB);
    bf16* HB = (bf16*)(ws + WS_BIG); bf16* QB_ = (bf16*)(ws + WS_BIG); bf16* KB = (bf16*)(ws + WS_BIG + 32 * MiB); bf16* VB = (bf16*)(ws + WS_BIG + 64 * MiB);
    bf16* GATE = (bf16*)(ws + WS_BIG); bf16* REC = (bf16*)(ws + WS_BIG + 40 * MiB);
    for (int pp = args.ph_lo; pp < args.ph_hi; ++pp) {
        int ph = pp; bool dummy = false;
        if (DUP_PH >= 0) { dummy = (pp == DUP_PH); ph = (pp <= DUP_PH) ? pp : pp - 1; }
        const int tid = otid(), G = osgpr((int)gridDim.x), bx = osgpr((int)blockIdx.x);
        const int vcu = (G % 8 == 0) ? (bx % 8) * (G / 8) + bx / 8 : bx;
        int kind = 0, f = 0, ssi = 0; const bf16* A = XB; const bf16* Bt = nullptr; int K = D; const float* xin = args.out; float alpha = 1.f;
        switch (ph) {
            case 0: kind = 0; break;
            case 1: kind = 1; f = 0; ssi = 0; break;
            case 2: kind = 2; A = HB; Bt = (const bf16*)(ws + WS_WD + 0 * WD_BYTES); K = FF; xin = args.in[I_X]; alpha = 0.5f; ssi = 1; break;
            case 3: kind = 3; break;
            case 4: kind = 4; break;
            case 5: kind = 2; A = (const bf16*)(ws + 218 * MiB); Bt = (const bf16*)(ws + WS_WO); K = D; alpha = 1.f; ssi = 2; break;
            case 6: kind = 1; f = 1; ssi = 2; break;
            case 7: kind = 2; A = HB; Bt = (const bf16*)(ws + WS_WD + 1 * WD_BYTES); K = FF; alpha = 0.5f; ssi = 3; break;
            case 8: kind = 1; f = 2; ssi = 3; break;
            case 9: kind = 2; A = HB; Bt = (const bf16*)(ws + WS_WD + 2 * WD_BYTES); K = FF; alpha = 0.5f; ssi = 4; break;
            case 10: kind = 5; break;
            case 11: kind = 6; break;
            case 12: kind = 7; break;
            case 13: kind = 2; A = GATE; Bt = (const bf16*)(ws + WS_WLOUT); K = R; alpha = 1.f; ssi = 5; break;
            case 14: kind = 1; f = 3; ssi = 5; break;
            case 15: kind = 2; A = HB; Bt = (const bf16*)(ws + WS_WD + 3 * WD_BYTES); K = FF; alpha = 0.5f; ssi = 6; break;
            default: kind = 8; break;
        }
        if (dummy) { alpha = 0.f; if (kind == 2) ssi = 7; }
        bf16* const OB = (bf16*)(ws + 218 * MiB);     bf16* const YB = dummy ? REC : GATE;
        if (KON(0) && kind == 0) { p0_prologue(lds, args, vcu, G, tid); }
        else if (KON(1) && kind == 1) { pg8::EpiSwiGLU E{HB, ssb + (size_t)ssi * M}; run_gemm(lds, XB, (const bf16*)(ws + WS_WGU + f * WGU_BYTES), NGU, D, E); }
        else if (KON(2) && kind == 2) { pg8::EpiResid E{xin, args.out, XB, ssb + (size_t)ssi * M, alpha}; run_gemm(lds, A, Bt, D, K, E); }
        else if (KON(3) && kind == 3) { pg8::EpiQKV E{QB_, (size_t)M * D, ssb + 1 * M, attn_body::C2, (float*)(ws + WS_NRM)}; run_gemm(lds, XB, (const bf16*)(ws + WS_WQKV), NQKV, D, E); flogit_phase(args, vcu, G, tid); }
        else if (KON(4) && kind == 4) {
            LAS float* Gl = (LAS float*)(lds + 86016); LAS float* wsum = (LAS float*)(lds + 86016 + 32768); LAS unsigned* tsw = (LAS unsigned*)(lds + 86016 + 32768 + 64);
            LAS int* sch = (LAS int*)(lds + 86016 + 32768 + 256);
            if (tid < 64) { const int l = tid & 31;
                const float fs = __hip_atomic_load((const float*)(ws + WS_FS) + l, __ATOMIC_RELAXED, __HIP_MEMORY_SCOPE_AGENT);
                const float avg = fmaxf(-fs * (1.0f / 8192.0f), 1e-3f); const int W = (int)fminf(128.f, ceilf(230.f / (64.f * avg)));
                int cost = 0; for (int qb = 0; qb < 32; ++qb) cost += min(4 * qb + 4, W + 5) + 8;
                int tot = cost; for (int o = 1; o < 32; o <<= 1) tot += shxi(tot, o, tid);
                int n = max(1, (int)(((long)cost * G) / tot)); int sumn = n; for (int o = 1; o < 32; o <<= 1) sumn += shxi(sumn, o, tid);
                for (int guard = 0; guard < 512 && sumn != G; ++guard) {
                    if (sumn < G) { const float load = (float)cost / (float)n; float m = load; for (int o = 1; o < 32; o <<= 1) m = fmaxf(m, shx(m, o, tid));
                        const int arg = __builtin_ctzll(__ballot(load == m)); if (l == arg) ++n; ++sumn; }
                    else { const float load = (n > 1) ? (float)cost / (float)(n - 1) : 3.0e38f; float m = load; for (int o = 1; o < 32; o <<= 1) m = fminf(m, shx(m, o, tid));
                        const int arg = __builtin_ctzll(__ballot(load == m)); if (l == arg) --n; --sumn; } }
                int start = n; for (int o = 1; o < 32; o <<= 1) { const int v = shupi(start, o, tid); if (l >= o) start += v; }
                start -= n;
                if (tid < 32 && vcu >= start && vcu < start + n) { sch[0] = l; sch[1] = vcu - start; sch[2] = n; } }
            __syncthreads();
            { const int bh = __builtin_amdgcn_readfirstlane(sch[0]), widx = __builtin_amdgcn_readfirstlane(sch[1]), nwg = __builtin_amdgcn_readfirstlane(sch[2]);
                attn_cumsum((const float*)(ws + WS_LOGF) + (size_t)bh * T, Gl, wsum, tid);
                { const int hd = bh & 15, bb = bh >> 4; const float* nq = (const float*)(ws + WS_NRM) + ((size_t)hd * 256 + bb * 128) * 2; const float* nk = nq + (size_t)16 * 256 * 2;
                    if (tid < 32) tsw[tid] = (unsigned)(4 * tid);
                    __syncthreads();
                    if (tid < 128) { const float kn2 = nk[tid * 2] + nk[tid * 2 + 1], gend = Gl[64 * tid + 63];
                        for (int qb = (tid >> 2) + 1; qb < 32; ++qb) { float qn2 = 0.f;
#pragma unroll
                            for (int r4 = 0; r4 < 4; ++r4) qn2 = fmaxf(qn2, nq[(4 * qb + r4) * 2] + nq[(4 * qb + r4) * 2 + 1]);
                            const float bound = 1.01f * sqrtf(qn2 * kn2) + Gl[256 * qb] - gend;
                            if (!(bound < -190.f)) atomicMin((unsigned*)tsw + qb, (unsigned)tid); } }
                    __syncthreads(); }
                for (int qb = 31; qb >= 0; --qb) { const int p = 31 - qb, r = p / nwg, pos = p - r * nwg, owner = (r & 1) ? nwg - 1 - pos : pos; if (owner != widx) continue;
                    const int tstart = __builtin_amdgcn_readfirstlane((int)tsw[qb]) & ~1;
                    attn_body::attn_unit<8>(bh >> 4, bh & 15, qb, (const attn_body::bf16*)QB_, (const attn_body::bf16*)KB, (const attn_body::bf16*)VB, (attn_body::bf16*)OB, (char*)lds_raw, (attn_body::lds_fptr)Gl, tstart); }
                __syncthreads(); }
        }
        else if (KON(5) && kind == 5) { pg8::EpiLruIn E{GATE, REC, ssb + 4 * M}; run_gemm(lds, XB, (const bf16*)(ws + WS_WLIN), 2 * R, D, E); }
        else if (KON(6) && kind == 6) { lru_passA(lds, args, vcu, G, tid); }
        else if (KON(7) && kind == 7) { lru_passB(lds, args, vcu, G, tid, YB); }
        else if (KON(8)) { const int lane = tid & 63, wave = tid >> 6, gw = vcu * NWAVES + wave, NGW = G * NWAVES; const float* ss = ssb + 6 * M; const f32x4* gn = (const f32x4*)args.in[I_FINN] + lane;
            for (int m = gw; m < M; m += NGW) { const float rs = pg8::rstd_row(ss, m); f32x4* xr = (f32x4*)(args.out + (size_t)m * D) + lane;
#pragma unroll
                for (int j = 0; j < 4; ++j) { const f32x4 v = xr[64 * j]; xr[64 * j] = v * rs * gn[64 * j]; } } }
        if (pp + 1 < args.ph_hi) { if (pp == args.ph_lo) grid.sync(); else xcd_barrier(xbar); if (DUP_SYNC) xcd_barrier(xbar); }
    }
}

#ifndef MK_PER_PHASE_LAUNCH
#define MK_PER_PHASE_LAUNCH 0
#endif
extern "C" void kernel_launch(void* const* d_in, const int* in_sizes, int n_in, void* d_out, int out_size, void* d_ws, size_t ws_size, hipStream_t stream) {
    static int grid = 0;
    if (grid == 0) {
        if (n_in != 21 || in_sizes[0] != M * D || out_size != M * D || ws_size < WS_END) { fprintf(stderr, "kernel_launch: unexpected shapes (n_in %d, in0 %d, out %d, ws %zu); nothing launched\n", n_in, n_in > 0 ? in_sizes[0] : -1, out_size, ws_size); grid = -1; return; }
        int dev = 0, cus = 0, per_cu = 0;
        if (hipGetDevice(&dev) != hipSuccess || hipDeviceGetAttribute(&cus, hipDeviceAttributeMultiprocessorCount, dev) != hipSuccess) { grid = -1; return; }
        if (hipFuncSetAttribute((const void*)fwd_megakernel, hipFuncAttributeMaxDynamicSharedMemorySize, LDS_BYTES) != hipSuccess) { fprintf(stderr, "kernel_launch: hipFuncSetAttribute failed\n"); grid = -1; return; }
        if (hipOccupancyMaxActiveBlocksPerMultiprocessor(&per_cu, (const void*)fwd_megakernel, NWAVES * 64, LDS_BYTES) != hipSuccess || per_cu < 1) { fprintf(stderr, "kernel_launch: occupancy query says %d blocks per CU\n", per_cu); per_cu = 1; }
        (void)hipGetLastError();
        grid = cus * per_cu;
        if (grid != 256) fprintf(stderr, "kernel_launch: grid %d (this kernel's static unit orders assume 256 workgroups)\n", grid);
    }
    if (grid < 0) return;
    Args a{};
    for (int i = 0; i < 21; ++i) a.in[i] = (const float*)d_in[i];
    a.out = (float*)d_out; a.ws = (unsigned char*)d_ws;
    if (hipMemsetAsync((unsigned char*)d_ws + WS_BAR, 0, BAR_BYTES, stream) != hipSuccess) { fprintf(stderr, "kernel_launch: memset of the barrier words failed\n"); return; }
#if MK_PER_PHASE_LAUNCH
    for (int ph = 0; ph < N_PHASES; ++ph) { a.ph_lo = ph; a.ph_hi = ph + 1; hipLaunchKernelGGL(fwd_megakernel, dim3(grid), dim3(NWAVES * 64), LDS_BYTES, stream, a); }
#else
    a.ph_lo = 0; a.ph_hi = N_PHASES + ((DUP_PH >= 0) ? 1 : 0);
    void* kargs[] = {&a};
    const hipError_t e = hipLaunchCooperativeKernel((const void*)fwd_megakernel, dim3(grid), dim3(NWAVES * 64), kargs, LDS_BYTES, stream);
    if (e != hipSuccess) fprintf(stderr, "kernel_launch: cooperative launch failed: %s (grid %d)\n", hipGetErrorString(e), grid);
#endif
}
```
